# Optimizing an MI355X kernel written in HIP

```python
import math
import jax
import jax.numpy as jnp
from jax import lax
import numpy as np

D_MODEL = 1024
BATCH = 4
SEQ = 8192
DEPTH = 1

ATTN_HEADS = 8
HEAD_DIM = 64
ATTN_WIDTH = ATTN_HEADS * HEAD_DIM
MOBA_BLOCK = 256
MOBA_TOPK = 3
MOBA_QCHUNK = 128
REL_BUCKETS = 32
REL_MAX_DISTANCE = 2048
GMLP_WIDTH = D_MODEL // 2
GMLP_GROUPS = 8
GMLP_GROUP_DIM = GMLP_WIDTH // GMLP_GROUPS
GMLP_CHUNK = 128
PEER_HEADS = 8
PEER_NKEYS = 128
PEER_EXPERTS = PEER_NKEYS * PEER_NKEYS
PEER_QDIM = 128
PEER_HALF = PEER_QDIM // 2
PEER_TOPK = 16
PEER_TOKCHUNK = 128
IN_WIDTH = 3 * ATTN_WIDTH + 2 * GMLP_WIDTH + 2 * D_MODEL
NORM_EPS = 1e-6
NEG_INF = -1e30

kernel_name = "hybrid_moba_gmlp_peer_block"


def rms_norm(x, g):
    xf = x.astype(jnp.float32)
    y = xf * lax.rsqrt(jnp.mean(xf * xf, axis=-1, keepdims=True) + NORM_EPS)
    return (y * g.astype(jnp.float32)).astype(x.dtype)


def layer_norm(x, g, b):
    xf = x.astype(jnp.float32)
    mu = jnp.mean(xf, axis=-1, keepdims=True)
    xc = xf - mu
    var = jnp.mean(xc * xc, axis=-1, keepdims=True)
    y = xc * lax.rsqrt(var + NORM_EPS) * g.astype(jnp.float32) + b.astype(jnp.float32)
    return y.astype(x.dtype)


def t5_bucket(rel):
    max_exact = REL_BUCKETS // 2
    n = jnp.maximum(rel, 0)
    nf = jnp.maximum(n, max_exact).astype(jnp.float32)
    large = max_exact + (jnp.log(nf / max_exact) / math.log(REL_MAX_DISTANCE / max_exact)
                         * (REL_BUCKETS - max_exact)).astype(jnp.int32)
    large = jnp.minimum(large, REL_BUCKETS - 1)
    return jnp.where(n < max_exact, n, large)


def moba_attention(q, k, v, rel_bias):
    B, S, H, dh = q.shape
    nb = -(-S // MOBA_BLOCK)
    pad = nb * MOBA_BLOCK - S
    q = q.transpose(0, 2, 1, 3)
    k = jnp.pad(k.transpose(0, 2, 1, 3), ((0, 0), (0, 0), (0, pad), (0, 0)))
    v = jnp.pad(v.transpose(0, 2, 1, 3), ((0, 0), (0, 0), (0, pad), (0, 0)))
    kb = k.reshape(B, H, nb, MOBA_BLOCK, dh)
    vb = v.reshape(B, H, nb, MOBA_BLOCK, dh)
    scale = dh ** -0.5
    q_blk = jnp.arange(S) // MOBA_BLOCK
    n_slots = min(MOBA_TOPK, nb - 1)
    if n_slots > 0:
        k_mean = jnp.mean(kb.astype(jnp.float32), axis=3)
        score = jnp.einsum('bhsd,bhnd->bhsn', q.astype(jnp.float32), k_mean)
        fully_past = jnp.arange(nb)[None, :] < q_blk[:, None]
        score = jnp.where(fully_past, score, NEG_INF)
        _, sel = lax.top_k(score, n_slots)
    else:
        sel = jnp.zeros((B, H, S, 0), jnp.int32)
    sel_valid = jnp.arange(n_slots)[None, :] < q_blk[:, None]

    nc = S // MOBA_QCHUNK
    q_c = q.reshape(B, H, nc, MOBA_QCHUNK, dh).transpose(2, 0, 1, 3, 4)
    sel_c = sel.reshape(B, H, nc, MOBA_QCHUNK, n_slots).transpose(2, 0, 1, 3, 4)
    valid_c = sel_valid.reshape(nc, MOBA_QCHUNK, n_slots)
    rb = rel_bias.T.astype(jnp.float32)
    b_ix = jnp.arange(B)[:, None, None]
    h_ix = jnp.arange(H)[None, :, None]
    offs = jnp.arange(MOBA_BLOCK)

    def one_chunk(args):
        qc, selc, validc, ci = args
        q_pos = ci * MOBA_QCHUNK + jnp.arange(MOBA_QCHUNK)
        own = (ci * MOBA_QCHUNK) // MOBA_BLOCK
        k_own = lax.dynamic_index_in_dim(kb, own, axis=2, keepdims=False)
        v_own = lax.dynamic_index_in_dim(vb, own, axis=2, keepdims=False)
        rel = q_pos[:, None] - (own * MOBA_BLOCK + offs)[None, :]
        lg = (jnp.einsum('bhqd,bhkd->bhqk', qc, k_own).astype(jnp.float32) * scale
              + rb[:, t5_bucket(rel)])
        logits = [jnp.where(rel >= 0, lg, NEG_INF)]
        for j in range(n_slots):
            idx = selc[..., j]
            k_j = kb[b_ix, h_ix, idx]
            rel_j = q_pos[:, None] - (idx[..., None] * MOBA_BLOCK + offs)
            lg = (jnp.einsum('bhqd,bhqkd->bhqk', qc, k_j).astype(jnp.float32) * scale
                  + rb[h_ix[..., None], t5_bucket(rel_j)])
            logits.append(jnp.where(validc[:, j][:, None], lg, NEG_INF))
        p = jax.nn.softmax(jnp.concatenate(logits, axis=-1), axis=-1).astype(vb.dtype)
        out = jnp.einsum('bhqk,bhkd->bhqd', p[..., :MOBA_BLOCK], v_own)
        for j in range(n_slots):
            v_j = vb[b_ix, h_ix, selc[..., j]]
            out = out + jnp.einsum('bhqk,bhqkd->bhqd',
                                   p[..., (j + 1) * MOBA_BLOCK:(j + 2) * MOBA_BLOCK], v_j)
        return out

    out = lax.map(one_chunk, (q_c, sel_c, valid_c, jnp.arange(nc)))
    return out.transpose(1, 0, 3, 2, 4).reshape(B, S, H * dh)


def spatial_gating(z_u, z_v, ln_g, ln_b, w_s, b_s):
    B, S, _ = z_u.shape
    u = jax.nn.gelu(z_u)
    v = layer_norm(jax.nn.gelu(z_v), ln_g, ln_b)
    nch = S // GMLP_CHUNK
    vc = v.reshape(B, nch, GMLP_CHUNK, GMLP_GROUPS, GMLP_GROUP_DIM)
    causal = jnp.tril(jnp.ones((GMLP_CHUNK, GMLP_CHUNK), dtype=bool))
    w = jnp.where(causal, w_s, jnp.zeros((), w_s.dtype)).astype(v.dtype)
    mixed = jnp.einsum('gts,bnsgc->bntgc', w, vc) + b_s.T[:, :, None].astype(v.dtype)
    return u * mixed.reshape(B, S, GMLP_WIDTH)


def token_mixing(h, w_in, gmlp_ln_g, gmlp_ln_b, gmlp_w_s, gmlp_b_s, rel_bias,
                 w_branch_attn, w_branch_gmlp, w_out):
    B, S, _ = h.shape
    proj = h @ w_in
    a3 = 3 * ATTN_WIDTH
    cuts = [ATTN_WIDTH, 2 * ATTN_WIDTH, a3, a3 + GMLP_WIDTH, a3 + 2 * GMLP_WIDTH,
            a3 + 2 * GMLP_WIDTH + D_MODEL]
    q, k, v, z_u, z_v, g_attn, g_gmlp = jnp.split(proj, cuts, axis=-1)
    heads = (B, S, ATTN_HEADS, HEAD_DIM)
    y_attn = moba_attention(q.reshape(heads), k.reshape(heads), v.reshape(heads), rel_bias)
    y_gmlp = spatial_gating(z_u, z_v, gmlp_ln_g, gmlp_ln_b, gmlp_w_s, gmlp_b_s)
    merged = (jax.nn.sigmoid(g_attn) * (y_attn @ w_branch_attn)
              + jax.nn.sigmoid(g_gmlp) * (y_gmlp @ w_branch_gmlp))
    return merged @ w_out


def peer_ffn(h, w_query, sub_keys, expert_u, expert_v):
    B, S, D = h.shape
    T = B * S
    x = h.reshape(T, D)
    q = (x @ w_query).reshape(T, PEER_HEADS, 2, PEER_HALF).astype(jnp.float32)
    sk = sub_keys.astype(jnp.float32)
    s1 = jnp.einsum('thd,kd->thk', q[:, :, 0], sk[0])
    s2 = jnp.einsum('thd,kd->thk', q[:, :, 1], sk[1])
    v1, i1 = lax.top_k(s1, PEER_TOPK)
    v2, i2 = lax.top_k(s2, PEER_TOPK)
    cand = (v1[..., :, None] + v2[..., None, :]).reshape(T, PEER_HEADS, PEER_TOPK * PEER_TOPK)
    sc, flat = lax.top_k(cand, PEER_TOPK)
    e = (jnp.take_along_axis(i1, flat // PEER_TOPK, axis=-1) * PEER_NKEYS
         + jnp.take_along_axis(i2, flat % PEER_TOPK, axis=-1))
    g = jax.nn.softmax(sc, axis=-1).astype(h.dtype)
    nchunk = T // PEER_TOKCHUNK

    def one_chunk(args):
        xc, ec, gc = args
        u = expert_u[ec]
        a = jax.nn.gelu(jnp.einsum('cd,chkd->chk', xc, u))
        return jnp.einsum('chk,chkd->cd', gc * a, expert_v[ec])

    out = lax.map(one_chunk, (x.reshape(nchunk, PEER_TOKCHUNK, D),
                              e.reshape(nchunk, PEER_TOKCHUNK, PEER_HEADS, PEER_TOPK),
                              g.reshape(nchunk, PEER_TOKCHUNK, PEER_HEADS, PEER_TOPK)))
    return out.reshape(B, S, D)


def setup_inputs(seed: int = 0) -> dict:
    key = jax.random.key(seed)
    ks = jax.random.split(key, 24)
    f32 = jnp.float32
    L = DEPTH

    def nrm(k, shape, scale):
        return jax.random.normal(k, shape, f32) * scale

    return {
        "x": nrm(ks[0], (BATCH, SEQ, D_MODEL), 1.0),
        "c": nrm(ks[1], (BATCH, D_MODEL), 1.0),
        "ada_w": nrm(ks[2], (L, D_MODEL, 6 * D_MODEL), 0.5 * D_MODEL ** -0.5),
        "ada_b": nrm(ks[3], (L, 6 * D_MODEL), 0.02),
        "pre_g1": 1.0 + nrm(ks[4], (L, D_MODEL), 0.02),
        "post_g1": 1.0 + nrm(ks[5], (L, D_MODEL), 0.02),
        "w_in": nrm(ks[6], (L, D_MODEL, IN_WIDTH), D_MODEL ** -0.5),
        "gmlp_ln_g": 1.0 + nrm(ks[7], (L, GMLP_WIDTH), 0.02),
        "gmlp_ln_b": nrm(ks[8], (L, GMLP_WIDTH), 0.02),
        "gmlp_w_s": nrm(ks[9], (L, GMLP_GROUPS, GMLP_CHUNK, GMLP_CHUNK), GMLP_CHUNK ** -0.5),
        "gmlp_b_s": 1.0 + nrm(ks[10], (L, GMLP_GROUPS, GMLP_CHUNK), 0.02),
        "rel_bias": nrm(ks[11], (REL_BUCKETS, ATTN_HEADS), 0.5),
        "w_branch_attn": nrm(ks[12], (L, ATTN_WIDTH, D_MODEL), ATTN_WIDTH ** -0.5),
        "w_branch_gmlp": nrm(ks[13], (L, GMLP_WIDTH, D_MODEL), GMLP_WIDTH ** -0.5),
        "w_out": nrm(ks[14], (L, D_MODEL, D_MODEL), D_MODEL ** -0.5),
        "pre_g2": 1.0 + nrm(ks[15], (L, D_MODEL), 0.02),
        "post_g2": 1.0 + nrm(ks[16], (L, D_MODEL), 0.02),
        "peer_w_query": nrm(ks[17], (L, D_MODEL, PEER_HEADS * PEER_QDIM), D_MODEL ** -0.5),
        "peer_sub_keys": nrm(ks[18], (L, 2, PEER_NKEYS, PEER_HALF), PEER_HALF ** -0.5),
        "peer_u": nrm(ks[19], (L, PEER_EXPERTS, D_MODEL), D_MODEL ** -0.5),
        "peer_v": nrm(ks[20], (L, PEER_EXPERTS, D_MODEL), D_MODEL ** -0.5),
    }


def reference(x, c, ada_w, ada_b, pre_g1, post_g1, w_in, gmlp_ln_g, gmlp_ln_b,
              gmlp_w_s, gmlp_b_s, rel_bias, w_branch_attn, w_branch_gmlp, w_out,
              pre_g2, post_g2, peer_w_query, peer_sub_keys, peer_u, peer_v):
    cond = jax.nn.silu(c)
    for l in range(DEPTH):
        mod = cond @ ada_w[l] + ada_b[l]
        sh1, sc1, gt1, sh2, sc2, gt2 = jnp.split(mod[:, None, :], 6, axis=-1)
        h = rms_norm(x, pre_g1[l]) * (1.0 + sc1) + sh1
        y = token_mixing(h, w_in[l], gmlp_ln_g[l], gmlp_ln_b[l], gmlp_w_s[l], gmlp_b_s[l],
                         rel_bias, w_branch_attn[l], w_branch_gmlp[l], w_out[l])
        x = x + gt1 * rms_norm(y, post_g1[l])
        h = rms_norm(x, pre_g2[l]) * (1.0 + sc2) + sh2
        y = peer_ffn(h, peer_w_query[l], peer_sub_keys[l], peer_u[l], peer_v[l])
        x = x + gt2 * rms_norm(y, post_g2[l])
    return x
```

```cpp
#include <hip/hip_runtime.h>
#include <cstdio>
#include <cstdint>
namespace pg8 {
#define PG8_LAS __attribute__((address_space(3)))
typedef unsigned short bf16_t;
typedef short bf16x8 __attribute__((ext_vector_type(8)));
typedef float f32x4 __attribute__((ext_vector_type(4)));
typedef unsigned u32x4 __attribute__((ext_vector_type(4)));
constexpr int BM = 256, BK = 64, HALF = 128, HTB = HALF * BK * 2  , STAGE_BYTES = 8 * HTB, NXCD = 8, WGM = 8;

__host__ __device__ __forceinline__ int lds_byte(int r, int c) { const int st = (r >> 4) * 2 + (c >> 5), rr = r & 15, cc = c & 31, ob = rr * 64 + cc * 2; return st * 1024 + (ob ^ (((ob >> 9) & 1) << 5)); }
__host__ __device__ __forceinline__ void stage_rc(int b, int& R, int& C) { const int st = b / 1024, sb = b % 1024, swz = sb ^ (((sb >> 9) & 1) << 5); R = (st >> 1) * 16 + swz / 64; C = (st & 1) * 32 + (swz % 64) / 2; }
__host__ __device__ __forceinline__ int perm32(int rho) { const int n = rho >> 4, i = rho & 15; return 8 * (i >> 2) + 4 * n + (i & 3); }

struct Unit { int pm, pn; };
struct Gemm { const bf16_t* A; const bf16_t* Bt; int M, N, K; };

struct StaticOrder {
    int nM, nN, nwg, G, c;
    __host__ __device__ void init(int M, int N, int G_, int c_) { nM = M / BM; nN = N / BM; nwg = nM * nN; G = G_; c = c_; }
    __host__ __device__ bool next(int i, Unit& u) const {
        const long L = (long)i * G + c; if (L >= nwg) return false;
        int wgid = (int)L; { const int q = nwg / NXCD, r = nwg % NXCD, xcd = wgid % NXCD, off = wgid / NXCD; wgid = (xcd < r ? xcd * (q + 1) : r * (q + 1) + (xcd - r) * q) + off; }
        const int nig = WGM * nN, gid = wgid / nig, fm = gid * WGM, gsz = (nM - fm) < WGM ? (nM - fm) : WGM;
        u.pm = fm + ((wgid % nig) % gsz); u.pn = (wgid % nig) / gsz; return true;
    }
    __device__ __forceinline__ void a_ready(const Unit&) const {}
    __device__ __forceinline__ void done(const Unit&) const {}
};

__device__ __forceinline__ unsigned cvt_pk_bf16(float lo, float hi) { unsigned r; asm volatile("v_cvt_pk_bf16_f32 %0, %1, %2" : "=v"(r) : "v"(lo), "v"(hi)); return r; }
__device__ __forceinline__ float bflo(unsigned u) { return __uint_as_float(u << 16); }
__device__ __forceinline__ float bfhi(unsigned u) { return __uint_as_float(u & 0xffff0000u); }
__device__ __forceinline__ float act_sigmoid(float x) { return __builtin_amdgcn_rcpf(1.0f + __builtin_amdgcn_exp2f(-1.4426950408889634f * x)); }
__device__ __forceinline__ float act_gelu(float x) { const float z = 1.5957691216057308f * (x + 0.044715f * x * x * x); return x * __builtin_amdgcn_rcpf(1.0f + __builtin_amdgcn_exp2f(-1.4426950408889634f * z)); }

struct EpiIn {
    static constexpr bool PERM = true, AFTER_DRAIN = false;
    bf16_t *Q, *Kk, *V, *U, *GV, *GA, *GG;
    __device__ __forceinline__ void operator()(const f32x4 (&acc)[2][2][4][2], const Unit& u, int wr, int wc, int fr, int fq) const {
        const int pn = u.pn; bf16_t* base; int ldc, colt, act;
        if (pn < 2) { base = Q; ldc = 512; colt = pn * 256; act = 0; }
        else if (pn < 4) { base = Kk; ldc = 512; colt = (pn - 2) * 256; act = 0; }
        else if (pn < 6) { base = V; ldc = 512; colt = (pn - 4) * 256; act = 0; }
        else if (pn < 8) { base = U; ldc = 512; colt = (pn - 6) * 256; act = 1; }
        else if (pn < 10) { base = GV; ldc = 512; colt = (pn - 8) * 256; act = 1; }
        else if (pn < 14) { base = GA; ldc = 1024; colt = (pn - 10) * 256; act = 2; }
        else { base = GG; ldc = 1024; colt = (pn - 14) * 256; act = 2; }
        const int row0 = u.pm * BM + wr * 64 + fr, col0 = colt + wc * 32 + 8 * fq;
#pragma unroll
        for (int ai = 0; ai < 2; ++ai)
#pragma unroll
            for (int m = 0; m < 4; ++m) { bf16_t* rowp = base + (size_t)(row0 + ai * HALF + m * 16) * ldc + col0;
#pragma unroll
                for (int bj = 0; bj < 2; ++bj) { f32x4 v0 = acc[ai][bj][m][0], v1 = acc[ai][bj][m][1];
                    if (act == 1) {
#pragma unroll
                        for (int j = 0; j < 4; ++j) { v0[j] = act_gelu(v0[j]); v1[j] = act_gelu(v1[j]); } }
                    else if (act == 2) {
#pragma unroll
                        for (int j = 0; j < 4; ++j) { v0[j] = act_sigmoid(v0[j]); v1[j] = act_sigmoid(v1[j]); } }
                    u32x4 w; w.x = cvt_pk_bf16(v0[0], v0[1]); w.y = cvt_pk_bf16(v0[2], v0[3]); w.z = cvt_pk_bf16(v1[0], v1[1]); w.w = cvt_pk_bf16(v1[2], v1[3]);
                    *(u32x4*)(rowp + bj * HALF) = w; } }
    }
};
struct EpiGate {
    static constexpr bool PERM = true, AFTER_DRAIN = false;
    const bf16_t* Gt; const bf16_t* Tin; bf16_t* O;
    __device__ __forceinline__ void operator()(const f32x4 (&acc)[2][2][4][2], const Unit& u, int wr, int wc, int fr, int fq) const {
        const int row0 = u.pm * BM + wr * 64 + fr, col0 = u.pn * BM + wc * 32 + 8 * fq;
#pragma unroll
        for (int ai = 0; ai < 2; ++ai)
#pragma unroll
            for (int m = 0; m < 4; ++m) { const size_t ro = (size_t)(row0 + ai * HALF + m * 16) * 1024 + col0;
#pragma unroll
                for (int bj = 0; bj < 2; ++bj) { const f32x4 v0 = acc[ai][bj][m][0], v1 = acc[ai][bj][m][1];
                    const u32x4 g = *(const u32x4*)(Gt + ro + bj * HALF);
                    float o[8];
                    o[0] = bflo(g.x) * v0[0]; o[1] = bfhi(g.x) * v0[1]; o[2] = bflo(g.y) * v0[2]; o[3] = bfhi(g.y) * v0[3];
                    o[4] = bflo(g.z) * v1[0]; o[5] = bfhi(g.z) * v1[1]; o[6] = bflo(g.w) * v1[2]; o[7] = bfhi(g.w) * v1[3];
                    if (Tin) { const u32x4 t = *(const u32x4*)(Tin + ro + bj * HALF);
                        o[0] += bflo(t.x); o[1] += bfhi(t.x); o[2] += bflo(t.y); o[3] += bfhi(t.y); o[4] += bflo(t.z); o[5] += bfhi(t.z); o[6] += bflo(t.w); o[7] += bfhi(t.w); }
                    u32x4 w; w.x = cvt_pk_bf16(o[0], o[1]); w.y = cvt_pk_bf16(o[2], o[3]); w.z = cvt_pk_bf16(o[4], o[5]); w.w = cvt_pk_bf16(o[6], o[7]);
                    *(u32x4*)(O + ro + bj * HALF) = w; } }
    }
};
struct EpiPlain {
    static constexpr bool PERM = true, AFTER_DRAIN = false;
    bf16_t* O; int ldc;
    __device__ __forceinline__ void operator()(const f32x4 (&acc)[2][2][4][2], const Unit& u, int wr, int wc, int fr, int fq) const {
        const int row0 = u.pm * BM + wr * 64 + fr, col0 = u.pn * BM + wc * 32 + 8 * fq;
#pragma unroll
        for (int ai = 0; ai < 2; ++ai)
#pragma unroll
            for (int m = 0; m < 4; ++m) { bf16_t* rowp = O + (size_t)(row0 + ai * HALF + m * 16) * ldc + col0;
#pragma unroll
                for (int bj = 0; bj < 2; ++bj) { const f32x4 v0 = acc[ai][bj][m][0], v1 = acc[ai][bj][m][1];
                    u32x4 w; w.x = cvt_pk_bf16(v0[0], v0[1]); w.y = cvt_pk_bf16(v0[2], v0[3]); w.z = cvt_pk_bf16(v1[0], v1[1]); w.w = cvt_pk_bf16(v1[2], v1[3]);
                    *(u32x4*)(rowp + bj * HALF) = w; } }
    }
};
template <class Epi, class Sched, bool ALIGN_EPI = false, bool SP2 = false>
__device__ __forceinline__ void gemm_phase(PG8_LAS unsigned char* lds, const Gemm g, const Sched& S, const Epi& E) {
    const int tid = threadIdx.x, wid = __builtin_amdgcn_readfirstlane(tid >> 6), lane = tid & 63, wr = wid >> 2, wc = wid & 3, fr = lane & 15, fq = lane >> 4;
    const int K = g.K, nt = K / BK;
    unsigned voffA[2], voffB[2];
#pragma unroll
    for (int i = 0; i < 2; ++i) { int R, C; stage_rc(tid * 16 + i * 8192, R, C); const int Rb = Epi::PERM ? ((R & ~31) + perm32(R & 31)) : R;
        voffA[i] = (unsigned)(R * K + C) * 2u; voffB[i] = (unsigned)(Rb * K + C) * 2u; }
    const size_t kstep = (size_t)(BK * 2);
    const size_t hstep = (size_t)HALF * K * 2;
    const size_t tstep = 2 * hstep;
    const unsigned ldsw = (unsigned)wid * 1024u;
    const int aoff = lds_byte(wr * 64 + fr, fq * 8), boff = lds_byte(wc * 32 + fr, fq * 8);
#define PG8_SA(b, h) (((b) * 2 + (h)) * HTB)
#define PG8_SB(b, h) ((4 + (b) * 2 + (h)) * HTB)
#define PG8_STAGE(bufoff, gbase, voff) do { _Pragma("unroll") for (int _i = 0; _i < 2; ++_i) \
        __builtin_amdgcn_global_load_lds((const unsigned*)((const char*)(gbase) + (voff)[_i]), (PG8_LAS unsigned*)(lds + (bufoff) + ldsw + _i * 8192), 16, 0, 0); } while (0)
#define PG8_LDA(dst, b, h) do { _Pragma("unroll") for (int m = 0; m < 4; ++m) _Pragma("unroll") for (int k = 0; k < 2; ++k) dst[m][k] = *(const PG8_LAS bf16x8*)(lds + PG8_SA(b, h) + aoff + m * 2048 + k * 1024); } while (0)
#define PG8_LDB(dst, b, h) do { _Pragma("unroll") for (int n = 0; n < 2; ++n) _Pragma("unroll") for (int k = 0; k < 2; ++k) dst[n][k] = *(const PG8_LAS bf16x8*)(lds + PG8_SB(b, h) + boff + n * 2048 + k * 1024); } while (0)
#define PG8_MMA(ai, bj, At, Bt) do { __builtin_amdgcn_s_setprio(1); _Pragma("unroll") for (int m = 0; m < 4; ++m) _Pragma("unroll") for (int n = 0; n < 2; ++n) _Pragma("unroll") for (int k = 0; k < 2; ++k) \
        acc[ai][bj][m][n] = __builtin_amdgcn_mfma_f32_16x16x32_bf16(Bt[n][k], At[m][k], acc[ai][bj][m][n], 0, 0, 0); __builtin_amdgcn_s_setprio(0); } while (0)
#define PG8_WAIT_V(n) asm volatile("s_waitcnt vmcnt(" #n ")" ::: "memory")
#define PG8_WAIT_L(n) asm volatile("s_waitcnt lgkmcnt(" #n ")" ::: "memory")
#define PG8_BAR __builtin_amdgcn_s_barrier()
#define PG8_SCHED __builtin_amdgcn_sched_barrier(0)
    Unit cur, nxt; int ui = 0;
    if (!S.next(0, cur)) return;
    f32x4 acc[2][2][4][2];
#pragma unroll
    for (int a = 0; a < 2; ++a)
#pragma unroll
        for (int b = 0; b < 2; ++b)
#pragma unroll
            for (int m = 0; m < 4; ++m)
#pragma unroll
                for (int n = 0; n < 2; ++n) acc[a][b][m][n] = (f32x4){0.f, 0.f, 0.f, 0.f};
    bf16x8 At[4][2], B0[2][2], B1[2][2];
    const char* cA = (const char*)g.A + (size_t)cur.pm * tstep; const char* cB = (const char*)g.Bt + (size_t)cur.pn * tstep;
    S.a_ready(cur);
    if constexpr (SP2) {
        PG8_STAGE(PG8_SB(0, 0), cB, voffB); PG8_STAGE(PG8_SB(0, 1), cB + hstep, voffB); PG8_STAGE(PG8_SA(0, 0), cA, voffA); PG8_STAGE(PG8_SA(0, 1), cA + hstep, voffA);
        if (wr == 1) PG8_BAR;
        PG8_WAIT_V(2); PG8_BAR;
        PG8_STAGE(PG8_SB(1, 0), cB + kstep, voffB); PG8_STAGE(PG8_SA(1, 0), cA + kstep, voffA); PG8_STAGE(PG8_SB(1, 1), cB + hstep + kstep, voffB);
        PG8_WAIT_V(6); PG8_BAR;
    } else {
        PG8_STAGE(PG8_SB(0, 0), cB, voffB); PG8_STAGE(PG8_SA(0, 0), cA, voffA); PG8_STAGE(PG8_SB(0, 1), cB + hstep, voffB); PG8_STAGE(PG8_SA(0, 1), cA + hstep, voffA);
        if (wr == 1) PG8_BAR;
        PG8_WAIT_V(4); PG8_BAR;
        PG8_STAGE(PG8_SB(1, 0), cB + kstep, voffB); PG8_STAGE(PG8_SA(1, 0), cA + kstep, voffA); PG8_STAGE(PG8_SB(1, 1), cB + hstep + kstep, voffB);
        PG8_WAIT_V(6); PG8_BAR;
    }
    for (;;) {
        const bool has_next = S.next(ui + 1, nxt);
        const char* nA = has_next ? (const char*)g.A + (size_t)nxt.pm * tstep : cA; const char* nB = has_next ? (const char*)g.Bt + (size_t)nxt.pn * tstep : cB;
        for (int t = 0; t < nt; t += 2) {
            const bool last = (t == nt - 2);
            const char* a1 = cA + (size_t)(t + 1) * kstep;
            const char* a2 = last ? nA : cA + (size_t)(t + 2) * kstep; const char* b2 = last ? nB : cB + (size_t)(t + 2) * kstep;
            const char* a3 = a2 + kstep; const char* b3 = b2 + kstep;
            if (last && has_next) S.a_ready(nxt);
            if constexpr (SP2) {
            PG8_LDB(B0, 0, 0); PG8_LDB(B1, 0, 1); PG8_SCHED; PG8_LDA(At, 0, 0); PG8_STAGE(PG8_SA(1, 1), a1 + hstep, voffA);
            PG8_WAIT_V(8); PG8_WAIT_L(0); PG8_BAR; PG8_MMA(0, 0, At, B0); PG8_MMA(0, 1, At, B1); PG8_BAR; PG8_SCHED;
            PG8_LDA(At, 0, 1); PG8_STAGE(PG8_SB(0, 0), b2, voffB); PG8_STAGE(PG8_SB(0, 1), b2 + hstep, voffB); PG8_STAGE(PG8_SA(0, 0), a2, voffA);
            PG8_WAIT_V(8); PG8_WAIT_L(0); PG8_BAR; PG8_MMA(1, 0, At, B0); PG8_MMA(1, 1, At, B1); PG8_BAR; PG8_SCHED;
            PG8_LDB(B0, 1, 0); PG8_LDB(B1, 1, 1); PG8_SCHED; PG8_LDA(At, 1, 0); PG8_STAGE(PG8_SA(0, 1), a2 + hstep, voffA);
            PG8_WAIT_V(8); PG8_WAIT_L(0); PG8_BAR; PG8_MMA(0, 0, At, B0); PG8_MMA(0, 1, At, B1); PG8_BAR; PG8_SCHED;
            PG8_LDA(At, 1, 1); PG8_STAGE(PG8_SB(1, 0), b3, voffB); PG8_STAGE(PG8_SB(1, 1), b3 + hstep, voffB); PG8_STAGE(PG8_SA(1, 0), a3, voffA);
            PG8_WAIT_V(8); PG8_WAIT_L(0); PG8_BAR; PG8_MMA(1, 0, At, B0); PG8_MMA(1, 1, At, B1); PG8_BAR; PG8_SCHED;
            } else {
            PG8_LDB(B0, 0, 0); PG8_SCHED; PG8_LDA(At, 0, 0); PG8_STAGE(PG8_SA(1, 1), a1 + hstep, voffA);
            PG8_WAIT_L(8); PG8_BAR; PG8_WAIT_L(0); PG8_MMA(0, 0, At, B0); PG8_BAR; PG8_SCHED;
            PG8_LDB(B1, 0, 1); PG8_STAGE(PG8_SB(0, 0), b2, voffB);
            PG8_BAR; PG8_WAIT_L(0); PG8_MMA(0, 1, At, B1); PG8_BAR;
            PG8_LDA(At, 0, 1); PG8_STAGE(PG8_SA(0, 0), a2, voffA);
            PG8_BAR; PG8_WAIT_L(0); PG8_MMA(1, 0, At, B0); PG8_BAR; PG8_SCHED;
            PG8_STAGE(PG8_SB(0, 1), b2 + hstep, voffB);
            PG8_WAIT_V(6); PG8_BAR; PG8_MMA(1, 1, At, B1); PG8_BAR;
            PG8_LDB(B0, 1, 0); PG8_SCHED; PG8_LDA(At, 1, 0); PG8_STAGE(PG8_SA(0, 1), a2 + hstep, voffA);
            PG8_WAIT_L(8); PG8_BAR; PG8_WAIT_L(0); PG8_MMA(0, 0, At, B0); PG8_BAR; PG8_SCHED;
            PG8_LDB(B1, 1, 1); PG8_STAGE(PG8_SB(1, 0), b3, voffB);
            PG8_BAR; PG8_WAIT_L(0); PG8_MMA(0, 1, At, B1); PG8_BAR;
            PG8_LDA(At, 1, 1); PG8_STAGE(PG8_SA(1, 0), a3, voffA);
            PG8_BAR; PG8_WAIT_L(0); PG8_MMA(1, 0, At, B0); PG8_BAR; PG8_SCHED;
            PG8_STAGE(PG8_SB(1, 1), b3 + hstep, voffB);
            PG8_WAIT_V(6); PG8_BAR; PG8_MMA(1, 1, At, B1); PG8_BAR;
            }
        }
        if constexpr (ALIGN_EPI) { if (wr == 0) PG8_BAR; }
        if constexpr (!Epi::AFTER_DRAIN) { E(acc, cur, wr, wc, fr, fq); S.done(cur); }
        if (!has_next) break;
#pragma unroll
        for (int a = 0; a < 2; ++a)
#pragma unroll
            for (int b = 0; b < 2; ++b)
#pragma unroll
                for (int m = 0; m < 4; ++m)
#pragma unroll
                    for (int n = 0; n < 2; ++n) acc[a][b][m][n] = (f32x4){0.f, 0.f, 0.f, 0.f};
        cur = nxt; cA = nA; cB = nB; ++ui;
        if constexpr (ALIGN_EPI) { if (wr == 1) PG8_BAR; }
    }
    PG8_WAIT_V(0);
    if constexpr (!ALIGN_EPI) { if (wr == 0) PG8_BAR; }
    PG8_BAR;
    if constexpr (Epi::AFTER_DRAIN) { E.fused(acc, cur, wr, wc, fr, fq, lds, wid, lane); S.done(cur); }
#undef PG8_SA
#undef PG8_SB
#undef PG8_STAGE
#undef PG8_LDA
#undef PG8_LDB
#undef PG8_MMA
#undef PG8_WAIT_V
#undef PG8_WAIT_L
#undef PG8_BAR
#undef PG8_SCHED
}
}

constexpr int NB = 4, SEQ = 8192, DM = 1024, NT = NB * SEQ;
constexpr int NH = 8, HD = 64, AW = 512, GW = 512, INW = 4608;
constexpr int NEXP = 16384;
constexpr float EPS = 1e-6f;
constexpr int NWAVES = 8, NTHR = 512;

#ifndef MK_ONE_LAUNCH
#define MK_ONE_LAUNCH 0
#endif
constexpr int NPH = 11;

constexpr size_t MiB = 1u << 20;
constexpr size_t WS_CTL = 0, CTL_ZERO_BYTES = 64 * 1024;
constexpr size_t WS_MOD = 1 * MiB;
constexpr size_t WS_KM = 1 * MiB + 128 * 1024;
constexpr size_t WS_BIAS = 1 * MiB + 512 * 1024;
constexpr size_t WS_WIN = 4 * MiB;
constexpr size_t WS_WBA = 13 * MiB, WS_WBG = 14 * MiB, WS_WOUT = 15 * MiB, WS_WQ = 17 * MiB;
constexpr size_t WS_PU = 20 * MiB, WS_PV = 52 * MiB;
constexpr size_t WS_A = 84 * MiB;
constexpr size_t WS_B = 148 * MiB;
constexpr size_t WS_C = 244 * MiB;
constexpr size_t WS_D = 308 * MiB;
constexpr size_t WS_E = 436 * MiB;
constexpr size_t WS_END = 500 * MiB;

constexpr int RING_BYTES = 131072;
constexpr int MISC_OFF = RING_BYTES;
constexpr int LDS_BYTES = 147456;

#define GAS __attribute__((address_space(1)))
#define LAS __attribute__((address_space(3)))
typedef unsigned short bf16;
typedef unsigned v4u __attribute__((ext_vector_type(4)));
typedef float f32x4 __attribute__((ext_vector_type(4)));
#define DEVI __device__ __forceinline__
DEVI float bf2f(bf16 v) { return __uint_as_float(((unsigned)v) << 16); }
DEVI float bflo(unsigned u) { return __uint_as_float(u << 16); }
DEVI float bfhi(unsigned u) { return __uint_as_float(u & 0xffff0000u); }
DEVI unsigned pk2(float lo, float hi) { return pg8::cvt_pk_bf16(lo, hi); }
DEVI float wave_sum(float v) {
#pragma unroll
    for (int o = 32; o > 0; o >>= 1) v += __shfl_xor(v, o);
    return v; }
DEVI float wave_max(float v) {
#pragma unroll
    for (int o = 32; o > 0; o >>= 1) v = fmaxf(v, __shfl_xor(v, o));
    return v; }
DEVI float gelu_tanh(float x) { return pg8::act_gelu(x); }

#define XB_TMO      128
#define XB_XCNT(j)  (256  + 64 * (j))
#define XB_XSUB(j)  (1280 + 64 * (j))
#define XB_XGEN(j)  (2304 + 64 * (j))
#define XB_TOP      3328
#define XB_TOPGEN   3392
#define XCD_BAR_WORDS 3456
#define XB_SPIN_CAP (1u << 18)

__device__ __forceinline__ unsigned xb_ld(unsigned* p)              { return __hip_atomic_load(p, __ATOMIC_RELAXED, __HIP_MEMORY_SCOPE_AGENT); }
__device__ __forceinline__ unsigned xb_add(unsigned* p, unsigned v) { return __hip_atomic_fetch_add(p, v, __ATOMIC_RELAXED, __HIP_MEMORY_SCOPE_AGENT); }
__device__ __forceinline__ unsigned xb_xcc_id() { return (unsigned)__builtin_amdgcn_s_getreg((3 << 11) | 20) & 0xFu; }
#define XB_SPIN(cond, bar) do { unsigned _sp = 0; while (cond) { __builtin_amdgcn_s_sleep(1); \
    if ((++_sp & 255u) == 0u) { if (xb_ld(&(bar)[XB_TMO])) break; if (_sp > XB_SPIN_CAP) { atomicAdd(&(bar)[XB_TMO], 1u); break; } } } } while (0)

struct XcdBarrier {
    unsigned* bar; unsigned x;
    volatile LAS unsigned* st;
};

__device__ __forceinline__ XcdBarrier xcd_barrier_post(unsigned* bar, volatile LAS unsigned* st) {
    XcdBarrier b; b.bar = bar; b.x = xb_xcc_id(); b.st = st;
    if (threadIdx.x == 0) (void)xb_add(&bar[XB_XCNT(b.x)], 1u);
    return b;
}
__device__ __forceinline__ void xcd_barrier_complete(unsigned* bar, unsigned x, unsigned& nloc, unsigned& nx) {
    const unsigned G = gridDim.x * gridDim.y * gridDim.z;
    unsigned sum, cnt, mine, sp = 0u;
    for (;;) {
        sum = 0u; cnt = 0u; mine = 0u;
#pragma unroll
        for (unsigned j = 0; j < 16; ++j) { const unsigned c = xb_ld(&bar[XB_XCNT(j)]); sum += c; cnt += (c > 0u) ? 1u : 0u; mine = (j == x) ? c : mine; }
        if (sum == G) break;
        __builtin_amdgcn_s_sleep(1);
        if ((++sp & 255u) == 0u) { if (xb_ld(&bar[XB_TMO])) break; if (sp > XB_SPIN_CAP) { atomicAdd(&bar[XB_TMO], 1u); break; } }
    }
    nloc = mine > 0u ? mine : 1u; nx = cnt > 0u ? cnt : 1u;
}

__device__ __forceinline__ void xcd_barrier(const XcdBarrier& b) {
    asm volatile("s_waitcnt vmcnt(0)" ::: "memory");
    __syncthreads();
    if (threadIdx.x == 0) {
        unsigned* bar = b.bar;
        __builtin_amdgcn_s_waitcnt(0);
        unsigned nloc = b.st[0], nx = b.st[1];
        if (nloc == 0u) { xcd_barrier_complete(bar, b.x, nloc, nx); b.st[0] = nloc; b.st[1] = nx; }
        const unsigned old = xb_add(&bar[XB_XSUB(b.x)], 1u);
        const unsigned gen = old / nloc;
        if (old + 1u == (gen + 1u) * nloc) {
            __builtin_amdgcn_fence(__ATOMIC_RELEASE, "agent");
            asm volatile("s_waitcnt vmcnt(0)" ::: "memory");
            const unsigned og = xb_add(&bar[XB_TOP], 1u);
            const unsigned tg = og / nx;
            if (og + 1u == (tg + 1u) * nx) xb_add(&bar[XB_TOPGEN], 1u);
            else XB_SPIN(xb_ld(&bar[XB_TOPGEN]) == tg, bar);
            __builtin_amdgcn_fence(__ATOMIC_ACQUIRE, "agent");
            xb_add(&bar[XB_XGEN(b.x)], 1u);
            asm volatile("s_waitcnt vmcnt(0)" ::: "memory");
        } else {
            XB_SPIN(xb_ld(&bar[XB_XGEN(b.x)]) == gen, bar);
            __builtin_amdgcn_fence(__ATOMIC_ACQUIRE, "agent");
            asm volatile("s_waitcnt vmcnt(0)" ::: "memory");
        }
    }
    __syncthreads();
}
struct Args { const float* in[21]; float* out; unsigned char* ws; int ph_lo, ph_hi; };

DEVI void p0_transpose_tile(const float* __restrict__ W, int K, int N, bf16* __restrict__ WT, int tk, int tn, float* tile, int tid) {
    const int k0 = tk * 64, n0 = tn * 64;
    { const int r = tid >> 4, c4 = (tid & 15) * 4;
#pragma unroll
      for (int hh = 0; hh < 2; ++hh) { const int rr = r + 32 * hh; const f32x4 v = *(const f32x4*)(W + (size_t)(k0 + rr) * N + n0 + c4);
          tile[rr * 65 + c4 + 0] = v[0]; tile[rr * 65 + c4 + 1] = v[1]; tile[rr * 65 + c4 + 2] = v[2]; tile[rr * 65 + c4 + 3] = v[3]; } }
    __syncthreads();
    { const int n = tid >> 3, kc = (tid & 7) * 8; float v[8];
#pragma unroll
      for (int j = 0; j < 8; ++j) v[j] = tile[(kc + j) * 65 + n];
      v4u w; w.x = pk2(v[0], v[1]); w.y = pk2(v[2], v[3]); w.z = pk2(v[4], v[5]); w.w = pk2(v[6], v[7]);
      *(v4u*)(WT + (size_t)(n0 + n) * K + k0 + kc) = w; }
    __syncthreads();
}
DEVI int t5_bucket(int rel) {
    const int n = rel < 0 ? 0 : rel;
    if (n < 16) return n;
    int b = 16;
    b = n >= 22 ? 17 : b; b = n >= 30 ? 18 : b; b = n >= 40 ? 19 : b; b = n >= 54 ? 20 : b; b = n >= 73 ? 21 : b; b = n >= 99 ? 22 : b; b = n >= 134 ? 23 : b; b = n >= 182 ? 24 : b;
    b = n >= 246 ? 25 : b; b = n >= 332 ? 26 : b; b = n >= 450 ? 27 : b; b = n >= 609 ? 28 : b; b = n >= 825 ? 29 : b; b = n >= 1117 ? 30 : b; b = n >= 1513 ? 31 : b;
    return b;
}
DEVI void p0_prologue(const Args& a, unsigned char* lds, int tid, int bid, int G) {
    unsigned char* ws = a.ws;
    float* tile = (float*)lds;
    float* silu = (float*)(lds + 32768);
    float* part = (float*)(lds + 49152);
    constexpr int N_WIN = 16 * 72, N_WB = 8 * 16, N_SQ = 16 * 16;
    constexpr int I1 = N_WIN, I2 = I1 + N_WB, I3 = I2 + N_WB, I4 = I3 + N_SQ, I5 = I4 + N_SQ, I6 = I5 + 96;
    bool have_silu = false;
    for (int it = bid; it < I6; it += G) {
        if (it < I1) { p0_transpose_tile(a.in[6], 1024, INW, (bf16*)(ws + WS_WIN), it / 72, it % 72, tile, tid); }
        else if (it < I2) { const int j = it - I1; p0_transpose_tile(a.in[12], 512, 1024, (bf16*)(ws + WS_WBA), j / 16, j % 16, tile, tid); }
        else if (it < I3) { const int j = it - I2; p0_transpose_tile(a.in[13], 512, 1024, (bf16*)(ws + WS_WBG), j / 16, j % 16, tile, tid); }
        else if (it < I4) { const int j = it - I3; p0_transpose_tile(a.in[14], 1024, 1024, (bf16*)(ws + WS_WOUT), j / 16, j % 16, tile, tid); }
        else if (it < I5) { const int j = it - I4; p0_transpose_tile(a.in[17], 1024, 1024, (bf16*)(ws + WS_WQ), j / 16, j % 16, tile, tid); }
        else {
            const int i = it - I5;
            if (!have_silu) { for (int idx = tid; idx < 4096; idx += NTHR) { const float c = a.in[1][idx]; silu[idx] = c / (1.0f + expf(-c)); } have_silu = true; }
            __syncthreads();
            const int w = tid >> 6, l = tid & 63, j = 64 * i + l;
            float acc[4] = {0.f, 0.f, 0.f, 0.f};
            const float* aw = a.in[2];
            for (int k = 128 * w; k < 128 * w + 128; ++k) { const float wv = aw[(size_t)k * 6144 + j];
#pragma unroll
                for (int b = 0; b < 4; ++b) acc[b] += silu[b * 1024 + k] * wv; }
#pragma unroll
            for (int b = 0; b < 4; ++b) part[(w * 4 + b) * 64 + l] = acc[b];
            __syncthreads();
            if (tid < 256) { const int b = tid >> 6; float s = a.in[3][j];
#pragma unroll
                for (int ww = 0; ww < 8; ++ww) s += part[(ww * 4 + b) * 64 + l];
                ((float*)(ws + WS_MOD))[b * 6144 + j] = s; }
            __syncthreads();
        }
    }
    {
        const size_t n8 = (size_t)NEXP * 1024 / 8;
        const float* pu = a.in[19]; const float* pv = a.in[20];
        bf16* du = (bf16*)(ws + WS_PU); bf16* dv = (bf16*)(ws + WS_PV);
        for (size_t i = (size_t)bid * NTHR + tid; i < 2 * n8; i += (size_t)G * NTHR) {
            const bool second = i >= n8; const size_t j = second ? i - n8 : i;
            const float* src = (second ? pv : pu) + j * 8; bf16* dst = (second ? dv : du) + j * 8;
            const f32x4 v0 = *(const f32x4*)src, v1 = *(const f32x4*)(src + 4);
            v4u w; w.x = pk2(v0[0], v0[1]); w.y = pk2(v0[2], v0[3]); w.z = pk2(v1[0], v1[1]); w.w = pk2(v1[2], v1[3]);
            *(v4u*)dst = w;
        }
    }
    for (int i = bid * NTHR + tid; i < 8 * 2048; i += G * NTHR) { const int h = i >> 11, rel = i & 2047; ((float*)(ws + WS_BIAS))[i] = a.in[11][t5_bucket(rel) * 8 + h]; }
}

DEVI void p1_prenorm(const float* __restrict__ x, const float* __restrict__ g, const float* __restrict__ mod, int sh_off, int sc_off, bf16* __restrict__ H, int gw, int nw, int lane) {
    for (int row = gw; row < NT; row += nw) {
        const int b = row >> 13; const float* xr = x + (size_t)row * DM; const float* mb = mod + b * 6144;
        f32x4 v[4]; float ss = 0.f;
#pragma unroll
        for (int i = 0; i < 4; ++i) { v[i] = *(const f32x4*)(xr + 4 * lane + 256 * i); ss += v[i][0] * v[i][0] + v[i][1] * v[i][1] + v[i][2] * v[i][2] + v[i][3] * v[i][3]; }
        ss = wave_sum(ss);
        const float r = rsqrtf(ss * (1.0f / DM) + EPS);
#pragma unroll
        for (int i = 0; i < 4; ++i) { const int d = 4 * lane + 256 * i;
            const f32x4 gg = *(const f32x4*)(g + d), sc = *(const f32x4*)(mb + sc_off + d), sh = *(const f32x4*)(mb + sh_off + d);
            float o[4];
#pragma unroll
            for (int j = 0; j < 4; ++j) o[j] = v[i][j] * r * gg[j] * (1.0f + sc[j]) + sh[j];
            uint2 w; w.x = pk2(o[0], o[1]); w.y = pk2(o[2], o[3]);
            *(uint2*)(H + (size_t)row * DM + d) = w; }
    }
}

DEVI void p3_kmean(const bf16* __restrict__ Kb, float* __restrict__ KM, int tid, int bid, int G) {
    for (int idx = bid * NTHR + tid; idx < NB * 32 * 512; idx += G * NTHR) {
        const int c = idx & 511, bn = idx >> 9, b = bn >> 5, n = bn & 31;
        const bf16* p = Kb + ((size_t)b * SEQ + n * 256) * 512 + c; float s = 0.f;
        for (int r = 0; r < 256; ++r) s += bf2f(p[(size_t)r * 512]);
        KM[((size_t)((b * 8 + (c >> 6)) * 32 + n)) * 64 + (c & 63)] = s * (1.0f / 256.0f);
    }
}

DEVI void p4_attn_simple(const bf16* __restrict__ Q, const bf16* __restrict__ Kb, const bf16* __restrict__ Vb, const float* __restrict__ KM, const float* __restrict__ BIAS,
                         bf16* __restrict__ YA, int gw, int nw, int lane) {
    for (int item = gw; item < NT * NH; item += nw) {
        const int t = item >> 3, h = item & 7, b = t >> 13, s = t & 8191, qb = s >> 8;
        float q[64];
        { const v4u* qp = (const v4u*)(Q + (size_t)t * 512 + h * 64);
#pragma unroll
          for (int i = 0; i < 8; ++i) { const v4u w = qp[i]; q[8 * i + 0] = bflo(w.x); q[8 * i + 1] = bfhi(w.x); q[8 * i + 2] = bflo(w.y); q[8 * i + 3] = bfhi(w.y);
              q[8 * i + 4] = bflo(w.z); q[8 * i + 5] = bfhi(w.z); q[8 * i + 6] = bflo(w.w); q[8 * i + 7] = bfhi(w.w); } }
        float sc = -3.0e38f;
        if (lane < qb) { const float* km = KM + ((size_t)((b * 8 + h) * 32 + lane)) * 64; float a = 0.f;
#pragma unroll
            for (int d = 0; d < 64; ++d) a += q[d] * km[d];
            sc = a; }
        int kb[4]; kb[0] = qb;
#pragma unroll
        for (int j = 0; j < 3; ++j) { const float m = wave_max(sc); const unsigned long long msk = __ballot(sc == m && lane < 32); const int idx = __ffsll((long long)msk) - 1; kb[j + 1] = idx & 31; if (lane == idx) sc = -3.2e38f; }
        float lg[4][4]; float mx = -3.0e38f;
        const float* bias = BIAS + h * 2048;
#pragma unroll
        for (int sg = 0; sg < 4; ++sg) {
            const bool segv = (sg == 0) || (sg - 1 < qb);
#pragma unroll
            for (int i = 0; i < 4; ++i) {
                const int kk = lane + 64 * i, kp = kb[sg] * 256 + kk, rel = s - kp;
                float v = -1.0e30f;
                if (segv && rel >= 0) {
                    const v4u* kr = (const v4u*)(Kb + ((size_t)b * SEQ + kp) * 512 + h * 64); float a = 0.f;
#pragma unroll
                    for (int c = 0; c < 8; ++c) { const v4u w = kr[c]; a += q[8 * c + 0] * bflo(w.x) + q[8 * c + 1] * bfhi(w.x) + q[8 * c + 2] * bflo(w.y) + q[8 * c + 3] * bfhi(w.y)
                            + q[8 * c + 4] * bflo(w.z) + q[8 * c + 5] * bfhi(w.z) + q[8 * c + 6] * bflo(w.w) + q[8 * c + 7] * bfhi(w.w); }
                    v = a * 0.125f + bias[rel > 2047 ? 2047 : rel];
                }
                lg[sg][i] = v; mx = fmaxf(mx, v);
            }
        }
        mx = wave_max(mx);
        float psum = 0.f;
#pragma unroll
        for (int sg = 0; sg < 4; ++sg)
#pragma unroll
            for (int i = 0; i < 4; ++i) { const float p = (lg[sg][i] > -1.0e29f) ? __expf(lg[sg][i] - mx) : 0.f; lg[sg][i] = p; psum += p; }
        psum = wave_sum(psum);
        float o = 0.f;
#pragma unroll
        for (int sg = 0; sg < 4; ++sg) {
            const bool segv = (sg == 0) || (sg - 1 < qb);
            if (segv) {
#pragma unroll
                for (int i = 0; i < 4; ++i) {
                    const int kbase = kb[sg] * 256 + 64 * i;
                    if (sg == 0 && kbase > s) continue;
                    const bf16* vp = Vb + ((size_t)b * SEQ + kbase) * 512 + h * 64 + lane;
                    const float pv = lg[sg][i];
                    for (int l2 = 0; l2 < 64; ++l2) { const float pk = __shfl(pv, l2); o += pk * bf2f(vp[(size_t)l2 * 512]); }
                }
            }
        }
        YA[(size_t)t * 512 + h * 64 + lane] = (bf16)(pk2(o / psum, 0.f) & 0xffffu);
    }
}
DEVI void p4_gmlp_unit(int unit, const bf16* __restrict__ U, const bf16* __restrict__ GV, const float* __restrict__ lng, const float* __restrict__ lnb,
                       const float* __restrict__ ws_, const float* __restrict__ bs_, bf16* __restrict__ YG, unsigned char* lds, int tid) {
    bf16* vn = (bf16*)lds;
    const int wv = tid >> 6, lane = tid & 63;
    const size_t row0 = (size_t)unit * 128;
    {
        float gg[8], bb[8];
#pragma unroll
        for (int j = 0; j < 8; ++j) { gg[j] = lng[8 * lane + j]; bb[j] = lnb[8 * lane + j]; }
        for (int r = 0; r < 16; ++r) {
            const int tt = 16 * wv + r;
            const v4u w = *(const v4u*)(GV + (row0 + tt) * 512 + 8 * lane);
            float v[8] = {bflo(w.x), bfhi(w.x), bflo(w.y), bfhi(w.y), bflo(w.z), bfhi(w.z), bflo(w.w), bfhi(w.w)};
            float s = 0.f;
#pragma unroll
            for (int j = 0; j < 8; ++j) s += v[j];
            const float mu = wave_sum(s) * (1.0f / 512.0f);
            float q = 0.f;
#pragma unroll
            for (int j = 0; j < 8; ++j) { v[j] -= mu; q += v[j] * v[j]; }
            const float rs = rsqrtf(wave_sum(q) * (1.0f / 512.0f) + EPS);
#pragma unroll
            for (int j = 0; j < 8; ++j) v[j] = v[j] * rs * gg[j] + bb[j];
            v4u o; o.x = pk2(v[0], v[1]); o.y = pk2(v[2], v[3]); o.z = pk2(v[4], v[5]); o.w = pk2(v[6], v[7]);
            *(v4u*)(vn + tt * 512 + 8 * lane) = o;
        }
    }
    __syncthreads();
    {
        const int c = tid, g = wv;
        const float* wg = ws_ + (size_t)g * 128 * 128;
        for (int tb = 0; tb < 8; ++tb) {
            float wr0[16], wr1[16], acc[16];
#pragma unroll
            for (int i = 0; i < 16; ++i) { const int t = 16 * tb + i; const float a0 = wg[t * 128 + lane], a1 = wg[t * 128 + 64 + lane];
                wr0[i] = (lane <= t) ? a0 : 0.f; wr1[i] = (64 + lane <= t) ? a1 : 0.f; acc[i] = 0.f; }
            const int smax = 16 * tb + 15;
            const int e0 = smax < 63 ? smax : 63;
            for (int s = 0; s <= e0; ++s) { const float vv = bf2f(vn[s * 512 + c]);
#pragma unroll
                for (int i = 0; i < 16; ++i) acc[i] += __shfl(wr0[i], s) * vv; }
            for (int s = 64; s <= smax; ++s) { const float vv = bf2f(vn[s * 512 + c]);
#pragma unroll
                for (int i = 0; i < 16; ++i) acc[i] += __shfl(wr1[i], s - 64) * vv; }
#pragma unroll
            for (int i = 0; i < 16; ++i) { const int t = 16 * tb + i; const size_t o = (row0 + t) * 512 + c;
                const float y = bf2f(U[o]) * (acc[i] + bs_[g * 128 + t]);
                YG[o] = (bf16)(pk2(y, 0.f) & 0xffffu); }
        }
    }
    __syncthreads();
}

DEVI void p7_mid(const float* __restrict__ x, const bf16* __restrict__ Y, const float* __restrict__ post_g1, const float* __restrict__ pre_g2, const float* __restrict__ mod,
                 float* __restrict__ X1, bf16* __restrict__ H2, int gw, int nw, int lane) {
    for (int row = gw; row < NT; row += nw) {
        const int b = row >> 13; const float* mb = mod + b * 6144;
        float y[16], xv[16]; float ss = 0.f;
#pragma unroll
        for (int i = 0; i < 4; ++i) { const int d = 4 * lane + 256 * i; const uint2 w = *(const uint2*)(Y + (size_t)row * DM + d);
            y[4 * i + 0] = bflo(w.x); y[4 * i + 1] = bfhi(w.x); y[4 * i + 2] = bflo(w.y); y[4 * i + 3] = bfhi(w.y);
            const f32x4 xx = *(const f32x4*)(x + (size_t)row * DM + d); xv[4 * i + 0] = xx[0]; xv[4 * i + 1] = xx[1]; xv[4 * i + 2] = xx[2]; xv[4 * i + 3] = xx[3]; }
#pragma unroll
        for (int j = 0; j < 16; ++j) ss += y[j] * y[j];
        const float r1 = rsqrtf(wave_sum(ss) * (1.0f / DM) + EPS);
        float s2 = 0.f;
#pragma unroll
        for (int i = 0; i < 4; ++i) { const int d = 4 * lane + 256 * i; const f32x4 g1 = *(const f32x4*)(post_g1 + d), gt = *(const f32x4*)(mb + 2048 + d);
            f32x4 o;
#pragma unroll
            for (int j = 0; j < 4; ++j) { const float v = xv[4 * i + j] + gt[j] * (y[4 * i + j] * r1 * g1[j]); xv[4 * i + j] = v; o[j] = v; s2 += v * v; }
            *(f32x4*)(X1 + (size_t)row * DM + d) = o; }
        const float r2 = rsqrtf(wave_sum(s2) * (1.0f / DM) + EPS);
#pragma unroll
        for (int i = 0; i < 4; ++i) { const int d = 4 * lane + 256 * i; const f32x4 g2 = *(const f32x4*)(pre_g2 + d), sc = *(const f32x4*)(mb + 4096 + d), sh = *(const f32x4*)(mb + 3072 + d);
            float o[4];
#pragma unroll
            for (int j = 0; j < 4; ++j) o[j] = xv[4 * i + j] * r2 * g2[j] * (1.0f + sc[j]) + sh[j];
            uint2 w; w.x = pk2(o[0], o[1]); w.y = pk2(o[2], o[3]);
            *(uint2*)(H2 + (size_t)row * DM + d) = w; }
    }
}

DEVI unsigned f2ord(float f) { const unsigned u = __float_as_uint(f); return u ^ ((u >> 31) ? 0xFFFFFFFFu : 0x80000000u); }
DEVI float ord2f(unsigned u) { const unsigned b = (u & 0x80000000u) ? (u ^ 0x80000000u) : ~u; return __uint_as_float(b); }
#define INSERT16(L, key) do { unsigned _k = (key); _Pragma("unroll") for (int _i = 0; _i < 16; ++_i) { const unsigned _h = L[_i] > _k ? L[_i] : _k; _k = L[_i] > _k ? _k : L[_i]; L[_i] = _h; } } while (0)
DEVI void p9_route(const bf16* __restrict__ QP, const float* __restrict__ subk, uint2* __restrict__ RT, unsigned char* lds, int tid, int bid, int G) {
    float* skl = (float*)lds;
    unsigned char* ixs = lds + 65536 + tid * 32;
    for (int i = tid; i < 2 * 128 * 64; i += NTHR) skl[i] = subk[i];
    __syncthreads();
    for (int base = bid * NTHR; base < NT * NH; base += G * NTHR) {
        const int idx = base + tid, t = idx >> 3, h = idx & 7;
        unsigned L[2][16];
#pragma unroll
        for (int hf = 0; hf < 2; ++hf) {
            float q[64];
            { const v4u* qp = (const v4u*)(QP + (size_t)t * 1024 + h * 128 + hf * 64);
#pragma unroll
              for (int i = 0; i < 8; ++i) { const v4u w = qp[i]; q[8 * i + 0] = bflo(w.x); q[8 * i + 1] = bfhi(w.x); q[8 * i + 2] = bflo(w.y); q[8 * i + 3] = bfhi(w.y);
                  q[8 * i + 4] = bflo(w.z); q[8 * i + 5] = bfhi(w.z); q[8 * i + 6] = bflo(w.w); q[8 * i + 7] = bfhi(w.w); } }
#pragma unroll
            for (int i = 0; i < 16; ++i) L[hf][i] = 0u;
            for (int j = 0; j < 128; ++j) {
                const f32x4* kr = (const f32x4*)(skl + (hf * 128 + j) * 64); float s = 0.f;
#pragma unroll
                for (int d4 = 0; d4 < 16; ++d4) { const f32x4 kv = kr[d4]; s += q[4 * d4] * kv[0] + q[4 * d4 + 1] * kv[1] + q[4 * d4 + 2] * kv[2] + q[4 * d4 + 3] * kv[3]; }
                const unsigned key = (f2ord(s) & ~0x7Fu) | (unsigned)(127 - j);
                INSERT16(L[hf], key);
            }
        }
        float v1[16], v2[16];
#pragma unroll
        for (int i = 0; i < 16; ++i) { v1[i] = ord2f(L[0][i] & ~0x7Fu); v2[i] = ord2f(L[1][i] & ~0x7Fu); ixs[i] = (unsigned char)(127u - (L[0][i] & 0x7Fu)); ixs[16 + i] = (unsigned char)(127u - (L[1][i] & 0x7Fu)); }
        unsigned C[16];
#pragma unroll
        for (int i = 0; i < 16; ++i) C[i] = 0u;
#pragma unroll
        for (int a = 0; a < 16; ++a)
#pragma unroll
            for (int b = 0; b < 16; ++b)
                if ((a + 1) * (b + 1) <= 16) { const unsigned key = (f2ord(v1[a] + v2[b]) & ~0xFFu) | (unsigned)(255 - (a * 16 + b)); INSERT16(C, key); }
        const float m = ord2f(C[0] & ~0xFFu);
        float p[16]; float sum = 0.f;
#pragma unroll
        for (int k = 0; k < 16; ++k) { p[k] = __expf(ord2f(C[k] & ~0xFFu) - m); sum += p[k]; }
        const float inv = 1.0f / sum;
        uint2* out = RT + (size_t)t * 128 + h * 16;
#pragma unroll
        for (int k = 0; k < 16; ++k) { const unsigned code = 255u - (C[k] & 0xFFu); const unsigned e = (unsigned)ixs[code >> 4] * 128u + (unsigned)ixs[16 + (code & 15u)];
            out[k] = make_uint2(e, __float_as_uint(p[k] * inv)); }
    }
    __syncthreads();
}

DEVI void p10_peer(const bf16* __restrict__ H2, const uint2* __restrict__ RT, const bf16* __restrict__ PU, const bf16* __restrict__ PV, const float* __restrict__ post_g2,
                   const float* __restrict__ mod, float* __restrict__ OUT, int gw, int nw, int lane) {
    for (int t = gw; t < NT; t += nw) {
        const int b = t >> 13;
        float x[16];
        { const v4u* hp = (const v4u*)(H2 + (size_t)t * DM); const v4u a0 = hp[lane], a1 = hp[64 + lane];
          x[0] = bflo(a0.x); x[1] = bfhi(a0.x); x[2] = bflo(a0.y); x[3] = bfhi(a0.y); x[4] = bflo(a0.z); x[5] = bfhi(a0.z); x[6] = bflo(a0.w); x[7] = bfhi(a0.w);
          x[8] = bflo(a1.x); x[9] = bfhi(a1.x); x[10] = bflo(a1.y); x[11] = bfhi(a1.y); x[12] = bflo(a1.z); x[13] = bfhi(a1.z); x[14] = bflo(a1.w); x[15] = bfhi(a1.w); }
        float o[16];
#pragma unroll
        for (int j = 0; j < 16; ++j) o[j] = 0.f;
        const uint2* rt = RT + (size_t)t * 128;
        for (int p = 0; p < 128; p += 4) {
            v4u ua[4], ub[4], va[4], vb[4]; float gt[4];
#pragma unroll
            for (int k = 0; k < 4; ++k) { const uint2 eg = rt[p + k]; const unsigned e = eg.x; gt[k] = __uint_as_float(eg.y);
                const v4u* ur = (const v4u*)(PU + (size_t)e * 1024); ua[k] = ur[lane]; ub[k] = ur[64 + lane];
                const v4u* vr = (const v4u*)(PV + (size_t)e * 1024); va[k] = vr[lane]; vb[k] = vr[64 + lane]; }
#pragma unroll
            for (int k = 0; k < 4; ++k) {
                float d = x[0] * bflo(ua[k].x) + x[1] * bfhi(ua[k].x) + x[2] * bflo(ua[k].y) + x[3] * bfhi(ua[k].y) + x[4] * bflo(ua[k].z) + x[5] * bfhi(ua[k].z) + x[6] * bflo(ua[k].w) + x[7] * bfhi(ua[k].w)
                        + x[8] * bflo(ub[k].x) + x[9] * bfhi(ub[k].x) + x[10] * bflo(ub[k].y) + x[11] * bfhi(ub[k].y) + x[12] * bflo(ub[k].z) + x[13] * bfhi(ub[k].z) + x[14] * bflo(ub[k].w) + x[15] * bfhi(ub[k].w);
                d = wave_sum(d);
                const float w = gt[k] * gelu_tanh(d);
                o[0] += w * bflo(va[k].x); o[1] += w * bfhi(va[k].x); o[2] += w * bflo(va[k].y); o[3] += w * bfhi(va[k].y); o[4] += w * bflo(va[k].z); o[5] += w * bfhi(va[k].z); o[6] += w * bflo(va[k].w); o[7] += w * bfhi(va[k].w);
                o[8] += w * bflo(vb[k].x); o[9] += w * bfhi(vb[k].x); o[10] += w * bflo(vb[k].y); o[11] += w * bfhi(vb[k].y); o[12] += w * bflo(vb[k].z); o[13] += w * bfhi(vb[k].z); o[14] += w * bflo(vb[k].w); o[15] += w * bfhi(vb[k].w);
            }
        }
        float ss = 0.f;
#pragma unroll
        for (int j = 0; j < 16; ++j) ss += o[j] * o[j];
        const float r = rsqrtf(wave_sum(ss) * (1.0f / DM) + EPS);
        const float* mb = mod + b * 6144 + 5120;
#pragma unroll
        for (int hh = 0; hh < 2; ++hh)
#pragma unroll
            for (int q4 = 0; q4 < 2; ++q4) { const int d = 512 * hh + 8 * lane + 4 * q4; float* op = OUT + (size_t)t * DM + d;
                const f32x4 x1 = *(const f32x4*)op, g2 = *(const f32x4*)(post_g2 + d), gt2 = *(const f32x4*)(mb + d);
                f32x4 res;
#pragma unroll
                for (int j = 0; j < 4; ++j) res[j] = x1[j] + gt2[j] * (o[8 * hh + 4 * q4 + j] * r * g2[j]);
                *(f32x4*)op = res; }
    }
}

__global__ void __launch_bounds__(NTHR, 2) fwd_kernel(Args args) {
    extern __shared__ __attribute__((aligned(16))) unsigned char lds[];
    const int tid = threadIdx.x, lane = tid & 63, wave = __builtin_amdgcn_readfirstlane(tid >> 6);
    const int G = gridDim.x, bid = blockIdx.x;
    const int gw = __builtin_amdgcn_readfirstlane(bid * NWAVES + wave), nw = G * NWAVES;
    unsigned char* ws = args.ws;
    volatile LAS unsigned* MISC = (volatile LAS unsigned*)((LAS unsigned char*)lds + MISC_OFF);
    if (tid < 64) MISC[tid] = 0u;
    __syncthreads();
#if MK_ONE_LAUNCH
    XcdBarrier bar = xcd_barrier_post((unsigned*)(ws + WS_CTL) + 1024, MISC + 8);
#define GRID_BAR() xcd_barrier(bar)
#else
#define GRID_BAR() do { } while (0)
#endif
    const int lo = args.ph_lo, hi = args.ph_hi;
#define IN(k) (lo <= (k) && (k) < hi)
#define SEAM(k) do { if (IN(k) && IN((k) + 1)) GRID_BAR(); } while (0)

    float* MOD = (float*)(ws + WS_MOD); float* KM = (float*)(ws + WS_KM); float* BIAS = (float*)(ws + WS_BIAS);
    bf16* WIN = (bf16*)(ws + WS_WIN); bf16* WBA = (bf16*)(ws + WS_WBA); bf16* WBG = (bf16*)(ws + WS_WBG); bf16* WOUT = (bf16*)(ws + WS_WOUT); bf16* WQ = (bf16*)(ws + WS_WQ);
    bf16* PU = (bf16*)(ws + WS_PU); bf16* PV = (bf16*)(ws + WS_PV);
    bf16* H1 = (bf16*)(ws + WS_A); bf16* MERGED = H1; bf16* H2 = H1;
    bf16* Qb = (bf16*)(ws + WS_B); bf16* Kb = Qb + (size_t)NT * 512; bf16* Vb = Kb + (size_t)NT * 512;
    bf16* T1 = Qb; bf16* Yb = Qb; bf16* QP = Qb;
    bf16* Ub = (bf16*)(ws + WS_C); bf16* GVb = Ub + (size_t)NT * 512; uint2* RT = (uint2*)(ws + WS_C);
    bf16* GA = (bf16*)(ws + WS_D); bf16* GG = GA + (size_t)NT * 1024;
    bf16* YA = (bf16*)(ws + WS_E); bf16* YG = YA + (size_t)NT * 512;
    LAS unsigned char* ring = (LAS unsigned char*)lds;

    if (IN(0)) { p0_prologue(args, lds, tid, bid, G); }
    SEAM(0);
    if (IN(1)) { p1_prenorm(args.in[0], args.in[4], MOD, 0, 1024, H1, gw, nw, lane); }
    SEAM(1);
    if (IN(2)) {
        pg8::Gemm g{H1, WIN, NT, INW, DM}; pg8::StaticOrder S; S.init(NT, INW, G, bid);
        pg8::EpiIn E{Qb, Kb, Vb, Ub, GVb, GA, GG};
        pg8::gemm_phase<pg8::EpiIn, pg8::StaticOrder, true, true>(ring, g, S, E);
    }
    SEAM(2);
    if (IN(3)) { p3_kmean(Kb, KM, tid, bid, G); }
    SEAM(3);
    if (IN(4)) {
        for (int u = bid; u < NB * 64; u += G) p4_gmlp_unit(u, Ub, GVb, args.in[7], args.in[8], args.in[9], args.in[10], YG, lds, tid);
        p4_attn_simple(Qb, Kb, Vb, KM, BIAS, YA, gw, nw, lane);
    }
    SEAM(4);
    if (IN(5)) {
        { pg8::Gemm g{YA, WBA, NT, DM, AW}; pg8::StaticOrder S; S.init(NT, DM, G, bid); pg8::EpiGate E{GA, nullptr, T1};
          pg8::gemm_phase<pg8::EpiGate, pg8::StaticOrder, true, true>(ring, g, S, E); }
        { pg8::Gemm g{YG, WBG, NT, DM, GW}; pg8::StaticOrder S; S.init(NT, DM, G, bid); pg8::EpiGate E{GG, T1, MERGED};
          pg8::gemm_phase<pg8::EpiGate, pg8::StaticOrder, true, true>(ring, g, S, E); }
    }
    SEAM(5);
    if (IN(6)) {
        pg8::Gemm g{MERGED, WOUT, NT, DM, DM}; pg8::StaticOrder S; S.init(NT, DM, G, bid); pg8::EpiPlain E{Yb, DM};
        pg8::gemm_phase<pg8::EpiPlain, pg8::StaticOrder, true, true>(ring, g, S, E);
    }
    SEAM(6);
    if (IN(7)) { p7_mid(args.in[0], Yb, args.in[5], args.in[15], MOD, args.out, H2, gw, nw, lane); }
    SEAM(7);
    if (IN(8)) {
        pg8::Gemm g{H2, WQ, NT, DM, DM}; pg8::StaticOrder S; S.init(NT, DM, G, bid); pg8::EpiPlain E{QP, DM};
        pg8::gemm_phase<pg8::EpiPlain, pg8::StaticOrder, true, true>(ring, g, S, E);
    }
    SEAM(8);
    if (IN(9)) { p9_route(QP, args.in[18], RT, lds, tid, bid, G); }
    SEAM(9);
    if (IN(10)) { p10_peer(H2, RT, PU, PV, args.in[16], MOD, args.out, gw, nw, lane); }
#undef IN
#undef SEAM
}

extern "C" void kernel_launch(void* const* d_in, const int* in_sizes, int n_in, void* d_out, int out_size, void* d_ws, size_t ws_size, hipStream_t stream) {
    static int grid = 0;
    if (grid == 0) {
        if (n_in != 21 || out_size != NT * DM || ws_size < WS_END) { fprintf(stderr, "kernel_launch: unexpected shapes (n_in %d out %d ws %zu)\n", n_in, out_size, ws_size); grid = -1; return; }
        int dev = 0, cus = 0, per_cu = 0;
        if (hipGetDevice(&dev) != hipSuccess || hipDeviceGetAttribute(&cus, hipDeviceAttributeMultiprocessorCount, dev) != hipSuccess) { grid = -1; return; }
        if (hipFuncSetAttribute((const void*)fwd_kernel, hipFuncAttributeMaxDynamicSharedMemorySize, LDS_BYTES) != hipSuccess) { fprintf(stderr, "kernel_launch: hipFuncSetAttribute failed\n"); grid = -1; return; }
        if (hipOccupancyMaxActiveBlocksPerMultiprocessor(&per_cu, (const void*)fwd_kernel, NTHR, LDS_BYTES) != hipSuccess || per_cu < 1) { fprintf(stderr, "kernel_launch: occupancy query says %d\n", per_cu); (void)hipGetLastError(); per_cu = 1; }
        grid = cus;
    }
    if (grid < 0) return;
    (void)hipMemsetAsync((char*)d_ws + WS_CTL, 0, CTL_ZERO_BYTES, stream);
    Args a{};
    for (int i = 0; i < 21; ++i) a.in[i] = (const float*)d_in[i];
    a.out = (float*)d_out; a.ws = (unsigned char*)d_ws;
#if MK_ONE_LAUNCH
    a.ph_lo = 0; a.ph_hi = NPH;
    hipLaunchKernelGGL(fwd_kernel, dim3(grid), dim3(NTHR), LDS_BYTES, stream, a);
#else
    for (int p = 0; p < NPH; ++p) { a.ph_lo = p; a.ph_hi = p + 1; hipLaunchKernelGGL(fwd_kernel, dim3(grid), dim3(NTHR), LDS_BYTES, stream, a); }
#endif
}
```

```cpp
#include <hip/hip_runtime.h>
#include <cstdio>
#include <cstdint>
namespace pg8 {
#define PG8_LAS __attribute__((address_space(3)))
typedef unsigned short bf16_t;
typedef short bf16x8 __attribute__((ext_vector_type(8)));
typedef float f32x4 __attribute__((ext_vector_type(4)));
typedef unsigned u32x4 __attribute__((ext_vector_type(4)));
constexpr int BM = 256, BK = 64, HALF = 128, HTB = HALF * BK * 2  , STAGE_BYTES = 8 * HTB, NXCD = 8, WGM = 8;

__host__ __device__ __forceinline__ int lds_byte(int r, int c) { const int st = (r >> 4) * 2 + (c >> 5), rr = r & 15, cc = c & 31, ob = rr * 64 + cc * 2; return st * 1024 + (ob ^ (((ob >> 9) & 1) << 5)); }
__host__ __device__ __forceinline__ void stage_rc(int b, int& R, int& C) { const int st = b / 1024, sb = b % 1024, swz = sb ^ (((sb >> 9) & 1) << 5); R = (st >> 1) * 16 + swz / 64; C = (st & 1) * 32 + (swz % 64) / 2; }
__host__ __device__ __forceinline__ int perm32(int rho) { const int n = rho >> 4, i = rho & 15; return 8 * (i >> 2) + 4 * n + (i & 3); }

struct Unit { int pm, pn; };
struct Gemm { const bf16_t* A; const bf16_t* Bt; int M, N, K; };

struct StaticOrder {
    int nM, nN, nwg, G, c;
    __host__ __device__ void init(int M, int N, int G_, int c_) { nM = M / BM; nN = N / BM; nwg = nM * nN; G = G_; c = c_; }
    __host__ __device__ bool next(int i, Unit& u) const {
        const long L = (long)i * G + c; if (L >= nwg) return false;
        int wgid = (int)L; { const int q = nwg / NXCD, r = nwg % NXCD, xcd = wgid % NXCD, off = wgid / NXCD; wgid = (xcd < r ? xcd * (q + 1) : r * (q + 1) + (xcd - r) * q) + off; }
        const int nig = WGM * nN, gid = wgid / nig, fm = gid * WGM, gsz = (nM - fm) < WGM ? (nM - fm) : WGM;
        u.pm = fm + ((wgid % nig) % gsz); u.pn = (wgid % nig) / gsz; return true;
    }
    __device__ __forceinline__ void a_ready(const Unit&) const {}
    __device__ __forceinline__ void done(const Unit&) const {}
};

typedef __bf16 bf16x2_cv __attribute__((ext_vector_type(2)));
typedef float f32x2_cv __attribute__((ext_vector_type(2)));
__device__ __forceinline__ unsigned cvt_pk_bf16(float lo, float hi) { const f32x2_cv v = {lo, hi}; return __builtin_bit_cast(unsigned, __builtin_convertvector(v, bf16x2_cv)); }
__device__ __forceinline__ float bflo(unsigned u) { return __uint_as_float(u << 16); }
__device__ __forceinline__ float bfhi(unsigned u) { return __uint_as_float(u & 0xffff0000u); }
__device__ __forceinline__ float act_sigmoid(float x) { return __builtin_amdgcn_rcpf(1.0f + __builtin_amdgcn_exp2f(-1.4426950408889634f * x)); }
__device__ __forceinline__ float act_gelu(float x) { const float z = 1.5957691216057308f * (x + 0.044715f * x * x * x); return x * __builtin_amdgcn_rcpf(1.0f + __builtin_amdgcn_exp2f(-1.4426950408889634f * z)); }

struct RowStore {
    unsigned wofs, rofs; int r_, p_;
    __device__ __forceinline__ void init(PG8_LAS unsigned char* stg, int wr, int wc, int fr, int fq) {
        PG8_LAS unsigned char* sb = stg + (wr * 4 + wc) * 2048; const int l = fq * 16 + fr; r_ = l >> 2; p_ = l & 3;
        wofs = (unsigned)(size_t)(sb + fr * 64 + (((fq + (fr >> 2)) & 3) << 4)); rofs = (unsigned)(size_t)(sb + r_ * 64 + (((p_ + (r_ >> 2)) & 3) << 4));
    }
    template <int SLOT> __device__ __forceinline__ void get(const u32x4& g, u32x4& t) const {
        if constexpr (SLOT == 0) asm volatile("ds_write_b128 %1, %2\n\tds_read_b128 %0, %3" : "=&v"(t) : "v"(rofs), "v"(g), "v"(wofs));
        else asm volatile("ds_write_b128 %1, %2 offset:1024\n\tds_read_b128 %0, %3 offset:1024" : "=&v"(t) : "v"(rofs), "v"(g), "v"(wofs));
    }
    template <int SLOT> __device__ __forceinline__ void put(const u32x4& w, u32x4& t) const {
        if constexpr (SLOT == 0) asm volatile("ds_write_b128 %1, %2\n\tds_read_b128 %0, %3" : "=&v"(t) : "v"(wofs), "v"(w), "v"(rofs));
        else asm volatile("ds_write_b128 %1, %2 offset:1024\n\tds_read_b128 %0, %3 offset:1024" : "=&v"(t) : "v"(wofs), "v"(w), "v"(rofs));
    }
};
#define PG8_RS_WAIT(n, t) asm volatile("s_waitcnt lgkmcnt(" #n ")" : "+v"(t))
#define PG8_RS_EMIT(first, w, newptr) do { u32x4 t_; if (bj == 0) R.put<0>(w, t_); else R.put<1>(w, t_); \
        if (!(first)) { PG8_RS_WAIT(2, tprev); *(u32x4*)pprev = tprev; } tprev = t_; pprev = (newptr); } while (0)
#define PG8_RS_FLUSH() do { PG8_RS_WAIT(0, tprev); *(u32x4*)pprev = tprev; } while (0)

struct EpiIn {
    static constexpr bool PERM = true, AFTER_DRAIN = false, MIDK = false;
    bf16_t *Q, *Kk, *V, *U, *GV, *GA, *GG; float* KM; PG8_LAS unsigned char* stg;
    __device__ __forceinline__ void operator()(const f32x4 (&acc)[2][2][4][2], const Unit& u, int wr, int wc, int fr, int fq) const {
        const int pn = u.pn; bf16_t* base; int ldc, colt, act;
        if (pn < 2) { base = Q; ldc = 512; colt = pn * 256; act = 0; }
        else if (pn < 4) { base = Kk; ldc = 512; colt = (pn - 2) * 256; act = 0; }
        else if (pn < 6) { base = V; ldc = 512; colt = (pn - 4) * 256; act = 0; }
        else if (pn < 8) { base = U; ldc = 512; colt = (pn - 6) * 256; act = 1; }
        else if (pn < 10) { base = GV; ldc = 512; colt = (pn - 8) * 256; act = 1; }
        else if (pn < 14) { base = GA; ldc = 1024; colt = (pn - 10) * 256; act = 2; }
        else { base = GG; ldc = 1024; colt = (pn - 14) * 256; act = 2; }
        const int row0 = u.pm * BM + wr * 64 + fr, col0 = colt + wc * 32 + 8 * fq;
        if (pn == 2 || pn == 3) {
#pragma unroll
            for (int bj = 0; bj < 2; ++bj)
#pragma unroll
                for (int n = 0; n < 2; ++n) { f32x4 s = (f32x4){0.f, 0.f, 0.f, 0.f};
#pragma unroll
                    for (int ai = 0; ai < 2; ++ai)
#pragma unroll
                        for (int m = 0; m < 4; ++m) s += acc[ai][bj][m][n];
#pragma unroll
                    for (int j = 0; j < 4; ++j) { float t = s[j]; t += __shfl_xor(t, 1); t += __shfl_xor(t, 2); t += __shfl_xor(t, 4); t += __shfl_xor(t, 8); s[j] = t; }
                    if (fr == 0) { const int col = colt + bj * HALF + wc * 32 + 8 * fq + 4 * n;
                        float* kp = KM + ((size_t)(((u.pm >> 5) * 8 + (col >> 6)) * 32 + (u.pm & 31))) * 64 + (col & 63);
#pragma unroll
                        for (int j = 0; j < 4; ++j) atomicAdd(kp + j, s[j] * (1.0f / 256.0f)); } }
        }
        const float qs = pn < 2 ? 0.125f * 1.4426950408889634f : 1.0f;
        RowStore R; R.init(stg, wr, wc, fr, fq); bf16_t* pprev = nullptr; u32x4 tprev = (u32x4){0u, 0u, 0u, 0u};
        const int rowt0 = u.pm * BM + wr * 64 + R.r_, colw = colt + wc * 32 + 8 * R.p_;
#pragma unroll
        for (int ai = 0; ai < 2; ++ai)
#pragma unroll
            for (int m = 0; m < 4; ++m) {
#pragma unroll
                for (int bj = 0; bj < 2; ++bj) { f32x4 v0 = acc[ai][bj][m][0] * qs, v1 = acc[ai][bj][m][1] * qs;
                    u32x4 w; w.x = cvt_pk_bf16(v0[0], v0[1]); w.y = cvt_pk_bf16(v0[2], v0[3]); w.z = cvt_pk_bf16(v1[0], v1[1]); w.w = cvt_pk_bf16(v1[2], v1[3]);
                    PG8_RS_EMIT(ai + m + bj == 0, w, base + (size_t)(rowt0 + ai * HALF + m * 16) * ldc + colw + bj * HALF); } }
        PG8_RS_FLUSH();
    }
};
struct EpiGate {
    static constexpr bool PERM = true, AFTER_DRAIN = false, MIDK = false;
    const bf16_t* Gt; const bf16_t* Tin; bf16_t* O;
    __device__ __forceinline__ void operator()(const f32x4 (&acc)[2][2][4][2], const Unit& u, int wr, int wc, int fr, int fq) const {
        const int row0 = u.pm * BM + wr * 64 + fr, col0 = u.pn * BM + wc * 32 + 8 * fq;
#pragma unroll
        for (int ai = 0; ai < 2; ++ai)
#pragma unroll
            for (int m = 0; m < 4; ++m) { const size_t ro = (size_t)(row0 + ai * HALF + m * 16) * 1024 + col0;
#pragma unroll
                for (int bj = 0; bj < 2; ++bj) { const f32x4 v0 = acc[ai][bj][m][0], v1 = acc[ai][bj][m][1];
                    const u32x4 g = *(const u32x4*)(Gt + ro + bj * HALF);
                    float o[8];
                    o[0] = bflo(g.x) * v0[0]; o[1] = bfhi(g.x) * v0[1]; o[2] = bflo(g.y) * v0[2]; o[3] = bfhi(g.y) * v0[3];
                    o[4] = bflo(g.z) * v1[0]; o[5] = bfhi(g.z) * v1[1]; o[6] = bflo(g.w) * v1[2]; o[7] = bfhi(g.w) * v1[3];
                    if (Tin) { const u32x4 t = *(const u32x4*)(Tin + ro + bj * HALF);
                        o[0] += bflo(t.x); o[1] += bfhi(t.x); o[2] += bflo(t.y); o[3] += bfhi(t.y); o[4] += bflo(t.z); o[5] += bfhi(t.z); o[6] += bflo(t.w); o[7] += bfhi(t.w); }
                    u32x4 w; w.x = cvt_pk_bf16(o[0], o[1]); w.y = cvt_pk_bf16(o[2], o[3]); w.z = cvt_pk_bf16(o[4], o[5]); w.w = cvt_pk_bf16(o[6], o[7]);
                    *(u32x4*)(O + ro + bj * HALF) = w; } }
    }
};
struct EpiPlain {
    static constexpr bool PERM = true, AFTER_DRAIN = false, MIDK = false;
    bf16_t* O; int ldc; PG8_LAS unsigned char* stg;
    __device__ __forceinline__ void operator()(const f32x4 (&acc)[2][2][4][2], const Unit& u, int wr, int wc, int fr, int fq) const {
        RowStore R; R.init(stg, wr, wc, fr, fq); bf16_t* pprev = nullptr; u32x4 tprev = (u32x4){0u, 0u, 0u, 0u};
        const int rowt0 = u.pm * BM + wr * 64 + R.r_, colw = u.pn * BM + wc * 32 + 8 * R.p_;
#pragma unroll
        for (int ai = 0; ai < 2; ++ai)
#pragma unroll
            for (int m = 0; m < 4; ++m) {
#pragma unroll
                for (int bj = 0; bj < 2; ++bj) { const f32x4 v0 = acc[ai][bj][m][0], v1 = acc[ai][bj][m][1];
                    u32x4 w; w.x = cvt_pk_bf16(v0[0], v0[1]); w.y = cvt_pk_bf16(v0[2], v0[3]); w.z = cvt_pk_bf16(v1[0], v1[1]); w.w = cvt_pk_bf16(v1[2], v1[3]);
                    PG8_RS_EMIT(ai + m + bj == 0, w, O + (size_t)(rowt0 + ai * HALF + m * 16) * ldc + colw + bj * HALF); } }
        PG8_RS_FLUSH();
    }
};

struct EpiMerge {
    static constexpr bool PERM = true, AFTER_DRAIN = false, MIDK = true;
    const bf16_t* GA; const bf16_t* GG; bf16_t* O; PG8_LAS unsigned char* stg;
    __device__ __forceinline__ void mid(f32x4 (&acc)[2][2][4][2], const Unit& u, int wr, int wc, int fr, int fq) const {
        RowStore R; R.init(stg, wr, wc, fr, fq);
        int rowt = u.pm * BM + wr * 64 + R.r_, colw = u.pn * BM + wc * 32 + 8 * R.p_;
        asm volatile("" : "+v"(rowt), "+v"(colw));
        const bf16_t* pa = GA + (size_t)rowt * 1024 + colw; const bf16_t* pg = GG + (size_t)rowt * 1024 + colw;
        u32x4 ca[2], cg[2];
#pragma unroll
        for (int bj = 0; bj < 2; ++bj) { ca[bj] = *(const u32x4*)(pa + bj * HALF); cg[bj] = *(const u32x4*)(pg + bj * HALF); }
#pragma unroll
        for (int it = 0; it < 8; ++it) { const int ai = it >> 2, m = it & 3;
            u32x4 na[2], ng[2];
            if (it < 7) { const size_t ro = (size_t)(((it + 1) >> 2) * HALF + ((it + 1) & 3) * 16) * 1024;
#pragma unroll
                for (int bj = 0; bj < 2; ++bj) { na[bj] = *(const u32x4*)(pa + ro + bj * HALF); ng[bj] = *(const u32x4*)(pg + ro + bj * HALF); } }
#pragma unroll
            for (int bj = 0; bj < 2; ++bj) {
                u32x4 a, g; R.get<0>(ca[bj], a); R.get<1>(cg[bj], g);
                asm volatile("s_waitcnt lgkmcnt(0)" : "+v"(a), "+v"(g));
                f32x4 r0, r1;
                r0[0] = bflo(a.x) * __builtin_amdgcn_rcpf(fmaxf(bflo(g.x), 1e-30f)); r0[1] = bfhi(a.x) * __builtin_amdgcn_rcpf(fmaxf(bfhi(g.x), 1e-30f));
                r0[2] = bflo(a.y) * __builtin_amdgcn_rcpf(fmaxf(bflo(g.y), 1e-30f)); r0[3] = bfhi(a.y) * __builtin_amdgcn_rcpf(fmaxf(bfhi(g.y), 1e-30f));
                r1[0] = bflo(a.z) * __builtin_amdgcn_rcpf(fmaxf(bflo(g.z), 1e-30f)); r1[1] = bfhi(a.z) * __builtin_amdgcn_rcpf(fmaxf(bfhi(g.z), 1e-30f));
                r1[2] = bflo(a.w) * __builtin_amdgcn_rcpf(fmaxf(bflo(g.w), 1e-30f)); r1[3] = bfhi(a.w) * __builtin_amdgcn_rcpf(fmaxf(bfhi(g.w), 1e-30f));
                acc[ai][bj][m][0] = acc[ai][bj][m][0] * r0; acc[ai][bj][m][1] = acc[ai][bj][m][1] * r1;
            }
            if (it < 7) {
#pragma unroll
                for (int bj = 0; bj < 2; ++bj) { ca[bj] = na[bj]; cg[bj] = ng[bj]; } }
        }
        asm volatile("s_waitcnt vmcnt(0)" ::: "memory");
    }
    __device__ __forceinline__ void operator()(const f32x4 (&acc)[2][2][4][2], const Unit& u, int wr, int wc, int fr, int fq) const {
        RowStore R; R.init(stg, wr, wc, fr, fq);
        const int rowt = u.pm * BM + wr * 64 + R.r_, colw = u.pn * BM + wc * 32 + 8 * R.p_;
        const bf16_t* pg = GG + (size_t)rowt * 1024 + colw; bf16_t* po = O + (size_t)rowt * 1024 + colw;
        bf16_t* pprev = nullptr; u32x4 tprev = (u32x4){0u, 0u, 0u, 0u};
        u32x4 cg[16];
#pragma unroll
        for (int it = 0; it < 8; ++it)
#pragma unroll
            for (int bj = 0; bj < 2; ++bj) cg[2 * it + bj] = *(const u32x4*)(pg + (size_t)((it >> 2) * HALF + (it & 3) * 16) * 1024 + bj * HALF);
        asm volatile("s_waitcnt vmcnt(0)" ::: "memory");
#pragma unroll
        for (int it = 0; it < 8; ++it) { const int ai = it >> 2, m = it & 3; const size_t rc = (size_t)(ai * HALF + m * 16) * 1024;
#pragma unroll
            for (int bj = 0; bj < 2; ++bj) { const f32x4 v0 = acc[ai][bj][m][0], v1 = acc[ai][bj][m][1];
                u32x4 g; R.get<0>(cg[2 * it + bj], g);
                asm volatile("s_waitcnt lgkmcnt(0)" : "+v"(g), "+v"(tprev));
                if (it + bj > 0) *(u32x4*)pprev = tprev;
                u32x4 w; w.x = cvt_pk_bf16(bflo(g.x) * v0[0], bfhi(g.x) * v0[1]); w.y = cvt_pk_bf16(bflo(g.y) * v0[2], bfhi(g.y) * v0[3]);
                w.z = cvt_pk_bf16(bflo(g.z) * v1[0], bfhi(g.z) * v1[1]); w.w = cvt_pk_bf16(bflo(g.w) * v1[2], bfhi(g.w) * v1[3]);
                u32x4 t_; R.put<1>(w, t_); tprev = t_; pprev = po + rc + bj * HALF; }
        }
        PG8_RS_FLUSH();
    }
};


struct EpiIn8 {
    static constexpr bool PERM = true, AFTER_DRAIN = false, MIDK = false;
    bf16_t *V, *U, *GV, *GA, *GG; const float* rs; const float* cs; PG8_LAS unsigned char* stg;
    template <int ACT> __device__ __forceinline__ void body(const f32x4 (&acc)[2][2][4][2], const Unit& u, bf16_t* base, int ldc, int colt, int wr, int wc, int fr, int fq) const {
        const int row0 = u.pm * BM + wr * 64 + fr, ccol0 = u.pn * BM + wc * 32 + 8 * fq;
        f32x4 cv[2][2];
#pragma unroll
        for (int bj = 0; bj < 2; ++bj)
#pragma unroll
            for (int n = 0; n < 2; ++n) cv[bj][n] = *(const f32x4*)(cs + ccol0 + bj * HALF + 4 * n);
        float rsv[8];
#pragma unroll
        for (int i = 0; i < 8; ++i) rsv[i] = rs[row0 + (i >> 2) * HALF + (i & 3) * 16];
        asm volatile("s_waitcnt vmcnt(0)" : "+v"(rsv[0]), "+v"(rsv[1]), "+v"(rsv[2]), "+v"(rsv[3]), "+v"(rsv[4]), "+v"(rsv[5]), "+v"(rsv[6]), "+v"(rsv[7]), "+v"(cv[0][0]), "+v"(cv[0][1]), "+v"(cv[1][0]), "+v"(cv[1][1]) :: "memory");
        RowStore R; R.init(stg, wr, wc, fr, fq); bf16_t* pprev = nullptr; u32x4 tprev = (u32x4){0u, 0u, 0u, 0u};
        const int rowt0 = u.pm * BM + wr * 64 + R.r_, colw = colt + wc * 32 + 8 * R.p_;
        constexpr float C1 = -1.4426950408889634f * 1.5957691216057308f, C2 = C1 * 0.044715f;
#pragma unroll
        for (int ai = 0; ai < 2; ++ai)
#pragma unroll
            for (int m = 0; m < 4; ++m) { const float rsc = ACT == 2 ? rsv[ai * 4 + m] * -1.4426950408889634f : rsv[ai * 4 + m];
#pragma unroll
                for (int bj = 0; bj < 2; ++bj) { f32x4 v0 = acc[ai][bj][m][0] * cv[bj][0] * rsc, v1 = acc[ai][bj][m][1] * cv[bj][1] * rsc;
                    if constexpr (ACT == 1) {
#pragma unroll
                        for (int j = 0; j < 4; ++j) { const float x0 = v0[j], x1 = v1[j];
                            v0[j] = x0 * __builtin_amdgcn_rcpf(1.0f + __builtin_amdgcn_exp2f(x0 * __builtin_fmaf(x0 * x0, C2, C1)));
                            v1[j] = x1 * __builtin_amdgcn_rcpf(1.0f + __builtin_amdgcn_exp2f(x1 * __builtin_fmaf(x1 * x1, C2, C1))); } }
                    else if constexpr (ACT == 2) {
#pragma unroll
                        for (int j = 0; j < 4; ++j) { v0[j] = __builtin_amdgcn_rcpf(1.0f + __builtin_amdgcn_exp2f(v0[j])); v1[j] = __builtin_amdgcn_rcpf(1.0f + __builtin_amdgcn_exp2f(v1[j])); } }
                    u32x4 w; w.x = cvt_pk_bf16(v0[0], v0[1]); w.y = cvt_pk_bf16(v0[2], v0[3]); w.z = cvt_pk_bf16(v1[0], v1[1]); w.w = cvt_pk_bf16(v1[2], v1[3]);
                    PG8_RS_EMIT(ai + m + bj == 0, w, base + (size_t)(rowt0 + ai * HALF + m * 16) * ldc + colw + bj * HALF); } }
        PG8_RS_FLUSH();
    }
    __device__ __forceinline__ void operator()(const f32x4 (&acc)[2][2][4][2], const Unit& u, int wr, int wc, int fr, int fq) const {
        const int pn = u.pn;
        if (pn < 2) body<0>(acc, u, V, 512, pn * 256, wr, wc, fr, fq);
        else if (pn < 6) body<1>(acc, u, pn < 4 ? U : GV, 512, ((pn - 2) & 1) * 256, wr, wc, fr, fq);
        else body<2>(acc, u, pn < 10 ? GA : GG, 1024, ((pn - 6) & 3) * 256, wr, wc, fr, fq);
    }
};

struct EpiPlain8 {
    static constexpr bool PERM = true, AFTER_DRAIN = false, MIDK = false;
    bf16_t* O; int ldc; const float* rs; const float* cs; PG8_LAS unsigned char* stg;
    __device__ __forceinline__ void operator()(const f32x4 (&acc)[2][2][4][2], const Unit& u, int wr, int wc, int fr, int fq) const {
        const int row0 = u.pm * BM + wr * 64 + fr, ccol0 = u.pn * BM + wc * 32 + 8 * fq;
        f32x4 cv[2][2];
#pragma unroll
        for (int bj = 0; bj < 2; ++bj)
#pragma unroll
            for (int n = 0; n < 2; ++n) cv[bj][n] = *(const f32x4*)(cs + ccol0 + bj * HALF + 4 * n);
        float rsv[8];
#pragma unroll
        for (int i = 0; i < 8; ++i) rsv[i] = rs[row0 + (i >> 2) * HALF + (i & 3) * 16];
        asm volatile("s_waitcnt vmcnt(0)" : "+v"(rsv[0]), "+v"(rsv[1]), "+v"(rsv[2]), "+v"(rsv[3]), "+v"(rsv[4]), "+v"(rsv[5]), "+v"(rsv[6]), "+v"(rsv[7]), "+v"(cv[0][0]), "+v"(cv[0][1]), "+v"(cv[1][0]), "+v"(cv[1][1]) :: "memory");
        RowStore R; R.init(stg, wr, wc, fr, fq); bf16_t* pprev = nullptr; u32x4 tprev = (u32x4){0u, 0u, 0u, 0u};
        const int rowt0 = u.pm * BM + wr * 64 + R.r_, colw = u.pn * BM + wc * 32 + 8 * R.p_;
#pragma unroll
        for (int ai = 0; ai < 2; ++ai)
#pragma unroll
            for (int m = 0; m < 4; ++m) { const float rsc = rsv[ai * 4 + m];
#pragma unroll
                for (int bj = 0; bj < 2; ++bj) { const f32x4 v0 = acc[ai][bj][m][0] * cv[bj][0] * rsc, v1 = acc[ai][bj][m][1] * cv[bj][1] * rsc;
                    u32x4 w; w.x = cvt_pk_bf16(v0[0], v0[1]); w.y = cvt_pk_bf16(v0[2], v0[3]); w.z = cvt_pk_bf16(v1[0], v1[1]); w.w = cvt_pk_bf16(v1[2], v1[3]);
                    PG8_RS_EMIT(ai + m + bj == 0, w, O + (size_t)(rowt0 + ai * HALF + m * 16) * ldc + colw + bj * HALF); } }
        PG8_RS_FLUSH();
    }
};
typedef int i32x8 __attribute__((ext_vector_type(8)));
typedef short s16x16 __attribute__((ext_vector_type(16)));
template <bool F8> __device__ __forceinline__ void mma_blk(f32x4 (&acc)[4][2], const bf16x8 (&At)[4][2], const bf16x8 (&Bt)[2][2]) {
    __builtin_amdgcn_s_setprio(1);
    if constexpr (!F8) {
#pragma unroll
        for (int m = 0; m < 4; ++m)
#pragma unroll
            for (int n = 0; n < 2; ++n)
#pragma unroll
                for (int k = 0; k < 2; ++k) acc[m][n] = __builtin_amdgcn_mfma_f32_16x16x32_bf16(Bt[n][k], At[m][k], acc[m][n], 0, 0, 0);
    } else {
#pragma unroll
        for (int m = 0; m < 4; ++m)
#pragma unroll
            for (int n = 0; n < 2; ++n) {
                const i32x8 b = __builtin_bit_cast(i32x8, __builtin_shufflevector(Bt[n][0], Bt[n][1], 0, 1, 2, 3, 4, 5, 6, 7, 8, 9, 10, 11, 12, 13, 14, 15));
                const i32x8 a = __builtin_bit_cast(i32x8, __builtin_shufflevector(At[m][0], At[m][1], 0, 1, 2, 3, 4, 5, 6, 7, 8, 9, 10, 11, 12, 13, 14, 15));
                asm volatile("v_mfma_f32_16x16x128_f8f6f4 %0, %1, %2, %0" : "+v"(acc[m][n]) : "v"(b), "v"(a));
            }
    }
    __builtin_amdgcn_s_setprio(0);
}
template <class Epi, class Sched, bool ALIGN_EPI = false, bool SP2 = false, bool F8 = false>
__device__ __forceinline__ void gemm_phase(PG8_LAS unsigned char* lds, const Gemm g, const Sched& S, const Epi& E) {
    const int tid = threadIdx.x, wid = __builtin_amdgcn_readfirstlane(tid >> 6), lane = tid & 63, wr = wid >> 2, wc = wid & 3, fr = lane & 15, fq = lane >> 4;
    const int K = g.K, nt = K / BK;
    unsigned voffA[2], voffB[2];
#pragma unroll
    for (int i = 0; i < 2; ++i) { int R, C; stage_rc(tid * 16 + i * 8192, R, C); const int Rb = Epi::PERM ? ((R & ~31) + perm32(R & 31)) : R;
        voffA[i] = (unsigned)(R * K + C) * 2u; voffB[i] = (unsigned)(Rb * K + C) * 2u; }
    const size_t kstep = (size_t)(BK * 2);
    const size_t hstep = (size_t)HALF * K * 2;
    const size_t tstep = 2 * hstep;
    const unsigned ldsw = (unsigned)wid * 1024u;
    const int aoff = lds_byte(wr * 64 + fr, fq * 8), boff = lds_byte(wc * 32 + fr, fq * 8);
#define PG8_SA(b, h) (((b) * 2 + (h)) * HTB)
#define PG8_SB(b, h) ((4 + (b) * 2 + (h)) * HTB)
#define PG8_STAGE(bufoff, gbase, voff) do { _Pragma("unroll") for (int _i = 0; _i < 2; ++_i) \
        __builtin_amdgcn_global_load_lds((const unsigned*)((const char*)(gbase) + (voff)[_i]), (PG8_LAS unsigned*)(lds + (bufoff) + ldsw + _i * 8192), 16, 0, 0); } while (0)
#define PG8_LDA(dst, b, h) do { _Pragma("unroll") for (int m = 0; m < 4; ++m) _Pragma("unroll") for (int k = 0; k < 2; ++k) dst[m][k] = *(const PG8_LAS bf16x8*)(lds + PG8_SA(b, h) + aoff + m * 2048 + k * 1024); } while (0)
#define PG8_LDB(dst, b, h) do { _Pragma("unroll") for (int n = 0; n < 2; ++n) _Pragma("unroll") for (int k = 0; k < 2; ++k) dst[n][k] = *(const PG8_LAS bf16x8*)(lds + PG8_SB(b, h) + boff + n * 2048 + k * 1024); } while (0)
#define PG8_MMA(ai, bj, At, Bt) mma_blk<F8>(acc[ai][bj], At, Bt)
#define PG8_WAIT_V(n) asm volatile("s_waitcnt vmcnt(" #n ")" ::: "memory")
#define PG8_WAIT_L(n) asm volatile("s_waitcnt lgkmcnt(" #n ")" ::: "memory")
#define PG8_BAR __builtin_amdgcn_s_barrier()
#define PG8_SCHED __builtin_amdgcn_sched_barrier(0)
    Unit cur, nxt; int ui = 0;
    if (!S.next(0, cur)) return;
    f32x4 acc[2][2][4][2];
#pragma unroll
    for (int a = 0; a < 2; ++a)
#pragma unroll
        for (int b = 0; b < 2; ++b)
#pragma unroll
            for (int m = 0; m < 4; ++m)
#pragma unroll
                for (int n = 0; n < 2; ++n) acc[a][b][m][n] = (f32x4){0.f, 0.f, 0.f, 0.f};
    bf16x8 At[4][2], B0[2][2], B1[2][2];
    const char* cA = (const char*)g.A + (size_t)cur.pm * tstep; const char* cB = (const char*)g.Bt + (size_t)cur.pn * tstep;
    S.a_ready(cur);
    if constexpr (SP2) {
        PG8_STAGE(PG8_SB(0, 0), cB, voffB); PG8_STAGE(PG8_SB(0, 1), cB + hstep, voffB); PG8_STAGE(PG8_SA(0, 0), cA, voffA); PG8_STAGE(PG8_SA(0, 1), cA + hstep, voffA);
        if (wr == 1) PG8_BAR;
        PG8_WAIT_V(2); PG8_BAR;
        PG8_STAGE(PG8_SB(1, 0), cB + kstep, voffB); PG8_STAGE(PG8_SA(1, 0), cA + kstep, voffA); PG8_STAGE(PG8_SB(1, 1), cB + hstep + kstep, voffB);
        PG8_WAIT_V(6); PG8_BAR;
    } else {
        PG8_STAGE(PG8_SB(0, 0), cB, voffB); PG8_STAGE(PG8_SA(0, 0), cA, voffA); PG8_STAGE(PG8_SB(0, 1), cB + hstep, voffB); PG8_STAGE(PG8_SA(0, 1), cA + hstep, voffA);
        if (wr == 1) PG8_BAR;
        PG8_WAIT_V(4); PG8_BAR;
        PG8_STAGE(PG8_SB(1, 0), cB + kstep, voffB); PG8_STAGE(PG8_SA(1, 0), cA + kstep, voffA); PG8_STAGE(PG8_SB(1, 1), cB + hstep + kstep, voffB);
        PG8_WAIT_V(6); PG8_BAR;
    }
    for (;;) {
        const bool has_next = S.next(ui + 1, nxt);
        const char* nA = has_next ? (const char*)g.A + (size_t)nxt.pm * tstep : cA; const char* nB = has_next ? (const char*)g.Bt + (size_t)nxt.pn * tstep : cB;
#pragma unroll 1
        for (int t = 0; t < nt; t += 2) {
            const bool last = (t == nt - 2);
            const char* a1 = cA + (size_t)(t + 1) * kstep;
            const char* a2 = last ? nA : cA + (size_t)(t + 2) * kstep; const char* b2 = last ? nB : cB + (size_t)(t + 2) * kstep;
            const char* a3 = a2 + kstep; const char* b3 = b2 + kstep;
            if (last && has_next) S.a_ready(nxt);
            if constexpr (SP2) {
            PG8_LDB(B0, 0, 0); PG8_LDB(B1, 0, 1); PG8_SCHED; PG8_LDA(At, 0, 0); PG8_STAGE(PG8_SA(1, 1), a1 + hstep, voffA);
            PG8_WAIT_V(8); PG8_WAIT_L(0); PG8_BAR; PG8_MMA(0, 0, At, B0); PG8_MMA(0, 1, At, B1); PG8_BAR; PG8_SCHED;
            PG8_LDA(At, 0, 1); PG8_STAGE(PG8_SB(0, 0), b2, voffB); PG8_STAGE(PG8_SB(0, 1), b2 + hstep, voffB); PG8_STAGE(PG8_SA(0, 0), a2, voffA);
            PG8_WAIT_V(8); PG8_WAIT_L(0); PG8_BAR; PG8_MMA(1, 0, At, B0); PG8_MMA(1, 1, At, B1); PG8_BAR; PG8_SCHED;
            PG8_LDB(B0, 1, 0); PG8_LDB(B1, 1, 1); PG8_SCHED; PG8_LDA(At, 1, 0); PG8_STAGE(PG8_SA(0, 1), a2 + hstep, voffA);
            PG8_WAIT_V(8); PG8_WAIT_L(0); PG8_BAR; PG8_MMA(0, 0, At, B0); PG8_MMA(0, 1, At, B1); PG8_BAR; PG8_SCHED;
            PG8_LDA(At, 1, 1); PG8_STAGE(PG8_SB(1, 0), b3, voffB); PG8_STAGE(PG8_SB(1, 1), b3 + hstep, voffB); PG8_STAGE(PG8_SA(1, 0), a3, voffA);
            PG8_WAIT_V(8); PG8_WAIT_L(0); PG8_BAR; PG8_MMA(1, 0, At, B0); PG8_MMA(1, 1, At, B1); PG8_BAR; PG8_SCHED;
            } else {
            PG8_LDB(B0, 0, 0); PG8_SCHED; PG8_LDA(At, 0, 0); PG8_STAGE(PG8_SA(1, 1), a1 + hstep, voffA);
            PG8_WAIT_L(8); PG8_BAR; PG8_WAIT_L(0); PG8_MMA(0, 0, At, B0); PG8_BAR; PG8_SCHED;
            PG8_LDB(B1, 0, 1); PG8_STAGE(PG8_SB(0, 0), b2, voffB);
            PG8_BAR; PG8_WAIT_L(0); PG8_MMA(0, 1, At, B1); PG8_BAR;
            PG8_LDA(At, 0, 1); PG8_STAGE(PG8_SA(0, 0), a2, voffA);
            PG8_BAR; PG8_WAIT_L(0); PG8_MMA(1, 0, At, B0); PG8_BAR; PG8_SCHED;
            PG8_STAGE(PG8_SB(0, 1), b2 + hstep, voffB);
            PG8_WAIT_V(6); PG8_BAR; PG8_MMA(1, 1, At, B1); PG8_BAR;
            PG8_LDB(B0, 1, 0); PG8_SCHED; PG8_LDA(At, 1, 0); PG8_STAGE(PG8_SA(0, 1), a2 + hstep, voffA);
            PG8_WAIT_L(8); PG8_BAR; PG8_WAIT_L(0); PG8_MMA(0, 0, At, B0); PG8_BAR; PG8_SCHED;
            PG8_LDB(B1, 1, 1); PG8_STAGE(PG8_SB(1, 0), b3, voffB);
            PG8_BAR; PG8_WAIT_L(0); PG8_MMA(0, 1, At, B1); PG8_BAR;
            PG8_LDA(At, 1, 1); PG8_STAGE(PG8_SA(1, 0), a3, voffA);
            PG8_BAR; PG8_WAIT_L(0); PG8_MMA(1, 0, At, B0); PG8_BAR; PG8_SCHED;
            PG8_STAGE(PG8_SB(1, 1), b3 + hstep, voffB);
            PG8_WAIT_V(6); PG8_BAR; PG8_MMA(1, 1, At, B1); PG8_BAR;
            }
            if constexpr (Epi::MIDK) { if (t + 2 == nt / 2) E.mid(acc, cur, wr, wc, fr, fq); }
        }
        if constexpr (F8) asm volatile("s_nop 15\n\ts_nop 15" ::: "memory");
        if constexpr (ALIGN_EPI) { if (wr == 0) PG8_BAR; }
        if constexpr (!Epi::AFTER_DRAIN) { E(acc, cur, wr, wc, fr, fq); S.done(cur); }
        if (!has_next) break;
#pragma unroll
        for (int a = 0; a < 2; ++a)
#pragma unroll
            for (int b = 0; b < 2; ++b)
#pragma unroll
                for (int m = 0; m < 4; ++m)
#pragma unroll
                    for (int n = 0; n < 2; ++n) acc[a][b][m][n] = (f32x4){0.f, 0.f, 0.f, 0.f};
        cur = nxt; cA = nA; cB = nB; ++ui;
        if constexpr (ALIGN_EPI) { if (wr == 1) PG8_BAR; }
    }
    PG8_WAIT_V(0);
    if constexpr (!ALIGN_EPI) { if (wr == 0) PG8_BAR; }
    PG8_BAR;
    if constexpr (Epi::AFTER_DRAIN) { E.fused(acc, cur, wr, wc, fr, fq, lds, wid, lane); S.done(cur); }
#undef PG8_SA
#undef PG8_SB
#undef PG8_STAGE
#undef PG8_LDA
#undef PG8_LDB
#undef PG8_MMA
#undef PG8_WAIT_V
#undef PG8_WAIT_L
#undef PG8_BAR
#undef PG8_SCHED
}
}

constexpr int NB = 4, SEQ = 8192, DM = 1024, NT = NB * SEQ;
constexpr int NH = 8, HD = 64, AW = 512, GW = 512, INW = 4608;
constexpr int NEXP = 16384;
constexpr float EPS = 1e-6f;
constexpr int NWAVES = 8, NTHR = 512;

#ifndef MK_ONE_LAUNCH
#define MK_ONE_LAUNCH 1
#endif
constexpr int NPH = 15;

constexpr size_t MiB = 1u << 20;
constexpr size_t WS_CTL = 0, CTL_ZERO_BYTES = 64 * 1024;
constexpr size_t WS_MOD = 1 * MiB;
constexpr size_t WS_KM = 1 * MiB + 128 * 1024;
constexpr size_t WS_BIAS = 1 * MiB + 512 * 1024;
constexpr size_t WS_WIN = 4 * MiB;
constexpr size_t WS_WIN8 = 6 * MiB;
constexpr size_t WS_WIN8S = 10 * MiB;
constexpr size_t WS_H8 = 436 * MiB;
constexpr size_t WS_HS = 2 * MiB + 262144;
constexpr size_t WS_WBA = 13 * MiB, WS_WBG = 14 * MiB, WS_WOUT = 15 * MiB, WS_WQ = 17 * MiB;
constexpr size_t WS_PU = 20 * MiB, WS_PV = 36 * MiB;
constexpr size_t WS_USC = 52 * MiB, WS_VSC = 52 * MiB + 65536;
constexpr size_t WS_A = 84 * MiB;
constexpr size_t WS_B = 148 * MiB;
constexpr size_t WS_C = 244 * MiB;
constexpr size_t WS_D = 308 * MiB;
constexpr size_t WS_E = 436 * MiB;
constexpr size_t WS_QP = 212 * MiB;
constexpr size_t WS_PART = 276 * MiB;
constexpr size_t WS_PW = 404 * MiB;
constexpr size_t WS_EID = 420 * MiB;
constexpr size_t WS_GATE = 428 * MiB;
constexpr size_t WS_XH = 444 * MiB, WS_XL = 476 * MiB;
constexpr size_t WS_XSC = 2 * MiB;
constexpr size_t WS_END = 508 * MiB;

constexpr int RING_BYTES = 131072;
constexpr int MISC_OFF = 155648;
constexpr int LDS_BYTES = 159744;

#define GAS __attribute__((address_space(1)))
#define LAS __attribute__((address_space(3)))
typedef unsigned short bf16;
typedef unsigned v4u __attribute__((ext_vector_type(4)));
typedef float f32x4 __attribute__((ext_vector_type(4)));
#define DEVI __device__ __forceinline__
DEVI float bf2f(bf16 v) { return __uint_as_float(((unsigned)v) << 16); }
DEVI float bflo(unsigned u) { return __uint_as_float(u << 16); }
DEVI float bfhi(unsigned u) { return __uint_as_float(u & 0xffff0000u); }
DEVI unsigned pk2(float lo, float hi) { unsigned r; asm volatile("s_nop 0\n\tv_cvt_pk_bf16_f32 %0, %1, %2" : "=v"(r) : "v"(lo), "v"(hi)); return r; }
DEVI float wave_sum(float v) {
#pragma unroll
    for (int o = 32; o > 0; o >>= 1) v += __shfl_xor(v, o);
    return v; }
DEVI float wave_max(float v) {
#pragma unroll
    for (int o = 32; o > 0; o >>= 1) v = fmaxf(v, __shfl_xor(v, o));
    return v; }
DEVI float gelu_tanh(float x) { return pg8::act_gelu(x); }

#define XB_TMO      128
#define XB_XCNT(j)  (256  + 64 * (j))
#define XB_XSUB(j)  (1280 + 64 * (j))
#define XB_XGEN(j)  (2304 + 64 * (j))
#define XB_TOP      3328
#define XB_TOPGEN   3392
#define XCD_BAR_WORDS 3456
#define XB_SPIN_CAP (1u << 18)

__device__ __forceinline__ unsigned xb_ld(unsigned* p)              { return __hip_atomic_load(p, __ATOMIC_RELAXED, __HIP_MEMORY_SCOPE_AGENT); }
__device__ __forceinline__ unsigned xb_add(unsigned* p, unsigned v) { return __hip_atomic_fetch_add(p, v, __ATOMIC_RELAXED, __HIP_MEMORY_SCOPE_AGENT); }
__device__ __forceinline__ unsigned xb_xcc_id() { return (unsigned)__builtin_amdgcn_s_getreg((3 << 11) | 20) & 0xFu; }
#define XB_SPIN(cond, bar) do { unsigned _sp = 0; while (cond) { __builtin_amdgcn_s_sleep(1); \
    if ((++_sp & 255u) == 0u) { if (xb_ld(&(bar)[XB_TMO])) break; if (_sp > XB_SPIN_CAP) { atomicAdd(&(bar)[XB_TMO], 1u); break; } } } } while (0)

struct XcdBarrier {
    unsigned* bar; unsigned x;
    volatile LAS unsigned* st;
};

__device__ __forceinline__ XcdBarrier xcd_barrier_post(unsigned* bar, volatile LAS unsigned* st) {
    XcdBarrier b; b.bar = bar; b.x = xb_xcc_id(); b.st = st;
    if (threadIdx.x == 0) (void)xb_add(&bar[XB_XCNT(b.x)], 1u);
    return b;
}
__device__ __forceinline__ void xcd_barrier_complete(unsigned* bar, unsigned x, unsigned& nloc, unsigned& nx) {
    const unsigned G = gridDim.x * gridDim.y * gridDim.z;
    unsigned sum, cnt, mine, sp = 0u;
    for (;;) {
        sum = 0u; cnt = 0u; mine = 0u;
#pragma unroll
        for (unsigned j = 0; j < 16; ++j) { const unsigned c = xb_ld(&bar[XB_XCNT(j)]); sum += c; cnt += (c > 0u) ? 1u : 0u; mine = (j == x) ? c : mine; }
        if (sum == G) break;
        __builtin_amdgcn_s_sleep(1);
        if ((++sp & 255u) == 0u) { if (xb_ld(&bar[XB_TMO])) break; if (sp > XB_SPIN_CAP) { atomicAdd(&bar[XB_TMO], 1u); break; } }
    }
    nloc = mine > 0u ? mine : 1u; nx = cnt > 0u ? cnt : 1u;
}

__device__ __forceinline__ void xcd_barrier(const XcdBarrier& b) {
    asm volatile("s_waitcnt vmcnt(0)" ::: "memory");
    __syncthreads();
    if (threadIdx.x == 0) {
        unsigned* bar = b.bar;
        __builtin_amdgcn_s_waitcnt(0);
        unsigned nloc = b.st[0], nx = b.st[1];
        if (nloc == 0u) { xcd_barrier_complete(bar, b.x, nloc, nx); b.st[0] = nloc; b.st[1] = nx; }
        const unsigned old = xb_add(&bar[XB_XSUB(b.x)], 1u);
        const unsigned gen = old / nloc;
        if (old + 1u == (gen + 1u) * nloc) {
            __builtin_amdgcn_fence(__ATOMIC_RELEASE, "agent");
            asm volatile("s_waitcnt vmcnt(0)" ::: "memory");
            const unsigned og = xb_add(&bar[XB_TOP], 1u);
            const unsigned tg = og / nx;
            if (og + 1u == (tg + 1u) * nx) xb_add(&bar[XB_TOPGEN], 1u);
            else XB_SPIN(xb_ld(&bar[XB_TOPGEN]) == tg, bar);
            __builtin_amdgcn_fence(__ATOMIC_ACQUIRE, "agent");
            xb_add(&bar[XB_XGEN(b.x)], 1u);
            asm volatile("s_waitcnt vmcnt(0)" ::: "memory");
        } else {
            XB_SPIN(xb_ld(&bar[XB_XGEN(b.x)]) == gen, bar);
            __builtin_amdgcn_fence(__ATOMIC_ACQUIRE, "agent");
            asm volatile("s_waitcnt vmcnt(0)" ::: "memory");
        }
    }
    __syncthreads();
}
struct Args { const float* in[21]; float* out; unsigned char* ws; int ph_lo, ph_hi; };

DEVI void p0_transpose_tile(const float* __restrict__ W, int K, int N, bf16* __restrict__ WT, int tk, int tn, float* tile, int tid, int ldk = 0, int koff = 0) {
    if (ldk == 0) ldk = K;
    const int k0 = tk * 64, n0 = tn * 64;
    { const int r = tid >> 4, c4 = (tid & 15) * 4;
#pragma unroll
      for (int hh = 0; hh < 2; ++hh) { const int rr = r + 32 * hh; const f32x4 v = *(const f32x4*)(W + (size_t)(k0 + rr) * N + n0 + c4);
          tile[rr * 65 + c4 + 0] = v[0]; tile[rr * 65 + c4 + 1] = v[1]; tile[rr * 65 + c4 + 2] = v[2]; tile[rr * 65 + c4 + 3] = v[3]; } }
    __syncthreads();
    { const int n = tid >> 3, kc = (tid & 7) * 8; float v[8];
#pragma unroll
      for (int j = 0; j < 8; ++j) v[j] = tile[(kc + j) * 65 + n];
      v4u w; w.x = pk2(v[0], v[1]); w.y = pk2(v[2], v[3]); w.z = pk2(v[4], v[5]); w.w = pk2(v[6], v[7]);
      *(v4u*)(WT + (size_t)(n0 + n) * ldk + koff + k0 + kc) = w; }
    __syncthreads();
}
DEVI int t5_bucket(int rel) {
    const int n = rel < 0 ? 0 : rel;
    if (n < 16) return n;
    int b = 16;
    b = n >= 22 ? 17 : b; b = n >= 30 ? 18 : b; b = n >= 40 ? 19 : b; b = n >= 54 ? 20 : b; b = n >= 73 ? 21 : b; b = n >= 99 ? 22 : b; b = n >= 134 ? 23 : b; b = n >= 182 ? 24 : b;
    b = n >= 246 ? 25 : b; b = n >= 332 ? 26 : b; b = n >= 450 ? 27 : b; b = n >= 609 ? 28 : b; b = n >= 825 ? 29 : b; b = n >= 1117 ? 30 : b; b = n >= 1513 ? 31 : b;
    return b;
}
DEVI void p0_fp8_strip(const float* __restrict__ W, int ldw, int c0, unsigned char* __restrict__ dst, float* __restrict__ dsc, int r0, unsigned char* lds, int tid) {
    unsigned char* t8 = (unsigned char*)lds;
    unsigned* cm = (unsigned*)(lds + 16 * 1040);
    if (tid < 16) cm[tid] = 0u;
    const int kq = tid >> 2, c4 = (tid & 3) * 4;
    f32x4 v[8];
#pragma unroll
    for (int j = 0; j < 8; ++j) v[j] = *(const f32x4*)(W + (size_t)(kq + 128 * j) * ldw + c0 + c4);
    __syncthreads();
    f32x4 m = {0.f, 0.f, 0.f, 0.f};
#pragma unroll
    for (int j = 0; j < 8; ++j)
#pragma unroll
        for (int c = 0; c < 4; ++c) m[c] = fmaxf(m[c], fabsf(v[j][c]));
#pragma unroll
    for (int off = 4; off < 64; off <<= 1)
#pragma unroll
        for (int c = 0; c < 4; ++c) m[c] = fmaxf(m[c], __shfl_xor(m[c], off));
    if ((tid & 63) < 4) {
#pragma unroll
        for (int c = 0; c < 4; ++c) atomicMax(&cm[c4 + c], __float_as_uint(m[c])); }
    __syncthreads();
    float inv[4];
#pragma unroll
    for (int c = 0; c < 4; ++c) inv[c] = 224.0f / fmaxf(__uint_as_float(cm[c4 + c]), 1e-30f);
    if (tid < 16) dsc[r0 + tid] = fmaxf(__uint_as_float(cm[tid]), 1e-30f) * (1.0f / 224.0f);
#pragma unroll
    for (int j = 0; j < 8; ++j)
#pragma unroll
        for (int c = 0; c < 4; ++c) { const int p = __builtin_amdgcn_cvt_pk_fp8_f32(v[j][c] * inv[c], 0.f, 0, false); t8[(c4 + c) * 1040 + kq + 128 * j] = (unsigned char)(p & 0xff); }
    __syncthreads();
    { const int n = tid >> 5, kb = (tid & 31) * 32; const v4u q0 = *(const v4u*)(t8 + n * 1040 + kb), q1 = *(const v4u*)(t8 + n * 1040 + kb + 16);
      unsigned char* d = dst + (size_t)(r0 + n) * 1024 + kb; *(v4u*)d = q0; *(v4u*)(d + 16) = q1; }
    __syncthreads();
}
DEVI void p0_prologue(const Args& a, unsigned char* lds, int tid, int bid, int G) {
    unsigned char* ws = a.ws;
    float* tile = (float*)lds;
    float* silu = (float*)(lds + 32768);
    float* part = (float*)(lds + 49152);
    constexpr int N_WIN = 16 * 16 + 224, N_WB = 8 * 16, N_SQ = 16 * 16;
    constexpr int I1 = N_WIN, I2 = I1 + N_WB, I3 = I2 + N_WB, I4 = I3 + N_SQ, I5 = I4 + 64, I6 = I5 + 96;
    bool have_silu = false;
    for (int it = bid; it < I6; it += G) {
        if (it < 256) { p0_transpose_tile(a.in[6], 1024, INW, (bf16*)(ws + WS_WIN), it / 16, it % 16, tile, tid); }
        else if (it < I1) { const int j = it - 256; p0_fp8_strip(a.in[6], INW, 1024 + 16 * j, ws + WS_WIN8, (float*)(ws + WS_WIN8S), 16 * j, lds, tid); }
        else if (it < I2) { const int j = it - I1; p0_transpose_tile(a.in[12], 512, 1024, (bf16*)(ws + WS_WBA), j / 16, j % 16, tile, tid, 1024, 0); }
        else if (it < I3) { const int j = it - I2; p0_transpose_tile(a.in[13], 512, 1024, (bf16*)(ws + WS_WBA), j / 16, j % 16, tile, tid, 1024, 512); }
        else if (it < I4) { const int j = it - I3; p0_transpose_tile(a.in[14], 1024, 1024, (bf16*)(ws + WS_WOUT), j / 16, j % 16, tile, tid); }
        else if (it < I5) { const int j = it - I4; p0_fp8_strip(a.in[17], 1024, 16 * j, ws + WS_WQ, (float*)(ws + WS_WQ + MiB), 16 * j, lds, tid); }
        else {
            const int i = it - I5;
            if (!have_silu) { for (int idx = tid; idx < 4096; idx += NTHR) { const float c = a.in[1][idx]; silu[idx] = c / (1.0f + expf(-c)); } have_silu = true; }
            __syncthreads();
            const int w = tid >> 6, l = tid & 63, j = 64 * i + l;
            float acc[4] = {0.f, 0.f, 0.f, 0.f};
            const float* aw = a.in[2];
#pragma unroll 1
            for (int k0 = 128 * w; k0 < 128 * w + 128; k0 += 32) {
                float wv[32];
#pragma unroll
                for (int u = 0; u < 32; ++u) wv[u] = aw[(size_t)(k0 + u) * 6144 + j];
#pragma unroll
                for (int u = 0; u < 32; ++u)
#pragma unroll
                    for (int b = 0; b < 4; ++b) acc[b] += silu[b * 1024 + k0 + u] * wv[u];
            }
#pragma unroll
            for (int b = 0; b < 4; ++b) part[(w * 4 + b) * 64 + l] = acc[b];
            __syncthreads();
            if (tid < 256) { const int b = tid >> 6; float s = a.in[3][j];
#pragma unroll
                for (int ww = 0; ww < 8; ++ww) s += part[(ww * 4 + b) * 64 + l];
                ((float*)(ws + WS_MOD))[b * 6144 + j] = s; }
            __syncthreads();
        }
    }
    {
        const int lane = tid & 63; const int gwv = bid * NWAVES + (tid >> 6), nwv = G * NWAVES;
        f32x4 nv[4];
        if (gwv < 2 * NEXP) { const float* s0 = (gwv >= NEXP ? a.in[20] + (size_t)(gwv - NEXP) * 1024 : a.in[19] + (size_t)gwv * 1024);
#pragma unroll
            for (int i = 0; i < 4; ++i) nv[i] = *(const f32x4*)(s0 + 4 * lane + 256 * i); }
        for (int rr = gwv; rr < 2 * NEXP; rr += nwv) {
            const bool second = rr >= NEXP; const int e = second ? rr - NEXP : rr;
            unsigned char* dst = ws + (second ? WS_PV : WS_PU);
            f32x4 v[4]; float am = 0.f;
#pragma unroll
            for (int i = 0; i < 4; ++i) { v[i] = nv[i]; am = fmaxf(am, fmaxf(fmaxf(fabsf(v[i][0]), fabsf(v[i][1])), fmaxf(fabsf(v[i][2]), fabsf(v[i][3])))); }
            { const int rn = (rr + nwv < 2 * NEXP) ? rr + nwv : rr; const float* s1 = (rn >= NEXP ? a.in[20] + (size_t)(rn - NEXP) * 1024 : a.in[19] + (size_t)rn * 1024);
#pragma unroll
              for (int i = 0; i < 4; ++i) nv[i] = *(const f32x4*)(s1 + 4 * lane + 256 * i); }
            am = wave_max(am); am = fmaxf(am, 1e-30f);
            const float inv = 224.0f / am;
            if (lane == 0) ((float*)(ws + (second ? WS_VSC : WS_USC)))[e] = am * (1.0f / 224.0f);
#pragma unroll
            for (int i = 0; i < 4; ++i) { int p = __builtin_amdgcn_cvt_pk_fp8_f32(v[i][0] * inv, v[i][1] * inv, 0, false); p = __builtin_amdgcn_cvt_pk_fp8_f32(v[i][2] * inv, v[i][3] * inv, p, true);
                const int sl = 2 * i + (lane >> 5);
                *(int*)(dst + ((size_t)sl * NEXP + e) * 128 + 4 * (lane & 31)) = p; }
        }
    }
    for (int i = bid * NTHR + tid; i < NB * 8 * 32 * 64; i += G * NTHR) ((float*)(ws + WS_KM))[i] = 0.f;
    for (int i = bid * NTHR + tid; i < 8 * 2048; i += G * NTHR) { const int h = i >> 11, rel = i & 2047; ((float*)(ws + WS_BIAS))[i] = a.in[11][t5_bucket(rel) * 8 + h]; }
}

DEVI void p1_prenorm(const float* __restrict__ x, const float* __restrict__ g, const float* __restrict__ mod, int sh_off, int sc_off, bf16* __restrict__ H, unsigned char* __restrict__ H8,
                     float* __restrict__ HS, int gw, int nw, int lane) {
    for (int row = gw; row < NT; row += nw) {
        const int b = row >> 13; const float* xr = x + (size_t)row * DM; const float* mb = mod + b * 6144;
        f32x4 v[4]; float ss = 0.f;
#pragma unroll
        for (int i = 0; i < 4; ++i) { v[i] = *(const f32x4*)(xr + 4 * lane + 256 * i); ss += v[i][0] * v[i][0] + v[i][1] * v[i][1] + v[i][2] * v[i][2] + v[i][3] * v[i][3]; }
        ss = wave_sum(ss);
        const float r = rsqrtf(ss * (1.0f / DM) + EPS);
        float o[16]; float am = 0.f;
#pragma unroll
        for (int i = 0; i < 4; ++i) { const int d = 4 * lane + 256 * i;
            const f32x4 gg = *(const f32x4*)(g + d), sc = *(const f32x4*)(mb + sc_off + d), sh = *(const f32x4*)(mb + sh_off + d);
#pragma unroll
            for (int j = 0; j < 4; ++j) { o[4 * i + j] = v[i][j] * r * gg[j] * (1.0f + sc[j]) + sh[j]; am = fmaxf(am, fabsf(o[4 * i + j])); }
            uint2 w; w.x = pk2(o[4 * i], o[4 * i + 1]); w.y = pk2(o[4 * i + 2], o[4 * i + 3]);
            *(uint2*)(H + (size_t)row * DM + d) = w; }
        am = fmaxf(wave_max(am), 1e-30f);
        const float inv = 224.0f / am;
        if (lane == 0) HS[row] = am * (1.0f / 224.0f);
#pragma unroll
        for (int i = 0; i < 4; ++i) { int p = __builtin_amdgcn_cvt_pk_fp8_f32(o[4 * i] * inv, o[4 * i + 1] * inv, 0, false); p = __builtin_amdgcn_cvt_pk_fp8_f32(o[4 * i + 2] * inv, o[4 * i + 3] * inv, p, true);
            *(int*)(H8 + (size_t)row * DM + 4 * lane + 256 * i) = p; }
    }
}


namespace kbs {
typedef short bf16x8 __attribute__((ext_vector_type(8)));
typedef short s16x4 __attribute__((ext_vector_type(4)));
constexpr int KROWB = 144;
constexpr int OFF_K = 0, OFF_V = 256 * KROWB, OFF_TAB = 2 * 256 * KROWB;
constexpr int TABN = 1600;
constexpr int OFF_SEL = OFF_TAB + TABN * 4;
constexpr int OFF_CNT = OFF_SEL + 1024;
constexpr int OFF_GB = OFF_CNT + 256;
constexpr int OFF_PFX = OFF_TAB + TABN * 4;
constexpr int END = OFF_PFX + 4112;
constexpr float SC2 = 0.125f * 1.4426950408889634f;
constexpr float NEG = -1.0e30f;
constexpr int TRI_TOTAL = 256 * 496;
constexpr int NGI = 32 * 136;
__host__ __device__ constexpr int tri(int n) { return 256 * (31 * n - n * (n - 1) / 2); }

DEVI s16x4 vtr(const unsigned char* p) { return __builtin_bit_cast(s16x4, __builtin_amdgcn_ds_read_tr16_b64_v4i16((LAS s16x4*)(LAS unsigned char*)p)); }

DEVI void select_unit(int bh, int qb, const bf16* __restrict__ Qb, const float* __restrict__ KM, unsigned* __restrict__ GCNT, unsigned short* __restrict__ GLIST, unsigned char* lds, int tid) {
    if (qb == 0) return;
    const int b = bh >> 3, h = bh & 7;
    const bf16* Qg = Qb + ((size_t)b * SEQ + 256 * qb) * 512 + h * 64;
    int* CNT = (int*)(lds + OFF_CNT); int* FIL = CNT + 32; int* GB = (int*)(lds + OFF_GB);
    if (tid < 64) CNT[tid] = 0;
    {
        const int lane = tid & 63, w = tid >> 6, li = lane & 15, g = lane >> 4;
        bf16x8 ah[2][2], al[2][2];
#pragma unroll
        for (int tl = 0; tl < 2; ++tl)
#pragma unroll
            for (int ks = 0; ks < 2; ++ks) {
                const float* kp = KM + ((size_t)(bh * 32 + 16 * tl + li)) * 64 + 8 * g + 32 * ks;
                const f32x4 a = *(const f32x4*)kp, c = *(const f32x4*)(kp + 4);
                const float v[8] = {a[0], a[1], a[2], a[3], c[0], c[1], c[2], c[3]};
                unsigned hi[4], lo[4];
#pragma unroll
                for (int k = 0; k < 4; ++k) { hi[k] = pk2(v[2 * k], v[2 * k + 1]); lo[k] = pk2(v[2 * k] - bflo(hi[k]), v[2 * k + 1] - bfhi(hi[k])); }
                ah[tl][ks] = __builtin_bit_cast(bf16x8, (v4u){hi[0], hi[1], hi[2], hi[3]}); al[tl][ks] = __builtin_bit_cast(bf16x8, (v4u){lo[0], lo[1], lo[2], lo[3]});
            }
#pragma unroll 1
        for (int gi = 0; gi < 2; ++gi) {
            const int q = 32 * w + 16 * gi + li;
            const bf16* qrow = Qg + (size_t)q * 512 + 8 * g;
            const bf16x8 qf0 = *(const bf16x8*)qrow, qf1 = *(const bf16x8*)(qrow + 32);
            f32x4 sc[2];
#pragma unroll
            for (int tl = 0; tl < 2; ++tl) {
                f32x4 d = __builtin_amdgcn_mfma_f32_16x16x32_bf16(ah[tl][0], qf0, (f32x4){0.f, 0.f, 0.f, 0.f}, 0, 0, 0);
                d = __builtin_amdgcn_mfma_f32_16x16x32_bf16(ah[tl][1], qf1, d, 0, 0, 0);
                d = __builtin_amdgcn_mfma_f32_16x16x32_bf16(al[tl][0], qf0, d, 0, 0, 0);
                d = __builtin_amdgcn_mfma_f32_16x16x32_bf16(al[tl][1], qf1, d, 0, 0, 0);
                sc[tl] = d;
            }
            float v0 = -3.0e38f, v1 = -3.0e38f, v2 = -3.0e38f; int i0 = 255, i1 = 255, i2 = 255;
#define KBS_INS(a_, n_) do { const float xa_ = (a_); const int xn_ = (n_); \
                if (xa_ > v0 || (xa_ == v0 && xn_ < i0)) { v2 = v1; i2 = i1; v1 = v0; i1 = i0; v0 = xa_; i0 = xn_; } \
                else if (xa_ > v1 || (xa_ == v1 && xn_ < i1)) { v2 = v1; i2 = i1; v1 = xa_; i1 = xn_; } \
                else if (xa_ > v2 || (xa_ == v2 && xn_ < i2)) { v2 = xa_; i2 = xn_; } } while (0)
#pragma unroll
            for (int tl = 0; tl < 2; ++tl)
#pragma unroll
                for (int j = 0; j < 4; ++j) { const int n = 16 * tl + 4 * g + j; if (n < qb) KBS_INS(sc[tl][j], n); }
#pragma unroll
            for (int st = 16; st <= 32; st <<= 1) {
                const float p0 = __shfl_xor(v0, st), p1 = __shfl_xor(v1, st), p2 = __shfl_xor(v2, st);
                const int j0 = __shfl_xor(i0, st), j1 = __shfl_xor(i1, st), j2 = __shfl_xor(i2, st);
                if (j0 != 255) KBS_INS(p0, j0);
                if (j1 != 255) KBS_INS(p1, j1);
                if (j2 != 255) KBS_INS(p2, j2);
            }
#undef KBS_INS
            if (g == 0) { unsigned char* sp = lds + OFF_SEL + q * 4; sp[0] = (unsigned char)i0; sp[1] = (unsigned char)i1; sp[2] = (unsigned char)i2; sp[3] = 255; }
        }
    }
    __syncthreads();
    const unsigned char* sp = lds + OFF_SEL + (tid & 255) * 4;
    if (tid < 256) {
#pragma unroll
        for (int j = 0; j < 3; ++j) { const int n = sp[j]; if (n != 255) atomicAdd(&CNT[n], 1); } }
    __syncthreads();
    if (tid < 32) { const int c = CNT[tid]; GB[tid] = c > 0 ? (int)atomicAdd(GCNT + bh * 32 + tid, (unsigned)c) : 0; }
    __syncthreads();
    if (tid < 256) {
        unsigned short* gl = GLIST + (size_t)bh * TRI_TOTAL;
#pragma unroll
        for (int j = 0; j < 3; ++j) { const int n = sp[j];
            if (n != 255) { const int pos = atomicAdd(&FIL[n], 1); gl[tri(n) + GB[n] + pos] = (unsigned short)((qb * 256 + tid) | (j << 13)); } } }
    __syncthreads();
}

DEVI void tile_load(const bf16* __restrict__ Kg, const bf16* __restrict__ Vg, size_t rowbase, unsigned char* lds, int tid) {
    v4u kr[4], vr[4];
#pragma unroll
    for (int i = 0; i < 4; ++i) { const int ch = tid + 512 * i, row = ch >> 3, c8 = ch & 7;
        kr[i] = *(const v4u*)(Kg + (rowbase + row) * 512 + c8 * 8); vr[i] = *(const v4u*)(Vg + (rowbase + row) * 512 + c8 * 8); }
#pragma unroll
    for (int i = 0; i < 4; ++i) { const int ch = tid + 512 * i, row = ch >> 3, c8 = ch & 7;
        *(v4u*)(lds + OFF_K + row * KROWB + c8 * 16) = kr[i]; *(v4u*)(lds + OFF_V + row * KROWB + c8 * 16) = vr[i]; }
}

template <bool OWN, bool FAR>
DEVI void chunk128_base(const unsigned char* lds, int ch, const bf16x8 qf0, const bf16x8 qf1, int lane, int relq, float& m, float& l, f32x4 (&o)[4]) {
    const int li = lane & 15, g = lane >> 4;
    const float* tab = (const float*)(lds + OFF_TAB);
    const float farb = tab[TABN - 1];
    f32x4 s[8];
    const unsigned char* kb = lds + OFF_K + (128 * ch + li) * KROWB + 16 * g;
#pragma unroll
    for (int kt = 0; kt < 8; ++kt)
#pragma unroll
        for (int j = 0; j < 4; ++j) { const int rel = relq - (16 * kt + 4 * g + j);
            s[kt][j] = OWN ? tab[rel < 0 ? 0 : rel] : (FAR ? farb : tab[rel > TABN - 1 ? TABN - 1 : rel]); }
#pragma unroll
    for (int kt = 0; kt < 8; ++kt) {
        const bf16x8 a0 = *(const bf16x8*)(kb + kt * 16 * KROWB), a1 = *(const bf16x8*)(kb + kt * 16 * KROWB + 64);
        s[kt] = __builtin_amdgcn_mfma_f32_16x16x32_bf16(a0, qf0, s[kt], 0, 0, 0);
        s[kt] = __builtin_amdgcn_mfma_f32_16x16x32_bf16(a1, qf1, s[kt], 0, 0, 0);
    }
    float mx = NEG;
#pragma unroll
    for (int kt = 0; kt < 8; ++kt) {
#pragma unroll
        for (int j = 0; j < 4; ++j) {
            const int rel = relq - (16 * kt + 4 * g + j);
            const float x = (!OWN || rel >= 0) ? s[kt][j] : NEG;
            s[kt][j] = x; mx = fmaxf(mx, x);
        }
    }
    mx = fmaxf(mx, __shfl_xor(mx, 16)); mx = fmaxf(mx, __shfl_xor(mx, 32));
    const float mnew = fmaxf(m, mx);
    const float alpha = __builtin_amdgcn_exp2f(m - mnew);
    float psum = 0.f;
#pragma unroll
    for (int kt = 0; kt < 8; ++kt) {
#pragma unroll
        for (int j = 0; j < 4; ++j) { const float p = __builtin_amdgcn_exp2f(s[kt][j] - mnew); s[kt][j] = p; psum += p; }
    }
    psum += __shfl_xor(psum, 16); psum += __shfl_xor(psum, 32);
    m = mnew; l = l * alpha + psum;
#pragma unroll
    for (int dt = 0; dt < 4; ++dt) o[dt] = o[dt] * alpha;
    const unsigned char* vb = lds + OFF_V + (128 * ch + 4 * g + (li >> 2)) * KROWB + 8 * (li & 3);
#pragma unroll
    for (int ks = 0; ks < 4; ++ks) {
        const bf16x8 pf = __builtin_bit_cast(bf16x8, (v4u){pk2(s[2 * ks][0], s[2 * ks][1]), pk2(s[2 * ks][2], s[2 * ks][3]), pk2(s[2 * ks + 1][0], s[2 * ks + 1][1]), pk2(s[2 * ks + 1][2], s[2 * ks + 1][3])});
#pragma unroll
        for (int dt = 0; dt < 4; ++dt) {
            const s16x4 t0 = vtr(vb + (32 * ks) * KROWB + 32 * dt), t1 = vtr(vb + (32 * ks + 16) * KROWB + 32 * dt);
            const bf16x8 vf = (bf16x8){t0[0], t0[1], t0[2], t0[3], t1[0], t1[1], t1[2], t1[3]};
            o[dt] = __builtin_amdgcn_mfma_f32_16x16x32_bf16(vf, pf, o[dt], 0, 0, 0);
        }
    }
}
template <bool FAR>
DEVI void chunk128_pair(const unsigned char* lds, int ch, const bf16x8 qf0, const bf16x8 qf1, int lane, int relq, float& m, float& l, f32x4 (&o)[4]) {
    const int li = lane & 15, g = lane >> 4;
    const float* tab = (const float*)(lds + OFF_TAB);
    const float farb = tab[TABN - 1];
    f32x4 s[8];
    const unsigned char* kb = lds + OFF_K + (128 * ch + li) * KROWB + 16 * g;
    const unsigned char* vb = lds + OFF_V + (128 * ch + 4 * g + (li >> 2)) * KROWB + 8 * (li & 3);
#pragma unroll
    for (int kt = 0; kt < 8; ++kt)
#pragma unroll
        for (int j = 0; j < 4; ++j) { const int rel = relq - (16 * kt + 4 * g + j); s[kt][j] = FAR ? farb : tab[rel > TABN - 1 ? TABN - 1 : rel]; }
    bf16x8 r0[2], r1[2];
#pragma unroll
    for (int kt = 0; kt < 2; ++kt) { r0[kt] = *(const bf16x8*)(kb + kt * 16 * KROWB); r1[kt] = *(const bf16x8*)(kb + kt * 16 * KROWB + 64); }
    __builtin_amdgcn_sched_barrier(0);
#pragma unroll
    for (int kt = 0; kt < 8; ++kt) {
        s[kt] = __builtin_amdgcn_mfma_f32_16x16x32_bf16(r0[kt & 1], qf0, s[kt], 0, 0, 0);
        s[kt] = __builtin_amdgcn_mfma_f32_16x16x32_bf16(r1[kt & 1], qf1, s[kt], 0, 0, 0);
        if (kt + 2 < 8) { r0[kt & 1] = *(const bf16x8*)(kb + (kt + 2) * 16 * KROWB); r1[kt & 1] = *(const bf16x8*)(kb + (kt + 2) * 16 * KROWB + 64); }
        __builtin_amdgcn_sched_barrier(0);
    }
    s16x4 va[2][4][2];
#pragma unroll
    for (int dt = 0; dt < 4; ++dt) { va[0][dt][0] = vtr(vb + 32 * dt); va[0][dt][1] = vtr(vb + 16 * KROWB + 32 * dt); }
    __builtin_amdgcn_sched_barrier(0);
    float mx = NEG;
#pragma unroll
    for (int kt = 0; kt < 8; ++kt) {
#pragma unroll
        for (int j = 0; j < 4; ++j) {
            mx = fmaxf(mx, s[kt][j]);
        }
    }
    mx = fmaxf(mx, __shfl_xor(mx, 16)); mx = fmaxf(mx, __shfl_xor(mx, 32));
    const float mnew = fmaxf(m, mx);
    const float alpha = __builtin_amdgcn_exp2f(m - mnew);
    float psum = 0.f;
#pragma unroll
    for (int kt = 0; kt < 8; ++kt) {
#pragma unroll
        for (int j = 0; j < 4; ++j) { const float p = __builtin_amdgcn_exp2f(s[kt][j] - mnew); s[kt][j] = p; psum += p; }
    }
    psum += __shfl_xor(psum, 16); psum += __shfl_xor(psum, 32);
    m = mnew; l = l * alpha + psum;
#pragma unroll
    for (int dt = 0; dt < 4; ++dt) o[dt] = o[dt] * alpha;
    __builtin_amdgcn_sched_barrier(0);
#pragma unroll
    for (int ks = 0; ks < 4; ++ks) {
        if (ks + 1 < 4) {
#pragma unroll
            for (int dt = 0; dt < 2; ++dt) { va[(ks + 1) & 1][dt][0] = vtr(vb + (32 * (ks + 1)) * KROWB + 32 * dt); va[(ks + 1) & 1][dt][1] = vtr(vb + (32 * (ks + 1) + 16) * KROWB + 32 * dt); } }
        const bf16x8 pf = __builtin_bit_cast(bf16x8, (v4u){pk2(s[2 * ks][0], s[2 * ks][1]), pk2(s[2 * ks][2], s[2 * ks][3]), pk2(s[2 * ks + 1][0], s[2 * ks + 1][1]), pk2(s[2 * ks + 1][2], s[2 * ks + 1][3])});
#pragma unroll
        for (int dt = 0; dt < 4; ++dt) {
            const s16x4 t0 = va[ks & 1][dt][0], t1 = va[ks & 1][dt][1];
            const bf16x8 vf = (bf16x8){t0[0], t0[1], t0[2], t0[3], t1[0], t1[1], t1[2], t1[3]};
            o[dt] = __builtin_amdgcn_mfma_f32_16x16x32_bf16(vf, pf, o[dt], 0, 0, 0);
            if (dt == 1 && ks + 1 < 4) {
#pragma unroll
                for (int d2 = 2; d2 < 4; ++d2) { va[(ks + 1) & 1][d2][0] = vtr(vb + (32 * (ks + 1)) * KROWB + 32 * d2); va[(ks + 1) & 1][d2][1] = vtr(vb + (32 * (ks + 1) + 16) * KROWB + 32 * d2); } }
        }
        __builtin_amdgcn_sched_barrier(0);
    }
}
template <bool OWN, bool FAR>
DEVI void chunk128(const unsigned char* lds, int ch, const bf16x8 qf0, const bf16x8 qf1, int lane, int relq, float& m, float& l, f32x4 (&o)[4]) {
    if constexpr (OWN) chunk128_base<true, false>(lds, ch, qf0, qf1, lane, relq, m, l, o);
    else chunk128_pair<FAR>(lds, ch, qf0, qf1, lane, relq, m, l, o);
}
DEVI void write_partial(unsigned char* __restrict__ POa, unsigned char* __restrict__ POc, float* __restrict__ PM, float* __restrict__ PL, int slot, size_t th, bool valid, int lane,
                        float m, float l, const f32x4 (&o)[4]) {
    if (!valid) return;
    const int g = lane >> 4;
    unsigned char* base = (slot < 2 ? POa + (size_t)slot * ((size_t)NT * NH * 128) : POc + (size_t)(slot - 2) * ((size_t)NT * NH * 128)) + th * 128 + 8 * g;
#pragma unroll
    for (int dt = 0; dt < 4; ++dt) { uint2 w; w.x = pk2(o[dt][0], o[dt][1]); w.y = pk2(o[dt][2], o[dt][3]); *(uint2*)(base + 32 * dt) = w; }
    if (g == 0) { PM[(size_t)slot * NT * NH + th] = m; PL[(size_t)slot * NT * NH + th] = l; }
}

DEVI void attn_items(const bf16* __restrict__ Qb, const bf16* __restrict__ Kb, const bf16* __restrict__ Vb, const float* __restrict__ BIAS, const unsigned* __restrict__ GCNT,
                     const unsigned short* __restrict__ GLIST, unsigned* __restrict__ queue, unsigned char* __restrict__ POa, unsigned char* __restrict__ POc, float* __restrict__ PM, float* __restrict__ PL,
                     unsigned char* lds, volatile LAS unsigned* MISC, int tid) {
    const int lane = tid & 63, w = __builtin_amdgcn_readfirstlane(tid >> 6), li = lane & 15, g = lane >> 4;
    int cur_h = -1;
    int* PFX = (int*)(lds + OFF_PFX);
    for (int p = tid; p < 1024; p += NTHR) { int parts = 0;
        if (p < 992) { const int c = (int)__hip_atomic_load(GCNT + (p & 31) * 32 + (p >> 5), __ATOMIC_RELAXED, __HIP_MEMORY_SCOPE_AGENT); parts = (((c + 15) >> 4) + 63) >> 6; }
        PFX[p + 1] = parts; }
    __syncthreads();
    if (tid < 64) { int v[16]; int sum = 0;
#pragma unroll
        for (int i = 0; i < 16; ++i) { v[i] = PFX[1 + 16 * tid + i]; sum += v[i]; }
        int incl = sum;
#pragma unroll
        for (int o = 1; o < 64; o <<= 1) { const int t = __shfl_up(incl, o); if (lane >= o) incl += t; }
        int run = incl - sum;
#pragma unroll
        for (int i = 0; i < 16; ++i) { run += v[i]; v[i] = run; }
#pragma unroll
        for (int i = 0; i < 16; ++i) PFX[1 + 16 * tid + i] = v[i];
        if (tid == 0) PFX[0] = 0; }
    __syncthreads();
    const int NG = PFX[992];
    if (tid == 0) MISC[16] = __hip_atomic_fetch_add(queue, 1u, __ATOMIC_RELAXED, __HIP_MEMORY_SCOPE_AGENT);
    int slot = 0;
#pragma unroll 1
    for (;;) {
        __syncthreads();
        const int it = (int)MISC[16 + slot];
        if (it >= NG + 1024) break;
        unsigned next_tk = 0;
        if (tid == 0) next_tk = __hip_atomic_fetch_add(queue, 1u, __ATOMIC_RELAXED, __HIP_MEMORY_SCOPE_AGENT);
        int bh, n, part = 0; bool own;
        if (it < NG) { own = false; int lo = 0, hi = 992;
            while (hi - lo > 1) { const int mid = (lo + hi) >> 1; if (PFX[mid] <= it) lo = mid; else hi = mid; }
            n = lo >> 5; bh = lo & 31; part = it - PFX[lo];
        } else { own = true; const int j = it - NG; bh = j & 31; n = j >> 5; }
        const int b = bh >> 3, h = bh & 7;
        int cnt = 0, G0 = 0, G1 = 0;
        if (!own) { cnt = (int)__hip_atomic_load(GCNT + bh * 32 + n, __ATOMIC_RELAXED, __HIP_MEMORY_SCOPE_AGENT); const int Gt = (cnt + 15) >> 4; G0 = 64 * part; G1 = G0 + 64 < Gt ? G0 + 64 : Gt; }
        if (h != cur_h) { int t_ = tid; asm volatile("" : "+v"(t_));
            float* tab = (float*)(lds + OFF_TAB); for (int i = t_; i < TABN; i += NTHR) tab[i] = BIAS[h * 2048 + i] * 1.4426950408889634f; cur_h = h; }
        tile_load(Kb + h * 64, Vb + h * 64, (size_t)b * SEQ + 256 * n, lds, tid);
        __syncthreads();
        if (own) {
            const int qb = n;
#pragma unroll 1
            for (int gi = 0; gi < 2; ++gi) {
                const int q = 32 * w + 16 * gi + li; const size_t t = (size_t)b * SEQ + 256 * qb + q;
                const bf16* qrow = Qb + t * 512 + h * 64 + 8 * g;
                const bf16x8 qf0 = *(const bf16x8*)qrow, qf1 = *(const bf16x8*)(qrow + 32);
                float m = NEG, l = 0.f; f32x4 o[4];
#pragma unroll
                for (int dt = 0; dt < 4; ++dt) o[dt] = (f32x4){0.f, 0.f, 0.f, 0.f};
                chunk128<true, false>(lds, 0, qf0, qf1, lane, q, m, l, o);
                if (w >= 4) chunk128<true, false>(lds, 1, qf0, qf1, lane, q - 128, m, l, o);
                write_partial(POa, POc, PM, PL, 3, t * NH + h, true, lane, m, l, o);
            }
        } else {
            const unsigned short* gl = GLIST + (size_t)bh * TRI_TOTAL + tri(n);
            int gq = G0 + w;
            auto ent = [&](int grp) -> int { const int c = 16 * grp + li; return (grp < G1) ? (int)gl[c < cnt ? c : 0] | ((c < cnt) ? 0 : 0x8000) : 0x8000; };
            int e0 = ent(gq), e1 = ent(gq + 8);
            const bf16* qr0 = Qb + ((size_t)b * SEQ + (e0 & 0x1FFF)) * 512 + h * 64 + 8 * g;
            bf16x8 q00 = *(const bf16x8*)qr0, q01 = *(const bf16x8*)(qr0 + 32);
#pragma unroll 1
            for (; gq < G1; gq += 8) {
                const int e2 = ent(gq + 16);
                const bf16* qr1 = Qb + ((size_t)b * SEQ + (e1 & 0x1FFF)) * 512 + h * 64 + 8 * g;
                const bf16x8 q10 = *(const bf16x8*)qr1, q11 = *(const bf16x8*)(qr1 + 32);
                const int s = e0 & 0x1FFF, slot = (e0 >> 13) & 3; const bool valid = (e0 & 0x8000) == 0;
                float m = NEG, l = 0.f; f32x4 o[4];
#pragma unroll
                for (int dt = 0; dt < 4; ++dt) o[dt] = (f32x4){0.f, 0.f, 0.f, 0.f};
                const int relq = s - 256 * n;
                const bool far = __all(!valid || relq - 255 >= 1513);
                if (far) { chunk128<false, true>(lds, 0, q00, q01, lane, relq, m, l, o); chunk128<false, true>(lds, 1, q00, q01, lane, relq - 128, m, l, o); }
                else { chunk128<false, false>(lds, 0, q00, q01, lane, relq, m, l, o); chunk128<false, false>(lds, 1, q00, q01, lane, relq - 128, m, l, o); }
                write_partial(POa, POc, PM, PL, slot, ((size_t)b * SEQ + s) * NH + h, valid, lane, m, l, o);
                e0 = e1; e1 = e2; q00 = q10; q01 = q11;
            }
        }
        slot ^= 1;
        if (tid == 0) MISC[16 + slot] = next_tk;
    }
}

DEVI void merge_partials(const unsigned char* __restrict__ POa, const unsigned char* __restrict__ POc, const float* __restrict__ PM, const float* __restrict__ PL, bf16* __restrict__ YA,
                         int gw, int nw, int lane) {
    const int hh = lane >> 3, pc = lane & 7;
    for (int t = gw; t < NT; t += nw) {
        const int qb = (t & (SEQ - 1)) >> 8; const size_t th = (size_t)t * NH + hh;
        float mj[4], lj[4]; v4u oj[4]; bool vj[4];
#pragma unroll
        for (int j = 0; j < 4; ++j) { vj[j] = (j == 3) || (j < qb);
            const unsigned char* base = (j < 2 ? POa + (size_t)j * ((size_t)NT * NH * 128) : POc + (size_t)(j - 2) * ((size_t)NT * NH * 128)) + th * 128 + 16 * pc;
            if (vj[j]) { mj[j] = PM[(size_t)j * NT * NH + th]; lj[j] = PL[(size_t)j * NT * NH + th]; oj[j] = *(const v4u*)base; }
            else { mj[j] = NEG; lj[j] = 0.f; oj[j] = (v4u){0u, 0u, 0u, 0u}; } }
        const float M = fmaxf(fmaxf(mj[0], mj[1]), fmaxf(mj[2], mj[3]));
        float L = 0.f; float acc[8] = {0.f, 0.f, 0.f, 0.f, 0.f, 0.f, 0.f, 0.f};
#pragma unroll
        for (int j = 0; j < 4; ++j) { const float a = vj[j] ? __builtin_amdgcn_exp2f(mj[j] - M) : 0.f; L += lj[j] * a;
            acc[0] += a * bflo(oj[j].x); acc[1] += a * bfhi(oj[j].x); acc[2] += a * bflo(oj[j].y); acc[3] += a * bfhi(oj[j].y);
            acc[4] += a * bflo(oj[j].z); acc[5] += a * bfhi(oj[j].z); acc[6] += a * bflo(oj[j].w); acc[7] += a * bfhi(oj[j].w); }
        const float inv = 1.0f / L;
        v4u w; w.x = pk2(acc[0] * inv, acc[1] * inv); w.y = pk2(acc[2] * inv, acc[3] * inv); w.z = pk2(acc[4] * inv, acc[5] * inv); w.w = pk2(acc[6] * inv, acc[7] * inv);
        *(v4u*)(YA + (size_t)t * 1024 + hh * 64 + 8 * pc) = w;
    }
}
}
typedef float f32x2_t __attribute__((ext_vector_type(2)));
DEVI void p4_gmlp_unit(int unit, const bf16* __restrict__ U, const bf16* __restrict__ GV, const float* __restrict__ lng, const float* __restrict__ lnb,
                       const float* __restrict__ ws_, const float* __restrict__ bs_, bf16* __restrict__ YG, unsigned char* lds, int tid) {
    typedef short bf16x8_t __attribute__((ext_vector_type(8)));
    typedef short s16x4_t __attribute__((ext_vector_type(4)));
    constexpr int VNP = 1040;
    const int wv = tid >> 6, lane = tid & 63;
    const size_t row0 = (size_t)unit * 128;
    {
        float gg[8], bb[8];
#pragma unroll
        for (int j = 0; j < 8; ++j) { gg[j] = lng[8 * lane + j]; bb[j] = lnb[8 * lane + j]; }
        for (int r = 0; r < 16; ++r) {
            const int tt = 16 * wv + r;
            const v4u w = *(const v4u*)(GV + (row0 + tt) * 512 + 8 * lane);
            float v[8] = {bflo(w.x), bfhi(w.x), bflo(w.y), bfhi(w.y), bflo(w.z), bfhi(w.z), bflo(w.w), bfhi(w.w)};
            float s = 0.f;
#pragma unroll
            for (int j = 0; j < 8; ++j) s += v[j];
            const float mu = wave_sum(s) * (1.0f / 512.0f);
            float q = 0.f;
#pragma unroll
            for (int j = 0; j < 8; ++j) { v[j] -= mu; q += v[j] * v[j]; }
            const float rs = rsqrtf(wave_sum(q) * (1.0f / 512.0f) + EPS);
#pragma unroll
            for (int j = 0; j < 8; ++j) v[j] = v[j] * rs * gg[j] + bb[j];
            v4u o; o.x = pk2(v[0], v[1]); o.y = pk2(v[2], v[3]); o.z = pk2(v[4], v[5]); o.w = pk2(v[6], v[7]);
            *(v4u*)(lds + tt * VNP + 16 * lane) = o;
        }
    }
    __syncthreads();
    {
        const int g = wv, li = lane & 15, kg = lane >> 4;
        const float* wg = ws_ + (size_t)g * 128 * 128;
        const unsigned char* vbase = lds + (8 * kg + (li >> 2)) * VNP + (64 * g + 4 * (li & 3)) * 2;
#pragma unroll
        for (int tt = 0; tt < 8; ++tt) {
            constexpr int dummy = 0; (void)dummy;
            const int t = 16 * tt + li;
            const int nks = tt / 2 + 1;
            bf16x8_t bw[4];
#pragma unroll
            for (int ks = 0; ks < 4; ++ks) {
                if (ks < nks) {
                    const float* wp = wg + t * 128 + 32 * ks + 8 * kg;
                    const f32x4 a = *(const f32x4*)wp, b = *(const f32x4*)(wp + 4);
                    const int s0 = 32 * ks + 8 * kg;
                    float m[8] = {a[0], a[1], a[2], a[3], b[0], b[1], b[2], b[3]};
#pragma unroll
                    for (int j = 0; j < 8; ++j) m[j] = (s0 + j <= t) ? m[j] : 0.f;
                    bw[ks] = __builtin_bit_cast(bf16x8_t, (v4u){pk2(m[0], m[1]), pk2(m[2], m[3]), pk2(m[4], m[5]), pk2(m[6], m[7])});
                }
            }
            const float bias = bs_[g * 128 + t];
#pragma unroll
            for (int ct = 0; ct < 4; ++ct) {
                f32x4 acc = (f32x4){0.f, 0.f, 0.f, 0.f};
#pragma unroll
                for (int ks = 0; ks < 4; ++ks) {
                    if (ks < nks) {
                        const unsigned char* ap = vbase + (32 * ks) * VNP + 32 * ct;
                        const s16x4_t t0 = __builtin_bit_cast(s16x4_t, __builtin_amdgcn_ds_read_tr16_b64_v4i16((LAS s16x4_t*)(LAS unsigned char*)ap));
                        const s16x4_t t1 = __builtin_bit_cast(s16x4_t, __builtin_amdgcn_ds_read_tr16_b64_v4i16((LAS s16x4_t*)(LAS unsigned char*)(ap + 4 * VNP)));
                        const bf16x8_t af = (bf16x8_t){t0[0], t0[1], t0[2], t0[3], t1[0], t1[1], t1[2], t1[3]};
                        acc = __builtin_amdgcn_mfma_f32_16x16x32_bf16(af, bw[ks], acc, 0, 0, 0);
                    }
                }
                const size_t o = (row0 + t) * 512 + 64 * g + 16 * ct + 4 * kg;
                const uint2 uu = *(const uint2*)(U + o);
                uint2 y; y.x = pk2(bflo(uu.x) * (acc[0] + bias), bfhi(uu.x) * (acc[1] + bias)); y.y = pk2(bflo(uu.y) * (acc[2] + bias), bfhi(uu.y) * (acc[3] + bias));
                *(uint2*)(YG + (row0 + t) * 1024 + 512 + 64 * g + 16 * ct + 4 * kg) = y;
            }
        }
    }
    __syncthreads();
}

DEVI void p7_mid(const float* __restrict__ x, const bf16* __restrict__ Y, const float* __restrict__ post_g1, const float* __restrict__ pre_g2, const float* __restrict__ mod,
                 float* __restrict__ X1, bf16* __restrict__ H2, unsigned char* __restrict__ XH, unsigned char* __restrict__ XL, float* __restrict__ XSC, int gw, int nw, int lane) {
    uint2 nyw[4]; f32x4 nxx[4];
    if (gw < NT) {
#pragma unroll
        for (int i = 0; i < 4; ++i) { const int d = 4 * lane + 256 * i; nyw[i] = *(const uint2*)(Y + (size_t)gw * DM + d); nxx[i] = *(const f32x4*)(x + (size_t)gw * DM + d); } }
    for (int row = gw; row < NT; row += nw) {
        const int b = row >> 13; const float* mb = mod + b * 6144;
        float y[16], xv[16]; float ss = 0.f;
#pragma unroll
        for (int i = 0; i < 4; ++i) { const uint2 w = nyw[i];
            y[4 * i + 0] = bflo(w.x); y[4 * i + 1] = bfhi(w.x); y[4 * i + 2] = bflo(w.y); y[4 * i + 3] = bfhi(w.y);
            const f32x4 xx = nxx[i]; xv[4 * i + 0] = xx[0]; xv[4 * i + 1] = xx[1]; xv[4 * i + 2] = xx[2]; xv[4 * i + 3] = xx[3]; }
        { const int nrow = (row + nw < NT) ? row + nw : row;
#pragma unroll
          for (int i = 0; i < 4; ++i) { const int d = 4 * lane + 256 * i; nyw[i] = *(const uint2*)(Y + (size_t)nrow * DM + d); nxx[i] = *(const f32x4*)(x + (size_t)nrow * DM + d); } }
#pragma unroll
        for (int j = 0; j < 16; ++j) ss += y[j] * y[j];
        const float r1 = rsqrtf(wave_sum(ss) * (1.0f / DM) + EPS);
        float s2 = 0.f;
#pragma unroll
        for (int i = 0; i < 4; ++i) { const int d = 4 * lane + 256 * i; const f32x4 g1 = *(const f32x4*)(post_g1 + d), gt = *(const f32x4*)(mb + 2048 + d);
            f32x4 o;
#pragma unroll
            for (int j = 0; j < 4; ++j) { const float v = xv[4 * i + j] + gt[j] * (y[4 * i + j] * r1 * g1[j]); xv[4 * i + j] = v; o[j] = v; s2 += v * v; }
            (void)o; }
        const float r2 = rsqrtf(wave_sum(s2) * (1.0f / DM) + EPS);
        float hv[16]; float am = 0.f;
#pragma unroll
        for (int i = 0; i < 4; ++i) { const int d = 4 * lane + 256 * i; const f32x4 g2 = *(const f32x4*)(pre_g2 + d), sc = *(const f32x4*)(mb + 4096 + d), sh = *(const f32x4*)(mb + 3072 + d);
#pragma unroll
            for (int j = 0; j < 4; ++j) { const float o = xv[4 * i + j] * r2 * g2[j] * (1.0f + sc[j]) + sh[j]; hv[4 * i + j] = o; am = fmaxf(am, fabsf(o)); }
        }
        am = fmaxf(wave_max(am), 1e-30f);
        const float sx = 224.0f / am;
        if (lane == 0) XSC[row] = am * (1.0f / 224.0f);
#pragma unroll
        for (int i = 0; i < 4; ++i) { const int d = 4 * lane + 256 * i;
            const float v0 = hv[4 * i] * sx, v1 = hv[4 * i + 1] * sx, v2 = hv[4 * i + 2] * sx, v3 = hv[4 * i + 3] * sx;
            int ph = __builtin_amdgcn_cvt_pk_fp8_f32(v0, v1, 0, false); ph = __builtin_amdgcn_cvt_pk_fp8_f32(v2, v3, ph, true);
            *(int*)(XH + (size_t)row * DM + d) = ph; }
    }
}

DEVI unsigned f2ord(float f) { const unsigned u = __float_as_uint(f); return u ^ ((u >> 31) ? 0xFFFFFFFFu : 0x80000000u); }
DEVI float ord2f(unsigned u) { const unsigned b = (u & 0x80000000u) ? (u ^ 0x80000000u) : ~u; return __uint_as_float(b); }
#define BITONIC_SORT16(N) do { _Pragma("unroll") for (int k_ = 2; k_ <= 16; k_ <<= 1) _Pragma("unroll") for (int j_ = k_ >> 1; j_ > 0; j_ >>= 1) _Pragma("unroll") for (int i_ = 0; i_ < 16; ++i_) { const int l_ = i_ ^ j_; \
    if (l_ > i_) { const unsigned a_ = N[i_], b_ = N[l_]; const unsigned hi_ = a_ > b_ ? a_ : b_, lo_ = a_ > b_ ? b_ : a_; if ((i_ & k_) == 0) { N[i_] = hi_; N[l_] = lo_; } else { N[i_] = lo_; N[l_] = hi_; } } } } while (0)
#define BITONIC_MERGE16(L, N) do { _Pragma("unroll") for (int i_ = 0; i_ < 16; ++i_) { const unsigned a_ = L[i_], b_ = N[15 - i_]; L[i_] = a_ > b_ ? a_ : b_; } \
    _Pragma("unroll") for (int j_ = 8; j_ > 0; j_ >>= 1) _Pragma("unroll") for (int i_ = 0; i_ < 16; ++i_) { const int l_ = i_ ^ j_; if (l_ > i_) { const unsigned a_ = L[i_], b_ = L[l_]; L[i_] = a_ > b_ ? a_ : b_; L[l_] = a_ > b_ ? b_ : a_; } } } while (0)
#define INSERT16(L, key) do { unsigned _k = (key); _Pragma("unroll") for (int _i = 0; _i < 16; ++_i) { const unsigned _h = L[_i] > _k ? L[_i] : _k; _k = L[_i] > _k ? _k : L[_i]; L[_i] = _h; } } while (0)
DEVI void p9_route(const bf16* __restrict__ QP, const float* __restrict__ subk, unsigned short* __restrict__ EID, float* __restrict__ GATE, unsigned char* lds, int tid, int bid, int G) {
    typedef short bf16x8_t __attribute__((ext_vector_type(8)));
    constexpr int SKROW = 144;
    unsigned char* skb = lds;
    const int lane = tid & 63, w = tid >> 6, li = lane & 15, g = lane >> 4;
    float* scr = (float*)(lds + 40960 + w * 5120);
    unsigned char* ixs = lds + 81920 + tid * 32;
    for (int i = tid; i < 2 * 128 * 8; i += NTHR) { const int row = i >> 3, c8 = i & 7; const float* sp = subk + row * 64 + c8 * 8;
        const f32x4 a = *(const f32x4*)sp, b = *(const f32x4*)(sp + 4);
        *(v4u*)(skb + row * SKROW + c8 * 16) = (v4u){pk2(a[0], a[1]), pk2(a[2], a[3]), pk2(b[0], b[1]), pk2(b[2], b[3])}; }
    __syncthreads();
    for (int base = bid * NTHR; base < NT * NH; base += G * NTHR) {
        const int idx = base + tid, t = idx >> 3, h = idx & 7;
        unsigned L[2][16];
#pragma unroll
        for (int hf = 0; hf < 2; ++hf) {
#pragma unroll
            for (int i = 0; i < 16; ++i) L[hf][i] = 0u;
            bf16x8_t af[4][2];
#pragma unroll
            for (int rt = 0; rt < 4; ++rt) { const int row = base + 64 * w + 16 * rt + li; const bf16* qp = QP + (size_t)(row >> 3) * 1024 + (row & 7) * 128 + hf * 64 + 8 * g;
                af[rt][0] = *(const bf16x8_t*)qp; af[rt][1] = *(const bf16x8_t*)(qp + 32); }
#pragma unroll 1
            for (int kt = 0; kt < 8; ++kt) {
                const unsigned char* bp = skb + (hf * 128 + 16 * kt + li) * SKROW + 16 * g;
                const bf16x8_t b0 = *(const bf16x8_t*)bp, b1 = *(const bf16x8_t*)(bp + 64);
#pragma unroll
                for (int rt = 0; rt < 4; ++rt) {
                    f32x4 d = __builtin_amdgcn_mfma_f32_16x16x32_bf16(af[rt][0], b0, (f32x4){0.f, 0.f, 0.f, 0.f}, 0, 0, 0);
                    d = __builtin_amdgcn_mfma_f32_16x16x32_bf16(af[rt][1], b1, d, 0, 0, 0);
#pragma unroll
                    for (int j = 0; j < 4; ++j) scr[(16 * rt + 4 * g + j) * 20 + li] = d[j];
                }
                asm volatile("s_waitcnt lgkmcnt(0)" ::: "memory");
                f32x4 sv[4];
#pragma unroll
                for (int c4 = 0; c4 < 4; ++c4) sv[c4] = *(const f32x4*)(scr + lane * 20 + 4 * c4);
                asm volatile("s_waitcnt lgkmcnt(0)" ::: "memory");
                unsigned N[16];
#pragma unroll
                for (int c = 0; c < 16; ++c) N[c] = (f2ord(sv[c >> 2][c & 3]) & ~0x7Fu) | (unsigned)(127 - (16 * kt + c));
#pragma unroll
                for (int k = 2; k <= 16; k <<= 1)
#pragma unroll
                    for (int j = k >> 1; j > 0; j >>= 1)
#pragma unroll
                        for (int i = 0; i < 16; ++i) { const int l = i ^ j;
                            if (l > i) { const unsigned a = N[i], b = N[l]; const unsigned hi = a > b ? a : b, lo = a > b ? b : a;
                                if ((i & k) == 0) { N[i] = hi; N[l] = lo; } else { N[i] = lo; N[l] = hi; } } }
                if (kt == 0) {
#pragma unroll
                    for (int i = 0; i < 16; ++i) L[hf][i] = N[i];
                } else {
#pragma unroll
                    for (int i = 0; i < 16; ++i) { const unsigned a = L[hf][i], b = N[15 - i]; L[hf][i] = a > b ? a : b; }
#pragma unroll
                    for (int j = 8; j > 0; j >>= 1)
#pragma unroll
                        for (int i = 0; i < 16; ++i) { const int l = i ^ j;
                            if (l > i) { const unsigned a = L[hf][i], b = L[hf][l]; L[hf][i] = a > b ? a : b; L[hf][l] = a > b ? b : a; } }
                }
            }
        }
        float v1[16], v2[16];
#pragma unroll
        for (int i = 0; i < 16; ++i) { v1[i] = ord2f(L[0][i] & ~0x7Fu); v2[i] = ord2f(L[1][i] & ~0x7Fu); ixs[i] = (unsigned char)(127u - (L[0][i] & 0x7Fu)); ixs[16 + i] = (unsigned char)(127u - (L[1][i] & 0x7Fu)); }
        unsigned C[16];
        {
            unsigned N0[16] = {(f2ord(v1[0] + v2[0]) & ~0xFFu) | 255u, (f2ord(v1[0] + v2[1]) & ~0xFFu) | 254u, (f2ord(v1[0] + v2[2]) & ~0xFFu) | 253u, (f2ord(v1[0] + v2[3]) & ~0xFFu) | 252u, (f2ord(v1[0] + v2[4]) & ~0xFFu) | 251u, (f2ord(v1[0] + v2[5]) & ~0xFFu) | 250u, (f2ord(v1[0] + v2[6]) & ~0xFFu) | 249u, (f2ord(v1[0] + v2[7]) & ~0xFFu) | 248u, (f2ord(v1[0] + v2[8]) & ~0xFFu) | 247u, (f2ord(v1[0] + v2[9]) & ~0xFFu) | 246u, (f2ord(v1[0] + v2[10]) & ~0xFFu) | 245u, (f2ord(v1[0] + v2[11]) & ~0xFFu) | 244u, (f2ord(v1[0] + v2[12]) & ~0xFFu) | 243u, (f2ord(v1[0] + v2[13]) & ~0xFFu) | 242u, (f2ord(v1[0] + v2[14]) & ~0xFFu) | 241u, (f2ord(v1[0] + v2[15]) & ~0xFFu) | 240u};
            BITONIC_SORT16(N0);
            unsigned N1[16] = {(f2ord(v1[1] + v2[0]) & ~0xFFu) | 239u, (f2ord(v1[1] + v2[1]) & ~0xFFu) | 238u, (f2ord(v1[1] + v2[2]) & ~0xFFu) | 237u, (f2ord(v1[1] + v2[3]) & ~0xFFu) | 236u, (f2ord(v1[1] + v2[4]) & ~0xFFu) | 235u, (f2ord(v1[1] + v2[5]) & ~0xFFu) | 234u, (f2ord(v1[1] + v2[6]) & ~0xFFu) | 233u, (f2ord(v1[1] + v2[7]) & ~0xFFu) | 232u, (f2ord(v1[2] + v2[0]) & ~0xFFu) | 223u, (f2ord(v1[2] + v2[1]) & ~0xFFu) | 222u, (f2ord(v1[2] + v2[2]) & ~0xFFu) | 221u, (f2ord(v1[2] + v2[3]) & ~0xFFu) | 220u, (f2ord(v1[2] + v2[4]) & ~0xFFu) | 219u, (f2ord(v1[3] + v2[0]) & ~0xFFu) | 207u, (f2ord(v1[3] + v2[1]) & ~0xFFu) | 206u, (f2ord(v1[3] + v2[2]) & ~0xFFu) | 205u};
            BITONIC_SORT16(N1);
            unsigned N2[16] = {(f2ord(v1[3] + v2[3]) & ~0xFFu) | 204u, (f2ord(v1[4] + v2[0]) & ~0xFFu) | 191u, (f2ord(v1[4] + v2[1]) & ~0xFFu) | 190u, (f2ord(v1[4] + v2[2]) & ~0xFFu) | 189u, (f2ord(v1[5] + v2[0]) & ~0xFFu) | 175u, (f2ord(v1[5] + v2[1]) & ~0xFFu) | 174u, (f2ord(v1[6] + v2[0]) & ~0xFFu) | 159u, (f2ord(v1[6] + v2[1]) & ~0xFFu) | 158u, (f2ord(v1[7] + v2[0]) & ~0xFFu) | 143u, (f2ord(v1[7] + v2[1]) & ~0xFFu) | 142u, (f2ord(v1[8] + v2[0]) & ~0xFFu) | 127u, (f2ord(v1[9] + v2[0]) & ~0xFFu) | 111u, (f2ord(v1[10] + v2[0]) & ~0xFFu) | 95u, (f2ord(v1[11] + v2[0]) & ~0xFFu) | 79u, (f2ord(v1[12] + v2[0]) & ~0xFFu) | 63u, (f2ord(v1[13] + v2[0]) & ~0xFFu) | 47u};
            BITONIC_SORT16(N2);
            unsigned N3[16] = {(f2ord(v1[14] + v2[0]) & ~0xFFu) | 31u, (f2ord(v1[15] + v2[0]) & ~0xFFu) | 15u, 0u, 0u, 0u, 0u, 0u, 0u, 0u, 0u, 0u, 0u, 0u, 0u, 0u, 0u};
            BITONIC_SORT16(N3);
#pragma unroll
            for (int i = 0; i < 16; ++i) C[i] = N0[i];
            BITONIC_MERGE16(C, N1);
            BITONIC_MERGE16(C, N2);
            BITONIC_MERGE16(C, N3);
        }
        const float m = ord2f(C[0] & ~0xFFu);
        float p[16]; float sum = 0.f;
#pragma unroll
        for (int k = 0; k < 16; ++k) { p[k] = __expf(ord2f(C[k] & ~0xFFu) - m); sum += p[k]; }
        const float inv = 1.0f / sum;
        unsigned ev[16];
#pragma unroll
        for (int k = 0; k < 16; ++k) { const unsigned code = 255u - (C[k] & 0xFFu); ev[k] = (unsigned)ixs[code >> 4] * 128u + (unsigned)ixs[16 + (code & 15u)]; }
        { v4u* eo = (v4u*)(EID + (size_t)t * 128 + h * 16);
          eo[0] = (v4u){ev[0] | (ev[1] << 16), ev[2] | (ev[3] << 16), ev[4] | (ev[5] << 16), ev[6] | (ev[7] << 16)};
          eo[1] = (v4u){ev[8] | (ev[9] << 16), ev[10] | (ev[11] << 16), ev[12] | (ev[13] << 16), ev[14] | (ev[15] << 16)};
          f32x4* go = (f32x4*)(GATE + (size_t)t * 128 + h * 16);
#pragma unroll
          for (int k4 = 0; k4 < 4; ++k4) go[k4] = (f32x4){p[4 * k4] * inv, p[4 * k4 + 1] * inv, p[4 * k4 + 2] * inv, p[4 * k4 + 3] * inv}; }
    }
    __syncthreads();
}

constexpr int NSL = 8, SLD = 128, PCH = 256, NPCH = NT / PCH;
template <int CTRL> DEVI float dppf(float x) { return __builtin_bit_cast(float, __builtin_amdgcn_mov_dpp(__builtin_bit_cast(int, x), CTRL, 0xf, 0xf, true)); }
DEVI int shfl_i(int v, int srclane) { return __builtin_amdgcn_ds_bpermute(srclane << 2, v); }

DEVI void dma16(const void* gsrc, LAS unsigned char* lds_wave_base) { __builtin_amdgcn_global_load_lds((const unsigned*)gsrc, (LAS unsigned*)lds_wave_base, 16, 0, 0); }
DEVI long mk64(unsigned lo, unsigned hi) { return (long)(((unsigned long long)hi << 32) | (unsigned long long)lo); }
DEVI void peer_u_issue_half(unsigned e01, int h, const unsigned char* __restrict__ tb, LAS unsigned char* buf, int lane) {
#pragma unroll
    for (int i = 0; i < 8; ++i) {
        const unsigned ee = (unsigned)shfl_i((int)e01, 32 * h + 4 * i + (lane >> 4)); const unsigned e = (ee >> (16 * ((lane >> 3) & 1))) & 0xFFFFu;
        const unsigned c = (unsigned)(lane & 7) ^ (unsigned)((4 * i + (lane >> 4)) & 7);
        dma16(tb + (e * (unsigned)SLD + c * 16u), buf + 1024 * i);
    }
}
DEVI void peer_u_compute_half(LAS unsigned char* buf, int h, const long (&bh)[4], f32x4& sel, int lane) {
    const int r = lane & 15, kg = lane >> 4, swz = (r >> 1) & 7;
    const unsigned aA = (unsigned)(size_t)(buf + r * 128 + (((2 * kg) ^ swz) << 4)), aB = (unsigned)(size_t)(buf + r * 128 + (((2 * kg + 1) ^ swz) << 4));
    v4u pa[4], pb[4];
    asm volatile("ds_read_b128 %0, %8\n\tds_read_b128 %1, %9\n\tds_read_b128 %2, %8 offset:2048\n\tds_read_b128 %3, %9 offset:2048\n\t"
                 "ds_read_b128 %4, %8 offset:4096\n\tds_read_b128 %5, %9 offset:4096\n\tds_read_b128 %6, %8 offset:6144\n\tds_read_b128 %7, %9 offset:6144\n\ts_waitcnt lgkmcnt(0)"
                 : "=&v"(pa[0]), "=&v"(pb[0]), "=&v"(pa[1]), "=&v"(pb[1]), "=&v"(pa[2]), "=&v"(pb[2]), "=&v"(pa[3]), "=&v"(pb[3]) : "v"(aA), "v"(aB) : "memory");
    typedef int i32x8_u __attribute__((ext_vector_type(8)));
    const i32x8_u bx = {(int)(unsigned)bh[0], (int)(unsigned)(bh[0] >> 32), (int)(unsigned)bh[1], (int)(unsigned)(bh[1] >> 32), (int)(unsigned)bh[2], (int)(unsigned)(bh[2] >> 32), (int)(unsigned)bh[3], (int)(unsigned)(bh[3] >> 32)};
#pragma unroll
    for (int T = 0; T < 4; ++T) {
        const i32x8_u a8 = {(int)pa[T].x, (int)pa[T].y, (int)pa[T].z, (int)pa[T].w, (int)pb[T].x, (int)pb[T].y, (int)pb[T].z, (int)pb[T].w};
        const f32x4 ah = __builtin_amdgcn_mfma_scale_f32_16x16x128_f8f6f4(a8, bx, (f32x4){0.f, 0.f, 0.f, 0.f}, 0, 0, 0, 0, 0, 0);
        sel = (r == 4 * h + T) ? ah : sel;
    }
}
DEVI void rec_issue(const unsigned char* p_eid, const unsigned char* p_aux, const unsigned char* p_sc, LAS unsigned char* rec, int lane) {
    const unsigned char* src = lane < 16 ? p_eid + 16 * lane : (lane < 24 ? p_aux + 16 * (lane - 16) : (lane == 24 ? p_sc : p_eid));
    dma16(src, rec);
}
DEVI void rec_read(LAS unsigned char* rec, int lane, unsigned& e01, v4u& a0, v4u& a1, unsigned (&sc4)[1], int scsel) {
    const unsigned ae = (unsigned)(size_t)(rec + 4 * lane), aa = (unsigned)(size_t)(rec + 256 + 32 * (lane >> 4)), as = (unsigned)(size_t)(rec + 384 + 4 * scsel);
    asm volatile("ds_read_b32 %0, %4\n\tds_read_b128 %1, %5\n\tds_read_b128 %2, %5 offset:16\n\tds_read_b32 %3, %6\n\ts_waitcnt lgkmcnt(0)"
                 : "=&v"(e01), "=&v"(a0), "=&v"(a1), "=&v"(sc4[0]) : "v"(ae), "v"(aa), "v"(as) : "memory");
}
DEVI void peer_u_tokens(int t0, int sl, const unsigned char* __restrict__ XH, const unsigned* __restrict__ EID32, const unsigned char* __restrict__ PUs, float* __restrict__ PART,
                        LAS unsigned char* wbuf, LAS unsigned char* rbuf, int lane) {
    constexpr int NTK = PCH / NWAVES;
    const int kg = lane >> 4;
    const unsigned char* tb = PUs + (size_t)sl * NEXP * SLD;
    LAS unsigned char* buf0 = wbuf; LAS unsigned char* buf1 = wbuf + 8192;
    unsigned e_cur; v4u x0, x1; unsigned scd[1];
    asm volatile("s_waitcnt lgkmcnt(0)" ::: "memory");
    rec_issue((const unsigned char*)(EID32 + (size_t)t0 * 64), XH + (size_t)t0 * DM + sl * SLD, (const unsigned char*)EID32, rbuf, lane);
    asm volatile("s_waitcnt vmcnt(0)" ::: "memory");
    rec_read(rbuf, lane, e_cur, x0, x1, scd, 0);
    peer_u_issue_half(e_cur, 0, tb, buf0, lane);
#pragma unroll 1
    for (int j = 0; j < NTK; ++j) {
        const int t = t0 + j; const int tn = (t + 1 < NT) ? t + 1 : t;
        LAS unsigned char* rnext = rbuf + 1024 * ((j + 1) & 1);
        rec_issue((const unsigned char*)(EID32 + (size_t)tn * 64), XH + (size_t)tn * DM + sl * SLD, (const unsigned char*)EID32, rnext, lane);
        peer_u_issue_half(e_cur, 1, tb, buf1, lane);
        asm volatile("s_waitcnt vmcnt(9)" ::: "memory");
        const long bh[4] = {mk64(x0.x, x0.y), mk64(x0.z, x0.w), mk64(x1.x, x1.y), mk64(x1.z, x1.w)};
        f32x4 sel = (f32x4){0.f, 0.f, 0.f, 0.f};
        peer_u_compute_half(buf0, 0, bh, sel, lane);
        asm volatile("s_waitcnt vmcnt(8)" ::: "memory");
        unsigned e_nn; v4u y0, y1;
        rec_read(rnext, lane, e_nn, y0, y1, scd, 0);
        peer_u_issue_half(e_nn, 0, tb, buf0, lane);
        asm volatile("s_waitcnt vmcnt(8)" ::: "memory");
        peer_u_compute_half(buf1, 1, bh, sel, lane);
        if ((lane & 15) < 8) { uint2 pw; pw.x = pk2(sel[0], sel[1]); pw.y = pk2(sel[2], sel[3]);
            *(uint2*)((bf16*)PART + ((size_t)sl * NT + t) * 128 + 16 * (lane & 15) + 4 * kg) = pw; }
        e_cur = e_nn; x0 = y0; x1 = y1;
    }
    asm volatile("s_waitcnt vmcnt(0)" ::: "memory");
}
DEVI void peer_v_compute_half(LAS unsigned char* buf, int h, const v4u& wa, const v4u& wb, f32x4 (&acc)[8], int lane) {
    const int li = lane & 15, kg = lane >> 4, q = li >> 1, p = li & 1;
    const int row = 8 * kg + q, swz = (row >> 1) & 7;
    const unsigned ab = (unsigned)(size_t)(buf + row * 128 + 8 * p);
    unsigned ad[8];
#pragma unroll
    for (int mt = 0; mt < 8; ++mt) ad[mt] = ab + (unsigned)((mt ^ swz) << 4);
    const unsigned w8[8] = {wa.x, wa.y, wa.z, wa.w, wb.x, wb.y, wb.z, wb.w};
#pragma unroll
    for (int sp = 0; sp < 2; ++sp) {
        long a[8];
        if (sp == 0) asm volatile("ds_read_b64_tr_b8 %0, %8\n\tds_read_b64_tr_b8 %1, %9\n\tds_read_b64_tr_b8 %2, %10\n\tds_read_b64_tr_b8 %3, %11\n\t"
                                  "ds_read_b64_tr_b8 %4, %12\n\tds_read_b64_tr_b8 %5, %13\n\tds_read_b64_tr_b8 %6, %14\n\tds_read_b64_tr_b8 %7, %15\n\ts_waitcnt lgkmcnt(0)"
                                  : "=&v"(a[0]), "=&v"(a[1]), "=&v"(a[2]), "=&v"(a[3]), "=&v"(a[4]), "=&v"(a[5]), "=&v"(a[6]), "=&v"(a[7])
                                  : "v"(ad[0]), "v"(ad[1]), "v"(ad[2]), "v"(ad[3]), "v"(ad[4]), "v"(ad[5]), "v"(ad[6]), "v"(ad[7]) : "memory");
        else asm volatile("ds_read_b64_tr_b8 %0, %8 offset:4096\n\tds_read_b64_tr_b8 %1, %9 offset:4096\n\tds_read_b64_tr_b8 %2, %10 offset:4096\n\tds_read_b64_tr_b8 %3, %11 offset:4096\n\t"
                          "ds_read_b64_tr_b8 %4, %12 offset:4096\n\tds_read_b64_tr_b8 %5, %13 offset:4096\n\tds_read_b64_tr_b8 %6, %14 offset:4096\n\tds_read_b64_tr_b8 %7, %15 offset:4096\n\ts_waitcnt lgkmcnt(0)"
                          : "=&v"(a[0]), "=&v"(a[1]), "=&v"(a[2]), "=&v"(a[3]), "=&v"(a[4]), "=&v"(a[5]), "=&v"(a[6]), "=&v"(a[7])
                          : "v"(ad[0]), "v"(ad[1]), "v"(ad[2]), "v"(ad[3]), "v"(ad[4]), "v"(ad[5]), "v"(ad[6]), "v"(ad[7]) : "memory");
        const int s = 2 * h + sp;
        const long bw = mk64(w8[2 * s], w8[2 * s + 1]);
#pragma unroll
        for (int mt = 0; mt < 8; ++mt) acc[mt] = __builtin_amdgcn_mfma_f32_16x16x32_fp8_fp8(a[mt], bw, acc[mt], 0, 0, 0);
    }
}
DEVI void peer_v_tokens(int t0, int sl, const unsigned char* __restrict__ WQ8, const float* __restrict__ WSC, const unsigned* __restrict__ EID32, const unsigned char* __restrict__ PVs,
                        bf16* __restrict__ Y2, LAS unsigned char* wbuf, LAS unsigned char* rbuf, int lane) {
    constexpr int NTK = PCH / NWAVES;
    const int kg = lane >> 4, n = lane & 15;
    const unsigned char* tb = PVs + (size_t)sl * NEXP * SLD;
    LAS unsigned char* buf0 = wbuf; LAS unsigned char* buf1 = wbuf + 8192;
    unsigned e_cur; v4u x0, x1; unsigned scb[1];
    asm volatile("s_waitcnt lgkmcnt(0)" ::: "memory");
    rec_issue((const unsigned char*)(EID32 + (size_t)t0 * 64), WQ8 + (size_t)t0 * 128, (const unsigned char*)(WSC + (t0 & ~3)), rbuf, lane);
    asm volatile("s_waitcnt vmcnt(0)" ::: "memory");
    rec_read(rbuf, lane, e_cur, x0, x1, scb, t0 & 3);
    unsigned sc_bits = scb[0];
    peer_u_issue_half(e_cur, 0, tb, buf0, lane);
#pragma unroll 1
    for (int j = 0; j < NTK; ++j) {
        const int t = t0 + j; const int tn = (t + 1 < NT) ? t + 1 : t;
        LAS unsigned char* rnext = rbuf + 1024 * ((j + 1) & 1);
        rec_issue((const unsigned char*)(EID32 + (size_t)tn * 64), WQ8 + (size_t)tn * 128, (const unsigned char*)(WSC + (tn & ~3)), rnext, lane);
        peer_u_issue_half(e_cur, 1, tb, buf1, lane);
        asm volatile("s_waitcnt vmcnt(9)" ::: "memory");
        f32x4 acc[8];
#pragma unroll
        for (int mt = 0; mt < 8; ++mt) acc[mt] = (f32x4){0.f, 0.f, 0.f, 0.f};
        peer_v_compute_half(buf0, 0, x0, x1, acc, lane);
        asm volatile("s_waitcnt vmcnt(8)" ::: "memory");
        unsigned e_nn; v4u y0, y1;
        rec_read(rnext, lane, e_nn, y0, y1, scb, tn & 3);
        peer_u_issue_half(e_nn, 0, tb, buf0, lane);
        asm volatile("s_waitcnt vmcnt(8)" ::: "memory");
        peer_v_compute_half(buf1, 1, x0, x1, acc, lane);
        f32x4 sel = acc[0];
#pragma unroll
        for (int mt = 1; mt < 8; ++mt) sel = (n == mt) ? acc[mt] : sel;
        const float sc = __uint_as_float(sc_bits);
        if (n < 8) { uint2 o; o.x = pk2(sel[0] * sc, sel[1] * sc); o.y = pk2(sel[2] * sc, sel[3] * sc);
            *(uint2*)(Y2 + (size_t)t * DM + sl * SLD + 16 * n + 4 * kg) = o; }
        e_cur = e_nn; x0 = y0; x1 = y1; sc_bits = scb[0];
    }
    asm volatile("s_waitcnt vmcnt(0)" ::: "memory");
}
template <bool UPASS>
DEVI void peer_pass(unsigned* __restrict__ qcnt, const unsigned char* __restrict__ XH, const unsigned char* __restrict__ XL, const float* __restrict__ W, const unsigned* __restrict__ EID32, const unsigned char* __restrict__ TAB,
                    float* __restrict__ PART, bf16* __restrict__ Y2, volatile LAS unsigned* MISC, unsigned char* ldsbase, int tid) {
    const int lane = tid & 63, wv = tid >> 6;
    const int pref = (int)(xb_xcc_id() & 7u);
    constexpr int NTK = PCH / NWAVES;
    unsigned live = 0xFFu;
#pragma unroll 1
    for (int k = 0; k < NSL; ++k) {
        const int sl = (pref + k) & (NSL - 1);
        if (k == 1) {
            __syncthreads();
            if (tid < 64) { const unsigned c = (tid < NSL) ? __hip_atomic_load(qcnt + 64 * tid, __ATOMIC_RELAXED, __HIP_MEMORY_SCOPE_AGENT) : (unsigned)NPCH;
                const unsigned long long m = __ballot(c < (unsigned)NPCH); if (tid == 0) MISC[17] = (unsigned)m; }
            __syncthreads();
            live = MISC[17];
        }
        if (!((live >> sl) & 1u)) continue;
#pragma unroll 1
        for (;;) {
            __syncthreads();
            if (tid == 0) MISC[16] = __hip_atomic_fetch_add(qcnt + 64 * sl, 1u, __ATOMIC_RELAXED, __HIP_MEMORY_SCOPE_AGENT);
            __syncthreads();
            const int it = (int)MISC[16];
            if (it >= NPCH) break;
            const int t0 = it * PCH + wv * NTK;
            if (UPASS) {
                peer_u_tokens(t0, sl, XH, EID32, TAB, PART, (LAS unsigned char*)ldsbase + wv * 16384, (LAS unsigned char*)ldsbase + 131072 + wv * 2048, lane);
            } else {
                peer_v_tokens(t0, sl, XH  , (const float*)XL  , EID32, TAB, Y2, (LAS unsigned char*)ldsbase + wv * 16384, (LAS unsigned char*)ldsbase + 131072 + wv * 2048, lane);
            }
        }
    }
}
DEVI void peer_reduce(const float* __restrict__ PART, const float* __restrict__ GATE, const unsigned short* __restrict__ EID, const float* __restrict__ USC, const float* __restrict__ VSC, const float* __restrict__ XSC,
                      unsigned char* __restrict__ WQ8, float* __restrict__ WSC, int gw, int nw, int lane) {
    for (int tp = gw; tp < NT / 2; tp += nw) {
        const int t = 2 * tp + (lane >> 5), i4 = lane & 31;
        const size_t i = (size_t)t * 32 + i4;
        f32x4 s = (f32x4){0.f, 0.f, 0.f, 0.f};
#pragma unroll
        for (int sl = 0; sl < NSL; ++sl) { const uint2 pw = *(const uint2*)((const bf16*)PART + (size_t)sl * NT * 128 + i * 4); s += (f32x4){bflo(pw.x), bfhi(pw.x), bflo(pw.y), bfhi(pw.y)}; }
        const f32x4 g = *(const f32x4*)(GATE + i * 4);
        const uint2 ee = *(const uint2*)(EID + i * 4);
        const unsigned e[4] = {ee.x & 0xFFFFu, ee.x >> 16, ee.y & 0xFFFFu, ee.y >> 16};
        const float xs = XSC[t];
        float o[4]; float am = 0.f;
#pragma unroll
        for (int j = 0; j < 4; ++j) { o[j] = g[j] * gelu_tanh(s[j] * USC[e[j]] * xs) * VSC[e[j]]; am = fmaxf(am, fabsf(o[j])); }
#pragma unroll
        for (int m = 16; m > 0; m >>= 1) am = fmaxf(am, __shfl_xor(am, m));
        am = fmaxf(am, 1e-30f);
        const float inv = 224.0f / am;
        int pk = __builtin_amdgcn_cvt_pk_fp8_f32(o[0] * inv, o[1] * inv, 0, false); pk = __builtin_amdgcn_cvt_pk_fp8_f32(o[2] * inv, o[3] * inv, pk, true);
        const int p0 = 4 * i4, sK = p0 >> 5, kgK = (p0 >> 3) & 3, jK = p0 & 7;
        *(int*)(WQ8 + (size_t)t * 128 + kgK * 32 + sK * 8 + jK) = pk;
        if (i4 == 0) WSC[t] = am * (1.0f / 224.0f);
    }
}
DEVI void p10_final(const float* __restrict__ x, const bf16* __restrict__ Y1, const bf16* __restrict__ Y2, const float* __restrict__ post_g1, const float* __restrict__ post_g2,
                    const float* __restrict__ mod, float* __restrict__ OUT, int gw, int nw, int lane) {
    for (int row = gw; row < NT; row += nw) {
        const int b = row >> 13; const float* mb = mod + b * 6144;
        float y1[16], y2[16]; float s1 = 0.f, s2 = 0.f;
#pragma unroll
        for (int i = 0; i < 4; ++i) { const int d = 4 * lane + 256 * i; const uint2 w1 = *(const uint2*)(Y1 + (size_t)row * DM + d), w2 = *(const uint2*)(Y2 + (size_t)row * DM + d);
            y1[4 * i + 0] = bflo(w1.x); y1[4 * i + 1] = bfhi(w1.x); y1[4 * i + 2] = bflo(w1.y); y1[4 * i + 3] = bfhi(w1.y);
            y2[4 * i + 0] = bflo(w2.x); y2[4 * i + 1] = bfhi(w2.x); y2[4 * i + 2] = bflo(w2.y); y2[4 * i + 3] = bfhi(w2.y); }
#pragma unroll
        for (int j = 0; j < 16; ++j) { s1 += y1[j] * y1[j]; s2 += y2[j] * y2[j]; }
        const float r1 = rsqrtf(wave_sum(s1) * (1.0f / DM) + EPS), r2 = rsqrtf(wave_sum(s2) * (1.0f / DM) + EPS);
#pragma unroll
        for (int i = 0; i < 4; ++i) { const int d = 4 * lane + 256 * i;
            const f32x4 xx = *(const f32x4*)(x + (size_t)row * DM + d), g1 = *(const f32x4*)(post_g1 + d), g2 = *(const f32x4*)(post_g2 + d), gt1 = *(const f32x4*)(mb + 2048 + d), gt2 = *(const f32x4*)(mb + 5120 + d);
            f32x4 res;
#pragma unroll
            for (int j = 0; j < 4; ++j) { const float x1 = xx[j] + gt1[j] * (y1[4 * i + j] * r1 * g1[j]); res[j] = x1 + gt2[j] * (y2[4 * i + j] * r2 * g2[j]); }
            *(f32x4*)(OUT + (size_t)row * DM + d) = res; }
    }
}

__global__ void __launch_bounds__(NTHR, 2) fwd_kernel(Args args) {
    extern __shared__ __attribute__((aligned(16))) unsigned char lds[];
    const int tid = threadIdx.x, lane = tid & 63, wave = __builtin_amdgcn_readfirstlane(tid >> 6);
    const int G = gridDim.x, bid = blockIdx.x;
    const int gw = __builtin_amdgcn_readfirstlane(bid * NWAVES + wave), nw = G * NWAVES;
    unsigned char* ws = args.ws;
    volatile LAS unsigned* MISC = (volatile LAS unsigned*)((LAS unsigned char*)lds + MISC_OFF);
    if (tid < 64) MISC[tid] = 0u;
    __syncthreads();
#if MK_ONE_LAUNCH
    XcdBarrier bar = xcd_barrier_post((unsigned*)(ws + WS_CTL) + 1024, MISC + 8);
#define GRID_BAR() xcd_barrier(bar)
#else
#define GRID_BAR() do { } while (0)
#endif
    const int lo = args.ph_lo, hi = args.ph_hi;
#define IN(k) (lo <= (k) && (k) < hi)
#define SEAM(k) do { if (IN(k) && IN((k) + 1)) GRID_BAR(); } while (0)

    float* MOD = (float*)(ws + WS_MOD); float* KM = (float*)(ws + WS_KM); float* BIAS = (float*)(ws + WS_BIAS);
    bf16* WIN = (bf16*)(ws + WS_WIN); bf16* WBA = (bf16*)(ws + WS_WBA); bf16* WBG = (bf16*)(ws + WS_WBG); bf16* WOUT = (bf16*)(ws + WS_WOUT); bf16* WQ = (bf16*)(ws + WS_WQ);
    const unsigned char* PU = ws + WS_PU; const unsigned char* PV = ws + WS_PV; const float* USC = (const float*)(ws + WS_USC); const float* VSC = (const float*)(ws + WS_VSC);
    bf16* H1 = (bf16*)(ws + WS_A); bf16* MERGED = H1; bf16* H2 = H1;
    bf16* Qb = (bf16*)(ws + WS_B); bf16* Kb = Qb + (size_t)NT * 512; bf16* Vb = Kb + (size_t)NT * 512;
    bf16* Yb = Qb; bf16* QP = (bf16*)(ws + WS_QP);
    bf16* Ub = (bf16*)(ws + WS_C); bf16* GVb = Ub + (size_t)NT * 512;
    float* PART = (float*)(ws + WS_PART); float* PW = (float*)(ws + WS_PW); unsigned short* EID = (unsigned short*)(ws + WS_EID); float* GATE = (float*)(ws + WS_GATE); bf16* Y2 = H1;
    unsigned* QCNT = (unsigned*)(ws + WS_CTL) + 8192; unsigned* GCNT = (unsigned*)(ws + WS_CTL) + 12288; unsigned* QATT = (unsigned*)(ws + WS_CTL) + 13376;
    unsigned char* WQ8 = ws + WS_PW; float* WSC = (float*)(ws + WS_XSC + 131072);
    unsigned short* GLIST = (unsigned short*)(ws + WS_WIN); unsigned char* POa = ws + WS_A; unsigned char* POc = ws + WS_C; float* PMp = (float*)(ws + 500 * MiB); float* PLp = (float*)(ws + 504 * MiB);
    unsigned char* XH = ws + WS_XH; unsigned char* XL = ws + WS_XL; float* XSC = (float*)(ws + WS_XSC);
    bf16* GA = (bf16*)(ws + WS_D); bf16* GG = GA + (size_t)NT * 1024;
    bf16* YA = (bf16*)(ws + WS_E); bf16* YG = YA;
    LAS unsigned char* ring = (LAS unsigned char*)lds;
#define LV(x) ({ int t_ = (x); asm volatile("" : "+v"(t_)); t_; })
#define LS(x) ({ int t_ = (x); asm volatile("" : "+s"(t_)); t_; })

    if (IN(0)) { p0_prologue(args, lds, LV(tid), bid, G); }
    SEAM(0);
    if (IN(1)) { p1_prenorm(args.in[0], args.in[4], MOD, 0, 1024, H1, ws + WS_H8, (float*)(ws + WS_HS), LS(gw), nw, LV(lane)); }
    SEAM(1);
    if (IN(2)) {
        { pg8::Gemm g{H1, WIN, NT, 1024, DM}; pg8::StaticOrder S; S.init(NT, 1024, G, bid); pg8::EpiIn E{Qb, Kb, Vb, Ub, GVb, GA, GG, KM, ring + RING_BYTES};
          pg8::gemm_phase<pg8::EpiIn, pg8::StaticOrder, true, true>(ring, g, S, E); }
        { pg8::Gemm g{(const bf16*)(ws + WS_H8), (const bf16*)(ws + WS_WIN8), NT, INW - 1024, DM / 2}; pg8::StaticOrder S; S.init(NT, INW - 1024, G, bid);
          pg8::EpiIn8 E{Vb, Ub, GVb, GA, GG, (const float*)(ws + WS_HS), (const float*)(ws + WS_WIN8S), ring + RING_BYTES};
          pg8::gemm_phase<pg8::EpiIn8, pg8::StaticOrder, true, true, true>(ring, g, S, E); }
    }
    SEAM(2);
    if (IN(3)) {
        for (int u = bid; u < NB * 64; u += G) p4_gmlp_unit(u, Ub, GVb, args.in[7], args.in[8], args.in[9], args.in[10], YG, lds, LV(tid));
#pragma unroll 1
        for (int u = bid; u < NB * NH * 32; u += G) kbs::select_unit(u >> 5, (u + (u >> 8) * 8) & 31, Qb, KM, GCNT, GLIST, lds, LV(tid));
    }
    SEAM(3);
    if (IN(4)) { kbs::attn_items(Qb, Kb, Vb, BIAS, GCNT, GLIST, QATT, POa, POc, PMp, PLp, lds, MISC, LV(tid)); }
    SEAM(4);
    if (IN(5)) { kbs::merge_partials(POa, POc, PMp, PLp, YA, LS(gw), nw, LV(lane)); }
    SEAM(5);
    if (IN(6)) {
        pg8::Gemm g{YA, WBA, NT, DM, DM}; pg8::StaticOrder S; S.init(NT, DM, G, bid); pg8::EpiMerge E{GA, GG, MERGED, ring + RING_BYTES};
        pg8::gemm_phase<pg8::EpiMerge, pg8::StaticOrder, true, true>(ring, g, S, E);
    }
    SEAM(6);
    if (IN(7)) {
        pg8::Gemm g{MERGED, WOUT, NT, DM, DM}; pg8::StaticOrder S; S.init(NT, DM, G, bid); pg8::EpiPlain E{Yb, DM, ring + RING_BYTES};
        pg8::gemm_phase<pg8::EpiPlain, pg8::StaticOrder, true, true>(ring, g, S, E);
    }
    SEAM(7);
    if (IN(8)) { p7_mid(args.in[0], Yb, args.in[5], args.in[15], MOD, args.out, H2, XH, XL, XSC, LS(gw), nw, LV(lane)); }
    SEAM(8);
    if (IN(9)) {
        pg8::Gemm g{(const bf16*)XH, (const bf16*)(ws + WS_WQ), NT, DM, DM / 2}; pg8::StaticOrder S; S.init(NT, DM, G, bid);
        pg8::EpiPlain8 E{QP, DM, XSC, (const float*)(ws + WS_WQ + MiB), ring + RING_BYTES};
        pg8::gemm_phase<pg8::EpiPlain8, pg8::StaticOrder, true, true, true>(ring, g, S, E);
    }
    SEAM(9);
    if (IN(10)) { p9_route(QP, args.in[18], EID, GATE, lds, LV(tid), bid, G); }
    SEAM(10);
    if (IN(11)) { peer_pass<true>(QCNT, XH, XL, nullptr, (const unsigned*)EID, PU, PART, nullptr, MISC, lds, LV(tid)); }
    SEAM(11);
    if (IN(12)) { peer_reduce(PART, GATE, EID, USC, VSC, XSC, WQ8, WSC, LS(gw), nw, LV(lane)); }
    SEAM(12);
    if (IN(13)) { peer_pass<false>(QCNT + 64 * NSL, WQ8, (const unsigned char*)WSC, nullptr, (const unsigned*)EID, PV, nullptr, Y2, MISC, lds, LV(tid)); }
    SEAM(13);
    if (IN(14)) { p10_final(args.in[0], Yb, Y2, args.in[5], args.in[16], MOD, args.out, LS(gw), nw, LV(lane)); }
#undef IN
#undef SEAM
}

extern "C" void kernel_launch(void* const* d_in, const int* in_sizes, int n_in, void* d_out, int out_size, void* d_ws, size_t ws_size, hipStream_t stream) {
    static int grid = 0;
    if (grid == 0) {
        if (n_in != 21 || out_size != NT * DM || ws_size < WS_END) { fprintf(stderr, "kernel_launch: unexpected shapes (n_in %d out %d ws %zu)\n", n_in, out_size, ws_size); grid = -1; return; }
        int dev = 0, cus = 0, per_cu = 0;
        if (hipGetDevice(&dev) != hipSuccess || hipDeviceGetAttribute(&cus, hipDeviceAttributeMultiprocessorCount, dev) != hipSuccess) { grid = -1; return; }
        if (hipFuncSetAttribute((const void*)fwd_kernel, hipFuncAttributeMaxDynamicSharedMemorySize, LDS_BYTES) != hipSuccess) { fprintf(stderr, "kernel_launch: hipFuncSetAttribute failed\n"); grid = -1; return; }
        if (hipOccupancyMaxActiveBlocksPerMultiprocessor(&per_cu, (const void*)fwd_kernel, NTHR, LDS_BYTES) != hipSuccess || per_cu < 1) { fprintf(stderr, "kernel_launch: occupancy query says %d\n", per_cu); (void)hipGetLastError(); per_cu = 1; }
        grid = cus;
    }
    if (grid < 0) return;
    (void)hipMemsetAsync((char*)d_ws + WS_CTL, 0, CTL_ZERO_BYTES, stream);
    Args a{};
    for (int i = 0; i < 21; ++i) a.in[i] = (const float*)d_in[i];
    a.out = (float*)d_out; a.ws = (unsigned char*)d_ws;
#if MK_ONE_LAUNCH
    a.ph_lo = 0; a.ph_hi = NPH;
    hipLaunchKernelGGL(fwd_kernel, dim3(grid), dim3(NTHR), LDS_BYTES, stream, a);
#else
    for (int p = 0; p < NPH; ++p) { a.ph_lo = p; a.ph_hi = p + 1; hipLaunchKernelGGL(fwd_kernel, dim3(grid), dim3(NTHR), LDS_BYTES, stream, a); }
#endif
}
```

```cpp
#include <hip/hip_runtime.h>
#include <cstdio>
#include <cstdint>
namespace pg8 {
#define PG8_LAS __attribute__((address_space(3)))
typedef unsigned short bf16_t;
typedef short bf16x8 __attribute__((ext_vector_type(8)));
typedef float f32x4 __attribute__((ext_vector_type(4)));
typedef unsigned u32x4 __attribute__((ext_vector_type(4)));
constexpr int BM = 256, BK = 64, HALF = 128, HTB = HALF * BK * 2  , STAGE_BYTES = 8 * HTB, NXCD = 8, WGM = 8;

__host__ __device__ __forceinline__ int lds_byte(int r, int c) { const int st = (r >> 4) * 2 + (c >> 5), rr = r & 15, cc = c & 31, ob = rr * 64 + cc * 2; return st * 1024 + (ob ^ (((ob >> 9) & 1) << 5)); }
__host__ __device__ __forceinline__ void stage_rc(int b, int& R, int& C) { const int st = b / 1024, sb = b % 1024, swz = sb ^ (((sb >> 9) & 1) << 5); R = (st >> 1) * 16 + swz / 64; C = (st & 1) * 32 + (swz % 64) / 2; }
__host__ __device__ __forceinline__ int perm32(int rho) { const int n = rho >> 4, i = rho & 15; return 8 * (i >> 2) + 4 * n + (i & 3); }

struct Unit { int pm, pn; };
struct Gemm { const bf16_t* A; const bf16_t* Bt; int M, N, K; };

struct StaticOrder {
    int nM, nN, nwg, G, c;
    __host__ __device__ void init(int M, int N, int G_, int c_) { nM = M / BM; nN = N / BM; nwg = nM * nN; G = G_; c = c_; }
    __host__ __device__ bool next(int i, Unit& u) const {
        const long L = (long)i * G + c; if (L >= nwg) return false;
        int wgid = (int)L; { const int q = nwg / NXCD, r = nwg % NXCD, xcd = wgid % NXCD, off = wgid / NXCD; wgid = (xcd < r ? xcd * (q + 1) : r * (q + 1) + (xcd - r) * q) + off; }
        const int nig = WGM * nN, gid = wgid / nig, fm = gid * WGM, gsz = (nM - fm) < WGM ? (nM - fm) : WGM;
        u.pm = fm + ((wgid % nig) % gsz); u.pn = (wgid % nig) / gsz; return true;
    }
    __device__ __forceinline__ void a_ready(const Unit&) const {}
    __device__ __forceinline__ void done(const Unit&) const {}
};

typedef __bf16 bf16x2_cv __attribute__((ext_vector_type(2)));
typedef float f32x2_cv __attribute__((ext_vector_type(2)));
__device__ __forceinline__ unsigned cvt_pk_bf16(float lo, float hi) { const f32x2_cv v = {lo, hi}; return __builtin_bit_cast(unsigned, __builtin_convertvector(v, bf16x2_cv)); }
__device__ __forceinline__ float bflo(unsigned u) { return __uint_as_float(u << 16); }
__device__ __forceinline__ float bfhi(unsigned u) { return __uint_as_float(u & 0xffff0000u); }
__device__ __forceinline__ float act_sigmoid(float x) { return __builtin_amdgcn_rcpf(1.0f + __builtin_amdgcn_exp2f(-1.4426950408889634f * x)); }
__device__ __forceinline__ float act_gelu(float x) { const float z = 1.5957691216057308f * (x + 0.044715f * x * x * x); return x * __builtin_amdgcn_rcpf(1.0f + __builtin_amdgcn_exp2f(-1.4426950408889634f * z)); }

struct RowStore {
    unsigned wofs, rofs; int r_, p_;
    __device__ __forceinline__ void init(PG8_LAS unsigned char* stg, int wr, int wc, int fr, int fq) {
        PG8_LAS unsigned char* sb = stg + (wr * 4 + wc) * 2048; const int l = fq * 16 + fr; r_ = l >> 2; p_ = l & 3;
        wofs = (unsigned)(size_t)(sb + fr * 64 + (((fq + (fr >> 2)) & 3) << 4)); rofs = (unsigned)(size_t)(sb + r_ * 64 + (((p_ + (r_ >> 2)) & 3) << 4));
    }
    template <int SLOT> __device__ __forceinline__ void get(const u32x4& g, u32x4& t) const {
        if constexpr (SLOT == 0) asm volatile("ds_write_b128 %1, %2\n\tds_read_b128 %0, %3" : "=&v"(t) : "v"(rofs), "v"(g), "v"(wofs));
        else asm volatile("ds_write_b128 %1, %2 offset:1024\n\tds_read_b128 %0, %3 offset:1024" : "=&v"(t) : "v"(rofs), "v"(g), "v"(wofs));
    }
    template <int SLOT> __device__ __forceinline__ void put(const u32x4& w, u32x4& t) const {
        if constexpr (SLOT == 0) asm volatile("ds_write_b128 %1, %2\n\tds_read_b128 %0, %3" : "=&v"(t) : "v"(wofs), "v"(w), "v"(rofs));
        else asm volatile("ds_write_b128 %1, %2 offset:1024\n\tds_read_b128 %0, %3 offset:1024" : "=&v"(t) : "v"(wofs), "v"(w), "v"(rofs));
    }
};
#define PG8_RS_WAIT(n, t) asm volatile("s_waitcnt lgkmcnt(" #n ")" : "+v"(t))
#define PG8_RS_EMIT(first, w, newptr) do { u32x4 t_; if (bj == 0) R.put<0>(w, t_); else R.put<1>(w, t_); \
        if (!(first)) { PG8_RS_WAIT(2, tprev); *(u32x4*)pprev = tprev; } tprev = t_; pprev = (newptr); } while (0)
#define PG8_RS_FLUSH() do { PG8_RS_WAIT(0, tprev); *(u32x4*)pprev = tprev; } while (0)

struct EpiIn {
    static constexpr bool PERM = true, AFTER_DRAIN = false, MIDK = false;
    bf16_t *Q, *Kk, *V, *U, *GV, *GA, *GG; float* KM; PG8_LAS unsigned char* stg;
    __device__ __forceinline__ void operator()(const f32x4 (&acc)[2][2][4][2], const Unit& u, int wr, int wc, int fr, int fq) const {
        const int pn = u.pn; bf16_t* base; int ldc, colt, act;
        if (pn < 2) { base = Q; ldc = 512; colt = pn * 256; act = 0; }
        else if (pn < 4) { base = Kk; ldc = 512; colt = (pn - 2) * 256; act = 0; }
        else if (pn < 6) { base = V; ldc = 512; colt = (pn - 4) * 256; act = 0; }
        else if (pn < 8) { base = U; ldc = 512; colt = (pn - 6) * 256; act = 1; }
        else if (pn < 10) { base = GV; ldc = 512; colt = (pn - 8) * 256; act = 1; }
        else if (pn < 14) { base = GA; ldc = 1024; colt = (pn - 10) * 256; act = 2; }
        else { base = GG; ldc = 1024; colt = (pn - 14) * 256; act = 2; }
        const int row0 = u.pm * BM + wr * 64 + fr, col0 = colt + wc * 32 + 8 * fq;
        if (pn == 2 || pn == 3) {
#pragma unroll
            for (int bj = 0; bj < 2; ++bj)
#pragma unroll
                for (int n = 0; n < 2; ++n) { f32x4 s = (f32x4){0.f, 0.f, 0.f, 0.f};
#pragma unroll
                    for (int ai = 0; ai < 2; ++ai)
#pragma unroll
                        for (int m = 0; m < 4; ++m) s += acc[ai][bj][m][n];
#pragma unroll
                    for (int j = 0; j < 4; ++j) { float t = s[j]; t += __shfl_xor(t, 1); t += __shfl_xor(t, 2); t += __shfl_xor(t, 4); t += __shfl_xor(t, 8); s[j] = t; }
                    if (fr == 0) { const int col = colt + bj * HALF + wc * 32 + 8 * fq + 4 * n;
                        float* kp = KM + ((size_t)(((u.pm >> 5) * 8 + (col >> 6)) * 32 + (u.pm & 31))) * 64 + (col & 63);
#pragma unroll
                        for (int j = 0; j < 4; ++j) atomicAdd(kp + j, s[j] * (1.0f / 256.0f)); } }
        }
        const float qs = pn < 2 ? 0.125f * 1.4426950408889634f : 1.0f;
        RowStore R; R.init(stg, wr, wc, fr, fq); bf16_t* pprev = nullptr; u32x4 tprev = (u32x4){0u, 0u, 0u, 0u};
        const int rowt0 = u.pm * BM + wr * 64 + R.r_, colw = colt + wc * 32 + 8 * R.p_;
#pragma unroll
        for (int ai = 0; ai < 2; ++ai)
#pragma unroll
            for (int m = 0; m < 4; ++m) {
#pragma unroll
                for (int bj = 0; bj < 2; ++bj) { f32x4 v0 = acc[ai][bj][m][0] * qs, v1 = acc[ai][bj][m][1] * qs;
                    u32x4 w; w.x = cvt_pk_bf16(v0[0], v0[1]); w.y = cvt_pk_bf16(v0[2], v0[3]); w.z = cvt_pk_bf16(v1[0], v1[1]); w.w = cvt_pk_bf16(v1[2], v1[3]);
                    PG8_RS_EMIT(ai + m + bj == 0, w, base + (size_t)(rowt0 + ai * HALF + m * 16) * ldc + colw + bj * HALF); } }
        PG8_RS_FLUSH();
    }
};
struct EpiGate {
    static constexpr bool PERM = true, AFTER_DRAIN = false, MIDK = false;
    const bf16_t* Gt; const bf16_t* Tin; bf16_t* O;
    __device__ __forceinline__ void operator()(const f32x4 (&acc)[2][2][4][2], const Unit& u, int wr, int wc, int fr, int fq) const {
        const int row0 = u.pm * BM + wr * 64 + fr, col0 = u.pn * BM + wc * 32 + 8 * fq;
#pragma unroll
        for (int ai = 0; ai < 2; ++ai)
#pragma unroll
            for (int m = 0; m < 4; ++m) { const size_t ro = (size_t)(row0 + ai * HALF + m * 16) * 1024 + col0;
#pragma unroll
                for (int bj = 0; bj < 2; ++bj) { const f32x4 v0 = acc[ai][bj][m][0], v1 = acc[ai][bj][m][1];
                    const u32x4 g = *(const u32x4*)(Gt + ro + bj * HALF);
                    float o[8];
                    o[0] = bflo(g.x) * v0[0]; o[1] = bfhi(g.x) * v0[1]; o[2] = bflo(g.y) * v0[2]; o[3] = bfhi(g.y) * v0[3];
                    o[4] = bflo(g.z) * v1[0]; o[5] = bfhi(g.z) * v1[1]; o[6] = bflo(g.w) * v1[2]; o[7] = bfhi(g.w) * v1[3];
                    if (Tin) { const u32x4 t = *(const u32x4*)(Tin + ro + bj * HALF);
                        o[0] += bflo(t.x); o[1] += bfhi(t.x); o[2] += bflo(t.y); o[3] += bfhi(t.y); o[4] += bflo(t.z); o[5] += bfhi(t.z); o[6] += bflo(t.w); o[7] += bfhi(t.w); }
                    u32x4 w; w.x = cvt_pk_bf16(o[0], o[1]); w.y = cvt_pk_bf16(o[2], o[3]); w.z = cvt_pk_bf16(o[4], o[5]); w.w = cvt_pk_bf16(o[6], o[7]);
                    *(u32x4*)(O + ro + bj * HALF) = w; } }
    }
};
struct EpiPlain {
    static constexpr bool PERM = true, AFTER_DRAIN = false, MIDK = false;
    bf16_t* O; int ldc; PG8_LAS unsigned char* stg;
    __device__ __forceinline__ void operator()(const f32x4 (&acc)[2][2][4][2], const Unit& u, int wr, int wc, int fr, int fq) const {
        RowStore R; R.init(stg, wr, wc, fr, fq); bf16_t* pprev = nullptr; u32x4 tprev = (u32x4){0u, 0u, 0u, 0u};
        const int rowt0 = u.pm * BM + wr * 64 + R.r_, colw = u.pn * BM + wc * 32 + 8 * R.p_;
#pragma unroll
        for (int ai = 0; ai < 2; ++ai)
#pragma unroll
            for (int m = 0; m < 4; ++m) {
#pragma unroll
                for (int bj = 0; bj < 2; ++bj) { const f32x4 v0 = acc[ai][bj][m][0], v1 = acc[ai][bj][m][1];
                    u32x4 w; w.x = cvt_pk_bf16(v0[0], v0[1]); w.y = cvt_pk_bf16(v0[2], v0[3]); w.z = cvt_pk_bf16(v1[0], v1[1]); w.w = cvt_pk_bf16(v1[2], v1[3]);
                    PG8_RS_EMIT(ai + m + bj == 0, w, O + (size_t)(rowt0 + ai * HALF + m * 16) * ldc + colw + bj * HALF); } }
        PG8_RS_FLUSH();
    }
};

struct EpiMerge {
    static constexpr bool PERM = true, AFTER_DRAIN = false, MIDK = true;
    const bf16_t* GA; const bf16_t* GG; bf16_t* O; PG8_LAS unsigned char* stg;
    __device__ __forceinline__ void mid(f32x4 (&acc)[2][2][4][2], const Unit& u, int wr, int wc, int fr, int fq) const {
        RowStore R; R.init(stg, wr, wc, fr, fq);
        int rowt = u.pm * BM + wr * 64 + R.r_, colw = u.pn * BM + wc * 32 + 8 * R.p_;
        asm volatile("" : "+v"(rowt), "+v"(colw));
        const bf16_t* pa = GA + (size_t)rowt * 1024 + colw; const bf16_t* pg = GG + (size_t)rowt * 1024 + colw;
        u32x4 ca[2], cg[2];
#pragma unroll
        for (int bj = 0; bj < 2; ++bj) { ca[bj] = *(const u32x4*)(pa + bj * HALF); cg[bj] = *(const u32x4*)(pg + bj * HALF); }
#pragma unroll
        for (int it = 0; it < 8; ++it) { const int ai = it >> 2, m = it & 3;
            u32x4 na[2], ng[2];
            if (it < 7) { const size_t ro = (size_t)(((it + 1) >> 2) * HALF + ((it + 1) & 3) * 16) * 1024;
#pragma unroll
                for (int bj = 0; bj < 2; ++bj) { na[bj] = *(const u32x4*)(pa + ro + bj * HALF); ng[bj] = *(const u32x4*)(pg + ro + bj * HALF); } }
#pragma unroll
            for (int bj = 0; bj < 2; ++bj) {
                u32x4 a, g; R.get<0>(ca[bj], a); R.get<1>(cg[bj], g);
                asm volatile("s_waitcnt lgkmcnt(0)" : "+v"(a), "+v"(g));
                f32x4 r0, r1;
                r0[0] = bflo(a.x) * __builtin_amdgcn_rcpf(fmaxf(bflo(g.x), 1e-30f)); r0[1] = bfhi(a.x) * __builtin_amdgcn_rcpf(fmaxf(bfhi(g.x), 1e-30f));
                r0[2] = bflo(a.y) * __builtin_amdgcn_rcpf(fmaxf(bflo(g.y), 1e-30f)); r0[3] = bfhi(a.y) * __builtin_amdgcn_rcpf(fmaxf(bfhi(g.y), 1e-30f));
                r1[0] = bflo(a.z) * __builtin_amdgcn_rcpf(fmaxf(bflo(g.z), 1e-30f)); r1[1] = bfhi(a.z) * __builtin_amdgcn_rcpf(fmaxf(bfhi(g.z), 1e-30f));
                r1[2] = bflo(a.w) * __builtin_amdgcn_rcpf(fmaxf(bflo(g.w), 1e-30f)); r1[3] = bfhi(a.w) * __builtin_amdgcn_rcpf(fmaxf(bfhi(g.w), 1e-30f));
                acc[ai][bj][m][0] = acc[ai][bj][m][0] * r0; acc[ai][bj][m][1] = acc[ai][bj][m][1] * r1;
            }
            if (it < 7) {
#pragma unroll
                for (int bj = 0; bj < 2; ++bj) { ca[bj] = na[bj]; cg[bj] = ng[bj]; } }
        }
        asm volatile("s_waitcnt vmcnt(0)" ::: "memory");
    }
    __device__ __forceinline__ void operator()(const f32x4 (&acc)[2][2][4][2], const Unit& u, int wr, int wc, int fr, int fq) const {
        RowStore R; R.init(stg, wr, wc, fr, fq);
        const int rowt = u.pm * BM + wr * 64 + R.r_, colw = u.pn * BM + wc * 32 + 8 * R.p_;
        const bf16_t* pg = GG + (size_t)rowt * 1024 + colw; bf16_t* po = O + (size_t)rowt * 1024 + colw;
        bf16_t* pprev = nullptr; u32x4 tprev = (u32x4){0u, 0u, 0u, 0u};
        u32x4 cg[16];
#pragma unroll
        for (int it = 0; it < 8; ++it)
#pragma unroll
            for (int bj = 0; bj < 2; ++bj) cg[2 * it + bj] = *(const u32x4*)(pg + (size_t)((it >> 2) * HALF + (it & 3) * 16) * 1024 + bj * HALF);
        asm volatile("s_waitcnt vmcnt(0)" ::: "memory");
#pragma unroll
        for (int it = 0; it < 8; ++it) { const int ai = it >> 2, m = it & 3; const size_t rc = (size_t)(ai * HALF + m * 16) * 1024;
#pragma unroll
            for (int bj = 0; bj < 2; ++bj) { const f32x4 v0 = acc[ai][bj][m][0], v1 = acc[ai][bj][m][1];
                u32x4 g; R.get<0>(cg[2 * it + bj], g);
                asm volatile("s_waitcnt lgkmcnt(0)" : "+v"(g), "+v"(tprev));
                if (it + bj > 0) *(u32x4*)pprev = tprev;
                u32x4 w; w.x = cvt_pk_bf16(bflo(g.x) * v0[0], bfhi(g.x) * v0[1]); w.y = cvt_pk_bf16(bflo(g.y) * v0[2], bfhi(g.y) * v0[3]);
                w.z = cvt_pk_bf16(bflo(g.z) * v1[0], bfhi(g.z) * v1[1]); w.w = cvt_pk_bf16(bflo(g.w) * v1[2], bfhi(g.w) * v1[3]);
                u32x4 t_; R.put<1>(w, t_); tprev = t_; pprev = po + rc + bj * HALF; }
        }
        PG8_RS_FLUSH();
    }
};


struct EpiIn8 {
    static constexpr bool PERM = true, AFTER_DRAIN = false, MIDK = false;
    bf16_t *V, *U, *GV, *GA, *GG; const float* rs; const float* cs; PG8_LAS unsigned char* stg;
    template <int ACT> __device__ __forceinline__ void body(const f32x4 (&acc)[2][2][4][2], const Unit& u, bf16_t* base, int ldc, int colt, int wr, int wc, int fr, int fq) const {
        const int row0 = u.pm * BM + wr * 64 + fr, ccol0 = u.pn * BM + wc * 32 + 8 * fq;
        f32x4 cv[2][2];
#pragma unroll
        for (int bj = 0; bj < 2; ++bj)
#pragma unroll
            for (int n = 0; n < 2; ++n) cv[bj][n] = *(const f32x4*)(cs + ccol0 + bj * HALF + 4 * n);
        float rsv[8];
#pragma unroll
        for (int i = 0; i < 8; ++i) rsv[i] = rs[row0 + (i >> 2) * HALF + (i & 3) * 16];
        asm volatile("s_waitcnt vmcnt(0)" : "+v"(rsv[0]), "+v"(rsv[1]), "+v"(rsv[2]), "+v"(rsv[3]), "+v"(rsv[4]), "+v"(rsv[5]), "+v"(rsv[6]), "+v"(rsv[7]), "+v"(cv[0][0]), "+v"(cv[0][1]), "+v"(cv[1][0]), "+v"(cv[1][1]) :: "memory");
        RowStore R; R.init(stg, wr, wc, fr, fq); bf16_t* pprev = nullptr; u32x4 tprev = (u32x4){0u, 0u, 0u, 0u};
        const int rowt0 = u.pm * BM + wr * 64 + R.r_, colw = colt + wc * 32 + 8 * R.p_;
        constexpr float C1 = -1.4426950408889634f * 1.5957691216057308f, C2 = C1 * 0.044715f;
#pragma unroll
        for (int ai = 0; ai < 2; ++ai)
#pragma unroll
            for (int m = 0; m < 4; ++m) { const float rsc = ACT == 2 ? rsv[ai * 4 + m] * -1.4426950408889634f : rsv[ai * 4 + m];
#pragma unroll
                for (int bj = 0; bj < 2; ++bj) { f32x4 v0 = acc[ai][bj][m][0] * cv[bj][0] * rsc, v1 = acc[ai][bj][m][1] * cv[bj][1] * rsc;
                    if constexpr (ACT == 1) {
#pragma unroll
                        for (int j = 0; j < 4; ++j) { const float x0 = v0[j], x1 = v1[j];
                            v0[j] = x0 * __builtin_amdgcn_rcpf(1.0f + __builtin_amdgcn_exp2f(x0 * __builtin_fmaf(x0 * x0, C2, C1)));
                            v1[j] = x1 * __builtin_amdgcn_rcpf(1.0f + __builtin_amdgcn_exp2f(x1 * __builtin_fmaf(x1 * x1, C2, C1))); } }
                    else if constexpr (ACT == 2) {
#pragma unroll
                        for (int j = 0; j < 4; ++j) { v0[j] = __builtin_amdgcn_rcpf(1.0f + __builtin_amdgcn_exp2f(v0[j])); v1[j] = __builtin_amdgcn_rcpf(1.0f + __builtin_amdgcn_exp2f(v1[j])); } }
                    u32x4 w; w.x = cvt_pk_bf16(v0[0], v0[1]); w.y = cvt_pk_bf16(v0[2], v0[3]); w.z = cvt_pk_bf16(v1[0], v1[1]); w.w = cvt_pk_bf16(v1[2], v1[3]);
                    PG8_RS_EMIT(ai + m + bj == 0, w, base + (size_t)(rowt0 + ai * HALF + m * 16) * ldc + colw + bj * HALF); } }
        PG8_RS_FLUSH();
    }
    __device__ __forceinline__ void operator()(const f32x4 (&acc)[2][2][4][2], const Unit& u, int wr, int wc, int fr, int fq) const {
        const int pn = u.pn;
        if (pn < 2) body<0>(acc, u, V, 512, pn * 256, wr, wc, fr, fq);
        else if (pn < 6) body<1>(acc, u, pn < 4 ? U : GV, 512, ((pn - 2) & 1) * 256, wr, wc, fr, fq);
        else body<2>(acc, u, pn < 10 ? GA : GG, 1024, ((pn - 6) & 3) * 256, wr, wc, fr, fq);
    }
};

struct EpiPlain8 {
    static constexpr bool PERM = true, AFTER_DRAIN = false, MIDK = false;
    bf16_t* O; int ldc; const float* rs; const float* cs; PG8_LAS unsigned char* stg;
    __device__ __forceinline__ void operator()(const f32x4 (&acc)[2][2][4][2], const Unit& u, int wr, int wc, int fr, int fq) const {
        const int row0 = u.pm * BM + wr * 64 + fr, ccol0 = u.pn * BM + wc * 32 + 8 * fq;
        f32x4 cv[2][2];
#pragma unroll
        for (int bj = 0; bj < 2; ++bj)
#pragma unroll
            for (int n = 0; n < 2; ++n) cv[bj][n] = *(const f32x4*)(cs + ccol0 + bj * HALF + 4 * n);
        float rsv[8];
#pragma unroll
        for (int i = 0; i < 8; ++i) rsv[i] = rs[row0 + (i >> 2) * HALF + (i & 3) * 16];
        asm volatile("s_waitcnt vmcnt(0)" : "+v"(rsv[0]), "+v"(rsv[1]), "+v"(rsv[2]), "+v"(rsv[3]), "+v"(rsv[4]), "+v"(rsv[5]), "+v"(rsv[6]), "+v"(rsv[7]), "+v"(cv[0][0]), "+v"(cv[0][1]), "+v"(cv[1][0]), "+v"(cv[1][1]) :: "memory");
        RowStore R; R.init(stg, wr, wc, fr, fq); bf16_t* pprev = nullptr; u32x4 tprev = (u32x4){0u, 0u, 0u, 0u};
        const int rowt0 = u.pm * BM + wr * 64 + R.r_, colw = u.pn * BM + wc * 32 + 8 * R.p_;
#pragma unroll
        for (int ai = 0; ai < 2; ++ai)
#pragma unroll
            for (int m = 0; m < 4; ++m) { const float rsc = rsv[ai * 4 + m];
#pragma unroll
                for (int bj = 0; bj < 2; ++bj) { const f32x4 v0 = acc[ai][bj][m][0] * cv[bj][0] * rsc, v1 = acc[ai][bj][m][1] * cv[bj][1] * rsc;
                    u32x4 w; w.x = cvt_pk_bf16(v0[0], v0[1]); w.y = cvt_pk_bf16(v0[2], v0[3]); w.z = cvt_pk_bf16(v1[0], v1[1]); w.w = cvt_pk_bf16(v1[2], v1[3]);
                    PG8_RS_EMIT(ai + m + bj == 0, w, O + (size_t)(rowt0 + ai * HALF + m * 16) * ldc + colw + bj * HALF); } }
        PG8_RS_FLUSH();
    }
};
typedef int i32x8 __attribute__((ext_vector_type(8)));
typedef short s16x16 __attribute__((ext_vector_type(16)));
template <bool F8> __device__ __forceinline__ void mma_blk(f32x4 (&acc)[4][2], const bf16x8 (&At)[4][2], const bf16x8 (&Bt)[2][2]) {
    __builtin_amdgcn_s_setprio(1);
    if constexpr (!F8) {
#pragma unroll
        for (int m = 0; m < 4; ++m)
#pragma unroll
            for (int n = 0; n < 2; ++n)
#pragma unroll
                for (int k = 0; k < 2; ++k) acc[m][n] = __builtin_amdgcn_mfma_f32_16x16x32_bf16(Bt[n][k], At[m][k], acc[m][n], 0, 0, 0);
    } else {
#pragma unroll
        for (int m = 0; m < 4; ++m)
#pragma unroll
            for (int n = 0; n < 2; ++n) {
                const i32x8 b = __builtin_bit_cast(i32x8, __builtin_shufflevector(Bt[n][0], Bt[n][1], 0, 1, 2, 3, 4, 5, 6, 7, 8, 9, 10, 11, 12, 13, 14, 15));
                const i32x8 a = __builtin_bit_cast(i32x8, __builtin_shufflevector(At[m][0], At[m][1], 0, 1, 2, 3, 4, 5, 6, 7, 8, 9, 10, 11, 12, 13, 14, 15));
                asm volatile("v_mfma_f32_16x16x128_f8f6f4 %0, %1, %2, %0" : "+v"(acc[m][n]) : "v"(b), "v"(a));
            }
    }
    __builtin_amdgcn_s_setprio(0);
}
template <class Epi, class Sched, bool ALIGN_EPI = false, bool SP2 = false, bool F8 = false>
__device__ __forceinline__ void gemm_phase(PG8_LAS unsigned char* lds, const Gemm g, const Sched& S, const Epi& E) {
    const int tid = threadIdx.x, wid = __builtin_amdgcn_readfirstlane(tid >> 6), lane = tid & 63, wr = wid >> 2, wc = wid & 3, fr = lane & 15, fq = lane >> 4;
    const int K = g.K, nt = K / BK;
    unsigned voffA[2], voffB[2];
#pragma unroll
    for (int i = 0; i < 2; ++i) { int R, C; stage_rc(tid * 16 + i * 8192, R, C); const int Rb = Epi::PERM ? ((R & ~31) + perm32(R & 31)) : R;
        voffA[i] = (unsigned)(R * K + C) * 2u; voffB[i] = (unsigned)(Rb * K + C) * 2u; }
    const size_t kstep = (size_t)(BK * 2);
    const size_t hstep = (size_t)HALF * K * 2;
    const size_t tstep = 2 * hstep;
    const unsigned ldsw = (unsigned)wid * 1024u;
    const int aoff = lds_byte(wr * 64 + fr, fq * 8), boff = lds_byte(wc * 32 + fr, fq * 8);
#define PG8_SA(b, h) (((b) * 2 + (h)) * HTB)
#define PG8_SB(b, h) ((4 + (b) * 2 + (h)) * HTB)
#define PG8_STAGE(bufoff, gbase, voff) do { _Pragma("unroll") for (int _i = 0; _i < 2; ++_i) \
        __builtin_amdgcn_global_load_lds((const unsigned*)((const char*)(gbase) + (voff)[_i]), (PG8_LAS unsigned*)(lds + (bufoff) + ldsw + _i * 8192), 16, 0, 0); } while (0)
#define PG8_LDA(dst, b, h) do { _Pragma("unroll") for (int m = 0; m < 4; ++m) _Pragma("unroll") for (int k = 0; k < 2; ++k) dst[m][k] = *(const PG8_LAS bf16x8*)(lds + PG8_SA(b, h) + aoff + m * 2048 + k * 1024); } while (0)
#define PG8_LDB(dst, b, h) do { _Pragma("unroll") for (int n = 0; n < 2; ++n) _Pragma("unroll") for (int k = 0; k < 2; ++k) dst[n][k] = *(const PG8_LAS bf16x8*)(lds + PG8_SB(b, h) + boff + n * 2048 + k * 1024); } while (0)
#define PG8_MMA(ai, bj, At, Bt) mma_blk<F8>(acc[ai][bj], At, Bt)
#define PG8_WAIT_V(n) asm volatile("s_waitcnt vmcnt(" #n ")" ::: "memory")
#define PG8_WAIT_L(n) asm volatile("s_waitcnt lgkmcnt(" #n ")" ::: "memory")
#define PG8_BAR __builtin_amdgcn_s_barrier()
#define PG8_SCHED __builtin_amdgcn_sched_barrier(0)
    Unit cur, nxt; int ui = 0;
    if (!S.next(0, cur)) return;
    f32x4 acc[2][2][4][2];
#pragma unroll
    for (int a = 0; a < 2; ++a)
#pragma unroll
        for (int b = 0; b < 2; ++b)
#pragma unroll
            for (int m = 0; m < 4; ++m)
#pragma unroll
                for (int n = 0; n < 2; ++n) acc[a][b][m][n] = (f32x4){0.f, 0.f, 0.f, 0.f};
    bf16x8 At[4][2], B0[2][2], B1[2][2];
    const char* cA = (const char*)g.A + (size_t)cur.pm * tstep; const char* cB = (const char*)g.Bt + (size_t)cur.pn * tstep;
    S.a_ready(cur);
    if constexpr (SP2) {
        PG8_STAGE(PG8_SB(0, 0), cB, voffB); PG8_STAGE(PG8_SB(0, 1), cB + hstep, voffB); PG8_STAGE(PG8_SA(0, 0), cA, voffA); PG8_STAGE(PG8_SA(0, 1), cA + hstep, voffA);
        if (wr == 1) PG8_BAR;
        PG8_WAIT_V(2); PG8_BAR;
        PG8_STAGE(PG8_SB(1, 0), cB + kstep, voffB); PG8_STAGE(PG8_SA(1, 0), cA + kstep, voffA); PG8_STAGE(PG8_SB(1, 1), cB + hstep + kstep, voffB);
        PG8_WAIT_V(6); PG8_BAR;
    } else {
        PG8_STAGE(PG8_SB(0, 0), cB, voffB); PG8_STAGE(PG8_SA(0, 0), cA, voffA); PG8_STAGE(PG8_SB(0, 1), cB + hstep, voffB); PG8_STAGE(PG8_SA(0, 1), cA + hstep, voffA);
        if (wr == 1) PG8_BAR;
        PG8_WAIT_V(4); PG8_BAR;
        PG8_STAGE(PG8_SB(1, 0), cB + kstep, voffB); PG8_STAGE(PG8_SA(1, 0), cA + kstep, voffA); PG8_STAGE(PG8_SB(1, 1), cB + hstep + kstep, voffB);
        PG8_WAIT_V(6); PG8_BAR;
    }
    for (;;) {
        const bool has_next = S.next(ui + 1, nxt);
        const char* nA = has_next ? (const char*)g.A + (size_t)nxt.pm * tstep : cA; const char* nB = has_next ? (const char*)g.Bt + (size_t)nxt.pn * tstep : cB;
#pragma unroll 1
        for (int t = 0; t < nt; t += 2) {
            const bool last = (t == nt - 2);
            const char* a1 = cA + (size_t)(t + 1) * kstep;
            const char* a2 = last ? nA : cA + (size_t)(t + 2) * kstep; const char* b2 = last ? nB : cB + (size_t)(t + 2) * kstep;
            const char* a3 = a2 + kstep; const char* b3 = b2 + kstep;
            if (last && has_next) S.a_ready(nxt);
            if constexpr (SP2) {
            PG8_LDB(B0, 0, 0); PG8_LDB(B1, 0, 1); PG8_SCHED; PG8_LDA(At, 0, 0); PG8_STAGE(PG8_SA(1, 1), a1 + hstep, voffA);
            PG8_WAIT_V(8); PG8_WAIT_L(0); PG8_BAR; PG8_MMA(0, 0, At, B0); PG8_MMA(0, 1, At, B1); PG8_BAR; PG8_SCHED;
            PG8_LDA(At, 0, 1); PG8_STAGE(PG8_SB(0, 0), b2, voffB); PG8_STAGE(PG8_SB(0, 1), b2 + hstep, voffB); PG8_STAGE(PG8_SA(0, 0), a2, voffA);
            PG8_WAIT_V(8); PG8_WAIT_L(0); PG8_BAR; PG8_MMA(1, 0, At, B0); PG8_MMA(1, 1, At, B1); PG8_BAR; PG8_SCHED;
            PG8_LDB(B0, 1, 0); PG8_LDB(B1, 1, 1); PG8_SCHED; PG8_LDA(At, 1, 0); PG8_STAGE(PG8_SA(0, 1), a2 + hstep, voffA);
            PG8_WAIT_V(8); PG8_WAIT_L(0); PG8_BAR; PG8_MMA(0, 0, At, B0); PG8_MMA(0, 1, At, B1); PG8_BAR; PG8_SCHED;
            PG8_LDA(At, 1, 1); PG8_STAGE(PG8_SB(1, 0), b3, voffB); PG8_STAGE(PG8_SB(1, 1), b3 + hstep, voffB); PG8_STAGE(PG8_SA(1, 0), a3, voffA);
            PG8_WAIT_V(8); PG8_WAIT_L(0); PG8_BAR; PG8_MMA(1, 0, At, B0); PG8_MMA(1, 1, At, B1); PG8_BAR; PG8_SCHED;
            } else {
            PG8_LDB(B0, 0, 0); PG8_SCHED; PG8_LDA(At, 0, 0); PG8_STAGE(PG8_SA(1, 1), a1 + hstep, voffA);
            PG8_WAIT_L(8); PG8_BAR; PG8_WAIT_L(0); PG8_MMA(0, 0, At, B0); PG8_BAR; PG8_SCHED;
            PG8_LDB(B1, 0, 1); PG8_STAGE(PG8_SB(0, 0), b2, voffB);
            PG8_BAR; PG8_WAIT_L(0); PG8_MMA(0, 1, At, B1); PG8_BAR;
            PG8_LDA(At, 0, 1); PG8_STAGE(PG8_SA(0, 0), a2, voffA);
            PG8_BAR; PG8_WAIT_L(0); PG8_MMA(1, 0, At, B0); PG8_BAR; PG8_SCHED;
            PG8_STAGE(PG8_SB(0, 1), b2 + hstep, voffB);
            PG8_WAIT_V(6); PG8_BAR; PG8_MMA(1, 1, At, B1); PG8_BAR;
            PG8_LDB(B0, 1, 0); PG8_SCHED; PG8_LDA(At, 1, 0); PG8_STAGE(PG8_SA(0, 1), a2 + hstep, voffA);
            PG8_WAIT_L(8); PG8_BAR; PG8_WAIT_L(0); PG8_MMA(0, 0, At, B0); PG8_BAR; PG8_SCHED;
            PG8_LDB(B1, 1, 1); PG8_STAGE(PG8_SB(1, 0), b3, voffB);
            PG8_BAR; PG8_WAIT_L(0); PG8_MMA(0, 1, At, B1); PG8_BAR;
            PG8_LDA(At, 1, 1); PG8_STAGE(PG8_SA(1, 0), a3, voffA);
            PG8_BAR; PG8_WAIT_L(0); PG8_MMA(1, 0, At, B0); PG8_BAR; PG8_SCHED;
            PG8_STAGE(PG8_SB(1, 1), b3 + hstep, voffB);
            PG8_WAIT_V(6); PG8_BAR; PG8_MMA(1, 1, At, B1); PG8_BAR;
            }
            if constexpr (Epi::MIDK) { if (t + 2 == nt / 2) E.mid(acc, cur, wr, wc, fr, fq); }
        }
        if constexpr (F8) asm volatile("s_nop 15\n\ts_nop 15" ::: "memory");
        if constexpr (ALIGN_EPI) { if (wr == 0) PG8_BAR; }
        if constexpr (!Epi::AFTER_DRAIN) { E(acc, cur, wr, wc, fr, fq); S.done(cur); }
        if (!has_next) break;
#pragma unroll
        for (int a = 0; a < 2; ++a)
#pragma unroll
            for (int b = 0; b < 2; ++b)
#pragma unroll
                for (int m = 0; m < 4; ++m)
#pragma unroll
                    for (int n = 0; n < 2; ++n) acc[a][b][m][n] = (f32x4){0.f, 0.f, 0.f, 0.f};
        cur = nxt; cA = nA; cB = nB; ++ui;
        if constexpr (ALIGN_EPI) { if (wr == 1) PG8_BAR; }
    }
    PG8_WAIT_V(0);
    if constexpr (!ALIGN_EPI) { if (wr == 0) PG8_BAR; }
    PG8_BAR;
    if constexpr (Epi::AFTER_DRAIN) { E.fused(acc, cur, wr, wc, fr, fq, lds, wid, lane); S.done(cur); }
#undef PG8_SA
#undef PG8_SB
#undef PG8_STAGE
#undef PG8_LDA
#undef PG8_LDB
#undef PG8_MMA
#undef PG8_WAIT_V
#undef PG8_WAIT_L
#undef PG8_BAR
#undef PG8_SCHED
}
}

constexpr int NB = 4, SEQ = 8192, DM = 1024, NT = NB * SEQ;
constexpr int NH = 8, HD = 64, AW = 512, GW = 512, INW = 4608;
constexpr int NEXP = 16384;
constexpr float EPS = 1e-6f;
constexpr int NWAVES = 8, NTHR = 512;

#ifndef MK_ONE_LAUNCH
#define MK_ONE_LAUNCH 1
#endif
constexpr int NPH = 15;

constexpr size_t MiB = 1u << 20;
constexpr size_t WS_CTL = 0, CTL_ZERO_BYTES = 64 * 1024;
constexpr size_t WS_MOD = 1 * MiB;
constexpr size_t WS_KM = 1 * MiB + 128 * 1024;
constexpr size_t WS_BIAS = 1 * MiB + 512 * 1024;
constexpr size_t WS_WIN = 4 * MiB;
constexpr size_t WS_WIN8 = 6 * MiB;
constexpr size_t WS_WIN8S = 10 * MiB;
constexpr size_t WS_H8 = 436 * MiB;
constexpr size_t WS_HS = 2 * MiB + 262144;
constexpr size_t WS_WBA = 13 * MiB, WS_WBG = 14 * MiB, WS_WOUT = 15 * MiB, WS_WQ = 17 * MiB;
constexpr size_t WS_PU = 20 * MiB, WS_PV = 36 * MiB;
constexpr size_t WS_USC = 52 * MiB, WS_VSC = 52 * MiB + 65536;
constexpr size_t WS_A = 84 * MiB;
constexpr size_t WS_B = 148 * MiB;
constexpr size_t WS_C = 244 * MiB;
constexpr size_t WS_D = 308 * MiB;
constexpr size_t WS_E = 436 * MiB;
constexpr size_t WS_QP = 212 * MiB;
constexpr size_t WS_PART = 276 * MiB;
constexpr size_t WS_PW = 404 * MiB;
constexpr size_t WS_EID = 420 * MiB;
constexpr size_t WS_GATE = 428 * MiB;
constexpr size_t WS_XH = 444 * MiB, WS_XL = 476 * MiB;
constexpr size_t WS_XSC = 2 * MiB;
constexpr size_t WS_END = 508 * MiB;

constexpr int RING_BYTES = 131072;
constexpr int MISC_OFF = 155648;
constexpr int LDS_BYTES = 159744;

#define GAS __attribute__((address_space(1)))
#define LAS __attribute__((address_space(3)))
typedef unsigned short bf16;
typedef unsigned v4u __attribute__((ext_vector_type(4)));
typedef float f32x4 __attribute__((ext_vector_type(4)));
#define DEVI __device__ __forceinline__
DEVI float bf2f(bf16 v) { return __uint_as_float(((unsigned)v) << 16); }
DEVI float bflo(unsigned u) { return __uint_as_float(u << 16); }
DEVI float bfhi(unsigned u) { return __uint_as_float(u & 0xffff0000u); }
DEVI unsigned pk2(float lo, float hi) { unsigned r; asm volatile("s_nop 0\n\tv_cvt_pk_bf16_f32 %0, %1, %2" : "=v"(r) : "v"(lo), "v"(hi)); return r; }
DEVI float wave_sum(float v) {
#pragma unroll
    for (int o = 32; o > 0; o >>= 1) v += __shfl_xor(v, o);
    return v; }
DEVI float wave_max(float v) {
#pragma unroll
    for (int o = 32; o > 0; o >>= 1) v = fmaxf(v, __shfl_xor(v, o));
    return v; }
DEVI float gelu_tanh(float x) { return pg8::act_gelu(x); }

#define XB_TMO      128
#define XB_XCNT(j)  (256  + 64 * (j))
#define XB_XSUB(j)  (1280 + 64 * (j))
#define XB_XGEN(j)  (2304 + 64 * (j))
#define XB_TOP      3328
#define XB_TOPGEN   3392
#define XCD_BAR_WORDS 3456
#define XB_SPIN_CAP (1u << 18)

__device__ __forceinline__ unsigned xb_ld(unsigned* p)              { return __hip_atomic_load(p, __ATOMIC_RELAXED, __HIP_MEMORY_SCOPE_AGENT); }
__device__ __forceinline__ unsigned xb_add(unsigned* p, unsigned v) { return __hip_atomic_fetch_add(p, v, __ATOMIC_RELAXED, __HIP_MEMORY_SCOPE_AGENT); }
__device__ __forceinline__ unsigned xb_xcc_id() { return (unsigned)__builtin_amdgcn_s_getreg((3 << 11) | 20) & 0xFu; }
#define XB_SPIN(cond, bar) do { unsigned _sp = 0; while (cond) { __builtin_amdgcn_s_sleep(1); \
    if ((++_sp & 255u) == 0u) { if (xb_ld(&(bar)[XB_TMO])) break; if (_sp > XB_SPIN_CAP) { atomicAdd(&(bar)[XB_TMO], 1u); break; } } } } while (0)

struct XcdBarrier {
    unsigned* bar; unsigned x;
    volatile LAS unsigned* st;
};

__device__ __forceinline__ XcdBarrier xcd_barrier_post(unsigned* bar, volatile LAS unsigned* st) {
    XcdBarrier b; b.bar = bar; b.x = xb_xcc_id(); b.st = st;
    if (threadIdx.x == 0) (void)xb_add(&bar[XB_XCNT(b.x)], 1u);
    return b;
}
__device__ __forceinline__ void xcd_barrier_complete(unsigned* bar, unsigned x, unsigned& nloc, unsigned& nx) {
    const unsigned G = gridDim.x * gridDim.y * gridDim.z;
    unsigned sum, cnt, mine, sp = 0u;
    for (;;) {
        sum = 0u; cnt = 0u; mine = 0u;
#pragma unroll
        for (unsigned j = 0; j < 16; ++j) { const unsigned c = xb_ld(&bar[XB_XCNT(j)]); sum += c; cnt += (c > 0u) ? 1u : 0u; mine = (j == x) ? c : mine; }
        if (sum == G) break;
        __builtin_amdgcn_s_sleep(1);
        if ((++sp & 255u) == 0u) { if (xb_ld(&bar[XB_TMO])) break; if (sp > XB_SPIN_CAP) { atomicAdd(&bar[XB_TMO], 1u); break; } }
    }
    nloc = mine > 0u ? mine : 1u; nx = cnt > 0u ? cnt : 1u;
}

__device__ __forceinline__ void xcd_barrier(const XcdBarrier& b) {
    asm volatile("s_waitcnt vmcnt(0)" ::: "memory");
    __syncthreads();
    if (threadIdx.x == 0) {
        unsigned* bar = b.bar;
        __builtin_amdgcn_s_waitcnt(0);
        unsigned nloc = b.st[0], nx = b.st[1];
        if (nloc == 0u) { xcd_barrier_complete(bar, b.x, nloc, nx); b.st[0] = nloc; b.st[1] = nx; }
        const unsigned old = xb_add(&bar[XB_XSUB(b.x)], 1u);
        const unsigned gen = old / nloc;
        if (old + 1u == (gen + 1u) * nloc) {
            __builtin_amdgcn_fence(__ATOMIC_RELEASE, "agent");
            asm volatile("s_waitcnt vmcnt(0)" ::: "memory");
            const unsigned og = xb_add(&bar[XB_TOP], 1u);
            const unsigned tg = og / nx;
            if (og + 1u == (tg + 1u) * nx) xb_add(&bar[XB_TOPGEN], 1u);
            else XB_SPIN(xb_ld(&bar[XB_TOPGEN]) == tg, bar);
            __builtin_amdgcn_fence(__ATOMIC_ACQUIRE, "agent");
            xb_add(&bar[XB_XGEN(b.x)], 1u);
            asm volatile("s_waitcnt vmcnt(0)" ::: "memory");
        } else {
            XB_SPIN(xb_ld(&bar[XB_XGEN(b.x)]) == gen, bar);
            __builtin_amdgcn_fence(__ATOMIC_ACQUIRE, "agent");
            asm volatile("s_waitcnt vmcnt(0)" ::: "memory");
        }
    }
    __syncthreads();
}
struct Args { const float* in[21]; float* out; unsigned char* ws; int ph_lo, ph_hi; };

DEVI void p0_transpose_tile(const float* __restrict__ W, int K, int N, bf16* __restrict__ WT, int tk, int tn, float* tile, int tid, int ldk = 0, int koff = 0) {
    if (ldk == 0) ldk = K;
    const int k0 = tk * 64, n0 = tn * 64;
    { const int r = tid >> 4, c4 = (tid & 15) * 4;
#pragma unroll
      for (int hh = 0; hh < 2; ++hh) { const int rr = r + 32 * hh; const f32x4 v = *(const f32x4*)(W + (size_t)(k0 + rr) * N + n0 + c4);
          tile[rr * 65 + c4 + 0] = v[0]; tile[rr * 65 + c4 + 1] = v[1]; tile[rr * 65 + c4 + 2] = v[2]; tile[rr * 65 + c4 + 3] = v[3]; } }
    __syncthreads();
    { const int n = tid >> 3, kc = (tid & 7) * 8; float v[8];
#pragma unroll
      for (int j = 0; j < 8; ++j) v[j] = tile[(kc + j) * 65 + n];
      v4u w; w.x = pk2(v[0], v[1]); w.y = pk2(v[2], v[3]); w.z = pk2(v[4], v[5]); w.w = pk2(v[6], v[7]);
      *(v4u*)(WT + (size_t)(n0 + n) * ldk + koff + k0 + kc) = w; }
    __syncthreads();
}
DEVI int t5_bucket(int rel) {
    const int n = rel < 0 ? 0 : rel;
    if (n < 16) return n;
    int b = 16;
    b = n >= 22 ? 17 : b; b = n >= 30 ? 18 : b; b = n >= 40 ? 19 : b; b = n >= 54 ? 20 : b; b = n >= 73 ? 21 : b; b = n >= 99 ? 22 : b; b = n >= 134 ? 23 : b; b = n >= 182 ? 24 : b;
    b = n >= 246 ? 25 : b; b = n >= 332 ? 26 : b; b = n >= 450 ? 27 : b; b = n >= 609 ? 28 : b; b = n >= 825 ? 29 : b; b = n >= 1117 ? 30 : b; b = n >= 1513 ? 31 : b;
    return b;
}
DEVI void p0_fp8_strip(const float* __restrict__ W, int ldw, int c0, unsigned char* __restrict__ dst, float* __restrict__ dsc, int r0, unsigned char* lds, int tid) {
    unsigned char* t8 = (unsigned char*)lds;
    unsigned* cm = (unsigned*)(lds + 16 * 1040);
    if (tid < 16) cm[tid] = 0u;
    const int kq = tid >> 2, c4 = (tid & 3) * 4;
    f32x4 v[8];
#pragma unroll
    for (int j = 0; j < 8; ++j) v[j] = *(const f32x4*)(W + (size_t)(kq + 128 * j) * ldw + c0 + c4);
    __syncthreads();
    f32x4 m = {0.f, 0.f, 0.f, 0.f};
#pragma unroll
    for (int j = 0; j < 8; ++j)
#pragma unroll
        for (int c = 0; c < 4; ++c) m[c] = fmaxf(m[c], fabsf(v[j][c]));
#pragma unroll
    for (int off = 4; off < 64; off <<= 1)
#pragma unroll
        for (int c = 0; c < 4; ++c) m[c] = fmaxf(m[c], __shfl_xor(m[c], off));
    if ((tid & 63) < 4) {
#pragma unroll
        for (int c = 0; c < 4; ++c) atomicMax(&cm[c4 + c], __float_as_uint(m[c])); }
    __syncthreads();
    float inv[4];
#pragma unroll
    for (int c = 0; c < 4; ++c) inv[c] = 224.0f / fmaxf(__uint_as_float(cm[c4 + c]), 1e-30f);
    if (tid < 16) dsc[r0 + tid] = fmaxf(__uint_as_float(cm[tid]), 1e-30f) * (1.0f / 224.0f);
#pragma unroll
    for (int j = 0; j < 8; ++j)
#pragma unroll
        for (int c = 0; c < 4; ++c) { const int p = __builtin_amdgcn_cvt_pk_fp8_f32(v[j][c] * inv[c], 0.f, 0, false); t8[(c4 + c) * 1040 + kq + 128 * j] = (unsigned char)(p & 0xff); }
    __syncthreads();
    { const int n = tid >> 5, kb = (tid & 31) * 32; const v4u q0 = *(const v4u*)(t8 + n * 1040 + kb), q1 = *(const v4u*)(t8 + n * 1040 + kb + 16);
      unsigned char* d = dst + (size_t)(r0 + n) * 1024 + kb; *(v4u*)d = q0; *(v4u*)(d + 16) = q1; }
    __syncthreads();
}
DEVI void p0_prologue(const Args& a, unsigned char* lds, int tid, int bid, int G) {
    unsigned char* ws = a.ws;
    float* tile = (float*)lds;
    float* silu = (float*)(lds + 32768);
    float* part = (float*)(lds + 49152);
    constexpr int N_WIN = 16 * 16 + 224, N_WB = 8 * 16, N_SQ = 16 * 16;
    constexpr int I1 = N_WIN, I2 = I1 + N_WB, I3 = I2 + N_WB, I4 = I3 + N_SQ, I5 = I4 + 64, I6 = I5 + 96;
    bool have_silu = false;
    for (int it = bid; it < I6; it += G) {
        if (it < 256) { p0_transpose_tile(a.in[6], 1024, INW, (bf16*)(ws + WS_WIN), it / 16, it % 16, tile, tid); }
        else if (it < I1) { const int j = it - 256; p0_fp8_strip(a.in[6], INW, 1024 + 16 * j, ws + WS_WIN8, (float*)(ws + WS_WIN8S), 16 * j, lds, tid); }
        else if (it < I2) { const int j = it - I1; p0_transpose_tile(a.in[12], 512, 1024, (bf16*)(ws + WS_WBA), j / 16, j % 16, tile, tid, 1024, 0); }
        else if (it < I3) { const int j = it - I2; p0_transpose_tile(a.in[13], 512, 1024, (bf16*)(ws + WS_WBA), j / 16, j % 16, tile, tid, 1024, 512); }
        else if (it < I4) { const int j = it - I3; p0_transpose_tile(a.in[14], 1024, 1024, (bf16*)(ws + WS_WOUT), j / 16, j % 16, tile, tid); }
        else if (it < I5) { const int j = it - I4; p0_fp8_strip(a.in[17], 1024, 16 * j, ws + WS_WQ, (float*)(ws + WS_WQ + MiB), 16 * j, lds, tid); }
        else {
            const int i = it - I5;
            if (!have_silu) { for (int idx = tid; idx < 4096; idx += NTHR) { const float c = a.in[1][idx]; silu[idx] = c / (1.0f + expf(-c)); } have_silu = true; }
            __syncthreads();
            const int w = tid >> 6, l = tid & 63, j = 64 * i + l;
            float acc[4] = {0.f, 0.f, 0.f, 0.f};
            const float* aw = a.in[2];
#pragma unroll 1
            for (int k0 = 128 * w; k0 < 128 * w + 128; k0 += 32) {
                float wv[32];
#pragma unroll
                for (int u = 0; u < 32; ++u) wv[u] = aw[(size_t)(k0 + u) * 6144 + j];
#pragma unroll
                for (int u = 0; u < 32; ++u)
#pragma unroll
                    for (int b = 0; b < 4; ++b) acc[b] += silu[b * 1024 + k0 + u] * wv[u];
            }
#pragma unroll
            for (int b = 0; b < 4; ++b) part[(w * 4 + b) * 64 + l] = acc[b];
            __syncthreads();
            if (tid < 256) { const int b = tid >> 6; float s = a.in[3][j];
#pragma unroll
                for (int ww = 0; ww < 8; ++ww) s += part[(ww * 4 + b) * 64 + l];
                ((float*)(ws + WS_MOD))[b * 6144 + j] = s; }
            __syncthreads();
        }
    }
    {
        const int lane = tid & 63; const int gwv = bid * NWAVES + (tid >> 6), nwv = G * NWAVES;
        for (int rr = gwv; rr < 2 * NEXP; rr += nwv) {
            const bool second = rr >= NEXP; const int e = second ? rr - NEXP : rr;
            const float* src = (second ? a.in[20] : a.in[19]) + (size_t)e * 1024;
            unsigned char* dst = ws + (second ? WS_PV : WS_PU);
            f32x4 v[4]; float am = 0.f;
#pragma unroll
            for (int i = 0; i < 4; ++i) { v[i] = *(const f32x4*)(src + 4 * lane + 256 * i); am = fmaxf(am, fmaxf(fmaxf(fabsf(v[i][0]), fabsf(v[i][1])), fmaxf(fabsf(v[i][2]), fabsf(v[i][3])))); }
            am = wave_max(am); am = fmaxf(am, 1e-30f);
            const float inv = 224.0f / am;
            if (lane == 0) ((float*)(ws + (second ? WS_VSC : WS_USC)))[e] = am * (1.0f / 224.0f);
#pragma unroll
            for (int i = 0; i < 4; ++i) { int p = __builtin_amdgcn_cvt_pk_fp8_f32(v[i][0] * inv, v[i][1] * inv, 0, false); p = __builtin_amdgcn_cvt_pk_fp8_f32(v[i][2] * inv, v[i][3] * inv, p, true);
                const int sl = 2 * i + (lane >> 5);
                *(int*)(dst + ((size_t)sl * NEXP + e) * 128 + 4 * (lane & 31)) = p; }
        }
    }
    for (int i = bid * NTHR + tid; i < NB * 8 * 32 * 64; i += G * NTHR) ((float*)(ws + WS_KM))[i] = 0.f;
    for (int i = bid * NTHR + tid; i < 8 * 2048; i += G * NTHR) { const int h = i >> 11, rel = i & 2047; ((float*)(ws + WS_BIAS))[i] = a.in[11][t5_bucket(rel) * 8 + h]; }
}

DEVI void p1_prenorm(const float* __restrict__ x, const float* __restrict__ g, const float* __restrict__ mod, int sh_off, int sc_off, bf16* __restrict__ H, unsigned char* __restrict__ H8,
                     float* __restrict__ HS, int gw, int nw, int lane) {
    f32x4 nv[4];
    if (gw < NT) {
#pragma unroll
        for (int i = 0; i < 4; ++i) nv[i] = *(const f32x4*)(x + (size_t)gw * DM + 4 * lane + 256 * i); }
    for (int row = gw; row < NT; row += nw) {
        const int b = row >> 13; const float* mb = mod + b * 6144;
        f32x4 v[4]; float ss = 0.f;
#pragma unroll
        for (int i = 0; i < 4; ++i) { v[i] = nv[i]; ss += v[i][0] * v[i][0] + v[i][1] * v[i][1] + v[i][2] * v[i][2] + v[i][3] * v[i][3]; }
        { const int nrow = (row + nw < NT) ? row + nw : row;
#pragma unroll
          for (int i = 0; i < 4; ++i) nv[i] = *(const f32x4*)(x + (size_t)nrow * DM + 4 * lane + 256 * i); }
        ss = wave_sum(ss);
        const float r = rsqrtf(ss * (1.0f / DM) + EPS);
        float o[16]; float am = 0.f;
#pragma unroll
        for (int i = 0; i < 4; ++i) { const int d = 4 * lane + 256 * i;
            const f32x4 gg = *(const f32x4*)(g + d), sc = *(const f32x4*)(mb + sc_off + d), sh = *(const f32x4*)(mb + sh_off + d);
#pragma unroll
            for (int j = 0; j < 4; ++j) { o[4 * i + j] = v[i][j] * r * gg[j] * (1.0f + sc[j]) + sh[j]; am = fmaxf(am, fabsf(o[4 * i + j])); }
            uint2 w; w.x = pk2(o[4 * i], o[4 * i + 1]); w.y = pk2(o[4 * i + 2], o[4 * i + 3]);
            *(uint2*)(H + (size_t)row * DM + d) = w; }
        am = fmaxf(wave_max(am), 1e-30f);
        const float inv = 224.0f / am;
        if (lane == 0) HS[row] = am * (1.0f / 224.0f);
#pragma unroll
        for (int i = 0; i < 4; ++i) { int p = __builtin_amdgcn_cvt_pk_fp8_f32(o[4 * i] * inv, o[4 * i + 1] * inv, 0, false); p = __builtin_amdgcn_cvt_pk_fp8_f32(o[4 * i + 2] * inv, o[4 * i + 3] * inv, p, true);
            *(int*)(H8 + (size_t)row * DM + 4 * lane + 256 * i) = p; }
    }
}


namespace kbs {
typedef short bf16x8 __attribute__((ext_vector_type(8)));
typedef short s16x4 __attribute__((ext_vector_type(4)));
constexpr int KROWB = 144;
constexpr int OFF_K = 0, OFF_V = 256 * KROWB, OFF_TAB = 2 * 256 * KROWB;
constexpr int TABN = 1600;
constexpr int OFF_SEL = OFF_TAB + TABN * 4;
constexpr int OFF_CNT = OFF_SEL + 1024;
constexpr int OFF_GB = OFF_CNT + 256;
constexpr int OFF_PFX = OFF_TAB + TABN * 4;
constexpr int END = OFF_PFX + 4112;
constexpr float SC2 = 0.125f * 1.4426950408889634f;
constexpr float NEG = -1.0e30f;
constexpr int TRI_TOTAL = 256 * 496;
constexpr int NGI = 32 * 136;
__host__ __device__ constexpr int tri(int n) { return 256 * (31 * n - n * (n - 1) / 2); }

DEVI s16x4 vtr(const unsigned char* p) { return __builtin_bit_cast(s16x4, __builtin_amdgcn_ds_read_tr16_b64_v4i16((LAS s16x4*)(LAS unsigned char*)p)); }

DEVI void select_unit(int bh, int qb, const bf16* __restrict__ Qb, const float* __restrict__ KM, unsigned* __restrict__ GCNT, unsigned short* __restrict__ GLIST, unsigned char* lds, int tid) {
    if (qb == 0) return;
    const int b = bh >> 3, h = bh & 7;
    const bf16* Qg = Qb + ((size_t)b * SEQ + 256 * qb) * 512 + h * 64;
    int* CNT = (int*)(lds + OFF_CNT); int* FIL = CNT + 32; int* GB = (int*)(lds + OFF_GB);
    if (tid < 64) CNT[tid] = 0;
    {
        const int lane = tid & 63, w = tid >> 6, li = lane & 15, g = lane >> 4;
        bf16x8 ah[2][2], al[2][2];
#pragma unroll
        for (int tl = 0; tl < 2; ++tl)
#pragma unroll
            for (int ks = 0; ks < 2; ++ks) {
                const float* kp = KM + ((size_t)(bh * 32 + 16 * tl + li)) * 64 + 8 * g + 32 * ks;
                const f32x4 a = *(const f32x4*)kp, c = *(const f32x4*)(kp + 4);
                const float v[8] = {a[0], a[1], a[2], a[3], c[0], c[1], c[2], c[3]};
                unsigned hi[4], lo[4];
#pragma unroll
                for (int k = 0; k < 4; ++k) { hi[k] = pk2(v[2 * k], v[2 * k + 1]); lo[k] = pk2(v[2 * k] - bflo(hi[k]), v[2 * k + 1] - bfhi(hi[k])); }
                ah[tl][ks] = __builtin_bit_cast(bf16x8, (v4u){hi[0], hi[1], hi[2], hi[3]}); al[tl][ks] = __builtin_bit_cast(bf16x8, (v4u){lo[0], lo[1], lo[2], lo[3]});
            }
#pragma unroll 1
        for (int gi = 0; gi < 2; ++gi) {
            const int q = 32 * w + 16 * gi + li;
            const bf16* qrow = Qg + (size_t)q * 512 + 8 * g;
            const bf16x8 qf0 = *(const bf16x8*)qrow, qf1 = *(const bf16x8*)(qrow + 32);
            f32x4 sc[2];
#pragma unroll
            for (int tl = 0; tl < 2; ++tl) {
                f32x4 d = __builtin_amdgcn_mfma_f32_16x16x32_bf16(ah[tl][0], qf0, (f32x4){0.f, 0.f, 0.f, 0.f}, 0, 0, 0);
                d = __builtin_amdgcn_mfma_f32_16x16x32_bf16(ah[tl][1], qf1, d, 0, 0, 0);
                d = __builtin_amdgcn_mfma_f32_16x16x32_bf16(al[tl][0], qf0, d, 0, 0, 0);
                d = __builtin_amdgcn_mfma_f32_16x16x32_bf16(al[tl][1], qf1, d, 0, 0, 0);
                sc[tl] = d;
            }
            float v0 = -3.0e38f, v1 = -3.0e38f, v2 = -3.0e38f; int i0 = 255, i1 = 255, i2 = 255;
#define KBS_INS(a_, n_) do { const float xa_ = (a_); const int xn_ = (n_); \
                if (xa_ > v0 || (xa_ == v0 && xn_ < i0)) { v2 = v1; i2 = i1; v1 = v0; i1 = i0; v0 = xa_; i0 = xn_; } \
                else if (xa_ > v1 || (xa_ == v1 && xn_ < i1)) { v2 = v1; i2 = i1; v1 = xa_; i1 = xn_; } \
                else if (xa_ > v2 || (xa_ == v2 && xn_ < i2)) { v2 = xa_; i2 = xn_; } } while (0)
#pragma unroll
            for (int tl = 0; tl < 2; ++tl)
#pragma unroll
                for (int j = 0; j < 4; ++j) { const int n = 16 * tl + 4 * g + j; if (n < qb) KBS_INS(sc[tl][j], n); }
#pragma unroll
            for (int st = 16; st <= 32; st <<= 1) {
                const float p0 = __shfl_xor(v0, st), p1 = __shfl_xor(v1, st), p2 = __shfl_xor(v2, st);
                const int j0 = __shfl_xor(i0, st), j1 = __shfl_xor(i1, st), j2 = __shfl_xor(i2, st);
                if (j0 != 255) KBS_INS(p0, j0);
                if (j1 != 255) KBS_INS(p1, j1);
                if (j2 != 255) KBS_INS(p2, j2);
            }
#undef KBS_INS
            if (g == 0) { unsigned char* sp = lds + OFF_SEL + q * 4; sp[0] = (unsigned char)i0; sp[1] = (unsigned char)i1; sp[2] = (unsigned char)i2; sp[3] = 255; }
        }
    }
    __syncthreads();
    const unsigned char* sp = lds + OFF_SEL + (tid & 255) * 4;
    if (tid < 256) {
#pragma unroll
        for (int j = 0; j < 3; ++j) { const int n = sp[j]; if (n != 255) atomicAdd(&CNT[n], 1); } }
    __syncthreads();
    if (tid < 32) { const int c = CNT[tid]; GB[tid] = c > 0 ? (int)atomicAdd(GCNT + bh * 32 + tid, (unsigned)c) : 0; }
    __syncthreads();
    if (tid < 256) {
        unsigned short* gl = GLIST + (size_t)bh * TRI_TOTAL;
#pragma unroll
        for (int j = 0; j < 3; ++j) { const int n = sp[j];
            if (n != 255) { const int pos = atomicAdd(&FIL[n], 1); gl[tri(n) + GB[n] + pos] = (unsigned short)((qb * 256 + tid) | (j << 13)); } } }
    __syncthreads();
}

DEVI void tile_load(const bf16* __restrict__ Kg, const bf16* __restrict__ Vg, size_t rowbase, unsigned char* lds, int tid) {
    v4u kr[4], vr[4];
#pragma unroll
    for (int i = 0; i < 4; ++i) { const int ch = tid + 512 * i, row = ch >> 3, c8 = ch & 7;
        kr[i] = *(const v4u*)(Kg + (rowbase + row) * 512 + c8 * 8); vr[i] = *(const v4u*)(Vg + (rowbase + row) * 512 + c8 * 8); }
#pragma unroll
    for (int i = 0; i < 4; ++i) { const int ch = tid + 512 * i, row = ch >> 3, c8 = ch & 7;
        *(v4u*)(lds + OFF_K + row * KROWB + c8 * 16) = kr[i]; *(v4u*)(lds + OFF_V + row * KROWB + c8 * 16) = vr[i]; }
}

template <bool OWN, bool FAR>
DEVI void chunk128_base(const unsigned char* lds, int ch, const bf16x8 qf0, const bf16x8 qf1, int lane, int relq, float& m, float& l, f32x4 (&o)[4]) {
    const int li = lane & 15, g = lane >> 4;
    const float* tab = (const float*)(lds + OFF_TAB);
    const float farb = tab[TABN - 1];
    f32x4 s[8];
    const unsigned char* kb = lds + OFF_K + (128 * ch + li) * KROWB + 16 * g;
#pragma unroll
    for (int kt = 0; kt < 8; ++kt)
#pragma unroll
        for (int j = 0; j < 4; ++j) { const int rel = relq - (16 * kt + 4 * g + j);
            s[kt][j] = OWN ? tab[rel < 0 ? 0 : rel] : (FAR ? farb : tab[rel > TABN - 1 ? TABN - 1 : rel]); }
#pragma unroll
    for (int kt = 0; kt < 8; ++kt) {
        const bf16x8 a0 = *(const bf16x8*)(kb + kt * 16 * KROWB), a1 = *(const bf16x8*)(kb + kt * 16 * KROWB + 64);
        s[kt] = __builtin_amdgcn_mfma_f32_16x16x32_bf16(a0, qf0, s[kt], 0, 0, 0);
        s[kt] = __builtin_amdgcn_mfma_f32_16x16x32_bf16(a1, qf1, s[kt], 0, 0, 0);
    }
    float mx = NEG;
#pragma unroll
    for (int kt = 0; kt < 8; ++kt) {
#pragma unroll
        for (int j = 0; j < 4; ++j) {
            const int rel = relq - (16 * kt + 4 * g + j);
            const float x = (!OWN || rel >= 0) ? s[kt][j] : NEG;
            s[kt][j] = x; mx = fmaxf(mx, x);
        }
    }
    mx = fmaxf(mx, __shfl_xor(mx, 16)); mx = fmaxf(mx, __shfl_xor(mx, 32));
    const float mnew = fmaxf(m, mx);
    const float alpha = __builtin_amdgcn_exp2f(m - mnew);
    float psum = 0.f;
#pragma unroll
    for (int kt = 0; kt < 8; ++kt) {
#pragma unroll
        for (int j = 0; j < 4; ++j) { const float p = __builtin_amdgcn_exp2f(s[kt][j] - mnew); s[kt][j] = p; psum += p; }
    }
    psum += __shfl_xor(psum, 16); psum += __shfl_xor(psum, 32);
    m = mnew; l = l * alpha + psum;
#pragma unroll
    for (int dt = 0; dt < 4; ++dt) o[dt] = o[dt] * alpha;
    const unsigned char* vb = lds + OFF_V + (128 * ch + 4 * g + (li >> 2)) * KROWB + 8 * (li & 3);
#pragma unroll
    for (int ks = 0; ks < 4; ++ks) {
        const bf16x8 pf = __builtin_bit_cast(bf16x8, (v4u){pk2(s[2 * ks][0], s[2 * ks][1]), pk2(s[2 * ks][2], s[2 * ks][3]), pk2(s[2 * ks + 1][0], s[2 * ks + 1][1]), pk2(s[2 * ks + 1][2], s[2 * ks + 1][3])});
#pragma unroll
        for (int dt = 0; dt < 4; ++dt) {
            const s16x4 t0 = vtr(vb + (32 * ks) * KROWB + 32 * dt), t1 = vtr(vb + (32 * ks + 16) * KROWB + 32 * dt);
            const bf16x8 vf = (bf16x8){t0[0], t0[1], t0[2], t0[3], t1[0], t1[1], t1[2], t1[3]};
            o[dt] = __builtin_amdgcn_mfma_f32_16x16x32_bf16(vf, pf, o[dt], 0, 0, 0);
        }
    }
}
template <bool FAR>
DEVI void chunk128_pair(const unsigned char* lds, int ch, const bf16x8 qf0, const bf16x8 qf1, int lane, int relq, float& m, float& l, f32x4 (&o)[4]) {
    const int li = lane & 15, g = lane >> 4;
    const float* tab = (const float*)(lds + OFF_TAB);
    const float farb = tab[TABN - 1];
    f32x4 s[8];
    const unsigned char* kb = lds + OFF_K + (128 * ch + li) * KROWB + 16 * g;
    const unsigned char* vb = lds + OFF_V + (128 * ch + 4 * g + (li >> 2)) * KROWB + 8 * (li & 3);
#pragma unroll
    for (int kt = 0; kt < 8; ++kt)
#pragma unroll
        for (int j = 0; j < 4; ++j) { const int rel = relq - (16 * kt + 4 * g + j); s[kt][j] = FAR ? farb : tab[rel > TABN - 1 ? TABN - 1 : rel]; }
    bf16x8 r0[2], r1[2];
#pragma unroll
    for (int kt = 0; kt < 2; ++kt) { r0[kt] = *(const bf16x8*)(kb + kt * 16 * KROWB); r1[kt] = *(const bf16x8*)(kb + kt * 16 * KROWB + 64); }
    __builtin_amdgcn_sched_barrier(0);
#pragma unroll
    for (int kt = 0; kt < 8; ++kt) {
        s[kt] = __builtin_amdgcn_mfma_f32_16x16x32_bf16(r0[kt & 1], qf0, s[kt], 0, 0, 0);
        s[kt] = __builtin_amdgcn_mfma_f32_16x16x32_bf16(r1[kt & 1], qf1, s[kt], 0, 0, 0);
        if (kt + 2 < 8) { r0[kt & 1] = *(const bf16x8*)(kb + (kt + 2) * 16 * KROWB); r1[kt & 1] = *(const bf16x8*)(kb + (kt + 2) * 16 * KROWB + 64); }
        __builtin_amdgcn_sched_barrier(0);
    }
    s16x4 va[2][4][2];
#pragma unroll
    for (int dt = 0; dt < 4; ++dt) { va[0][dt][0] = vtr(vb + 32 * dt); va[0][dt][1] = vtr(vb + 16 * KROWB + 32 * dt); }
    __builtin_amdgcn_sched_barrier(0);
    float mx = NEG;
#pragma unroll
    for (int kt = 0; kt < 8; ++kt) {
#pragma unroll
        for (int j = 0; j < 4; ++j) {
            mx = fmaxf(mx, s[kt][j]);
        }
    }
    mx = fmaxf(mx, __shfl_xor(mx, 16)); mx = fmaxf(mx, __shfl_xor(mx, 32));
    const float mnew = fmaxf(m, mx);
    const float alpha = __builtin_amdgcn_exp2f(m - mnew);
    float psum = 0.f;
#pragma unroll
    for (int kt = 0; kt < 8; ++kt) {
#pragma unroll
        for (int j = 0; j < 4; ++j) { const float p = __builtin_amdgcn_exp2f(s[kt][j] - mnew); s[kt][j] = p; psum += p; }
    }
    psum += __shfl_xor(psum, 16); psum += __shfl_xor(psum, 32);
    m = mnew; l = l * alpha + psum;
#pragma unroll
    for (int dt = 0; dt < 4; ++dt) o[dt] = o[dt] * alpha;
    __builtin_amdgcn_sched_barrier(0);
#pragma unroll
    for (int ks = 0; ks < 4; ++ks) {
        if (ks + 1 < 4) {
#pragma unroll
            for (int dt = 0; dt < 2; ++dt) { va[(ks + 1) & 1][dt][0] = vtr(vb + (32 * (ks + 1)) * KROWB + 32 * dt); va[(ks + 1) & 1][dt][1] = vtr(vb + (32 * (ks + 1) + 16) * KROWB + 32 * dt); } }
        const bf16x8 pf = __builtin_bit_cast(bf16x8, (v4u){pk2(s[2 * ks][0], s[2 * ks][1]), pk2(s[2 * ks][2], s[2 * ks][3]), pk2(s[2 * ks + 1][0], s[2 * ks + 1][1]), pk2(s[2 * ks + 1][2], s[2 * ks + 1][3])});
#pragma unroll
        for (int dt = 0; dt < 4; ++dt) {
            const s16x4 t0 = va[ks & 1][dt][0], t1 = va[ks & 1][dt][1];
            const bf16x8 vf = (bf16x8){t0[0], t0[1], t0[2], t0[3], t1[0], t1[1], t1[2], t1[3]};
            o[dt] = __builtin_amdgcn_mfma_f32_16x16x32_bf16(vf, pf, o[dt], 0, 0, 0);
            if (dt == 1 && ks + 1 < 4) {
#pragma unroll
                for (int d2 = 2; d2 < 4; ++d2) { va[(ks + 1) & 1][d2][0] = vtr(vb + (32 * (ks + 1)) * KROWB + 32 * d2); va[(ks + 1) & 1][d2][1] = vtr(vb + (32 * (ks + 1) + 16) * KROWB + 32 * d2); } }
        }
        __builtin_amdgcn_sched_barrier(0);
    }
}
template <bool OWN, bool FAR>
DEVI void chunk128(const unsigned char* lds, int ch, const bf16x8 qf0, const bf16x8 qf1, int lane, int relq, float& m, float& l, f32x4 (&o)[4]) {
    if constexpr (OWN) chunk128_base<true, false>(lds, ch, qf0, qf1, lane, relq, m, l, o);
    else chunk128_pair<FAR>(lds, ch, qf0, qf1, lane, relq, m, l, o);
}
DEVI void write_partial(unsigned char* __restrict__ POa, unsigned char* __restrict__ POc, float* __restrict__ PM, float* __restrict__ PL, int slot, size_t th, bool valid, int lane,
                        float m, float l, const f32x4 (&o)[4]) {
    if (!valid) return;
    const int g = lane >> 4;
    unsigned char* base = (slot < 2 ? POa + (size_t)slot * ((size_t)NT * NH * 128) : POc + (size_t)(slot - 2) * ((size_t)NT * NH * 128)) + th * 128 + 8 * g;
#pragma unroll
    for (int dt = 0; dt < 4; ++dt) { uint2 w; w.x = pk2(o[dt][0], o[dt][1]); w.y = pk2(o[dt][2], o[dt][3]); *(uint2*)(base + 32 * dt) = w; }
    if (g == 0) { PM[(size_t)slot * NT * NH + th] = m; PL[(size_t)slot * NT * NH + th] = l; }
}

DEVI void attn_items(const bf16* __restrict__ Qb, const bf16* __restrict__ Kb, const bf16* __restrict__ Vb, const float* __restrict__ BIAS, const unsigned* __restrict__ GCNT,
                     const unsigned short* __restrict__ GLIST, unsigned* __restrict__ queue, unsigned char* __restrict__ POa, unsigned char* __restrict__ POc, float* __restrict__ PM, float* __restrict__ PL,
                     unsigned char* lds, volatile LAS unsigned* MISC, int tid) {
    const int lane = tid & 63, w = __builtin_amdgcn_readfirstlane(tid >> 6), li = lane & 15, g = lane >> 4;
    int cur_h = -1;
    int* PFX = (int*)(lds + OFF_PFX);
    for (int p = tid; p < 1024; p += NTHR) { int parts = 0;
        if (p < 992) { const int c = (int)__hip_atomic_load(GCNT + (p & 31) * 32 + (p >> 5), __ATOMIC_RELAXED, __HIP_MEMORY_SCOPE_AGENT); parts = (((c + 15) >> 4) + 63) >> 6; }
        PFX[p + 1] = parts; }
    __syncthreads();
    if (tid < 64) { int v[16]; int sum = 0;
#pragma unroll
        for (int i = 0; i < 16; ++i) { v[i] = PFX[1 + 16 * tid + i]; sum += v[i]; }
        int incl = sum;
#pragma unroll
        for (int o = 1; o < 64; o <<= 1) { const int t = __shfl_up(incl, o); if (lane >= o) incl += t; }
        int run = incl - sum;
#pragma unroll
        for (int i = 0; i < 16; ++i) { run += v[i]; v[i] = run; }
#pragma unroll
        for (int i = 0; i < 16; ++i) PFX[1 + 16 * tid + i] = v[i];
        if (tid == 0) PFX[0] = 0; }
    __syncthreads();
    const int NG = PFX[992];
    if (tid == 0) MISC[16] = __hip_atomic_fetch_add(queue, 1u, __ATOMIC_RELAXED, __HIP_MEMORY_SCOPE_AGENT);
    int slot = 0;
#pragma unroll 1
    for (;;) {
        __syncthreads();
        const int it = (int)MISC[16 + slot];
        if (it >= NG + 1024) break;
        unsigned next_tk = 0;
        if (tid == 0) next_tk = __hip_atomic_fetch_add(queue, 1u, __ATOMIC_RELAXED, __HIP_MEMORY_SCOPE_AGENT);
        int bh, n, part = 0; bool own;
        if (it < NG) { own = false; int lo = 0, hi = 992;
            while (hi - lo > 1) { const int mid = (lo + hi) >> 1; if (PFX[mid] <= it) lo = mid; else hi = mid; }
            n = lo >> 5; bh = lo & 31; part = it - PFX[lo];
        } else { own = true; const int j = it - NG; bh = j & 31; n = j >> 5; }
        const int b = bh >> 3, h = bh & 7;
        int cnt = 0, G0 = 0, G1 = 0;
        if (!own) { cnt = (int)__hip_atomic_load(GCNT + bh * 32 + n, __ATOMIC_RELAXED, __HIP_MEMORY_SCOPE_AGENT); const int Gt = (cnt + 15) >> 4; G0 = 64 * part; G1 = G0 + 64 < Gt ? G0 + 64 : Gt; }
        if (h != cur_h) { int t_ = tid; asm volatile("" : "+v"(t_));
            float* tab = (float*)(lds + OFF_TAB); for (int i = t_; i < TABN; i += NTHR) tab[i] = BIAS[h * 2048 + i] * 1.4426950408889634f; cur_h = h; }
        tile_load(Kb + h * 64, Vb + h * 64, (size_t)b * SEQ + 256 * n, lds, tid);
        __syncthreads();
        if (own) {
            const int qb = n;
#pragma unroll 1
            for (int gi = 0; gi < 2; ++gi) {
                const int q = 32 * w + 16 * gi + li; const size_t t = (size_t)b * SEQ + 256 * qb + q;
                const bf16* qrow = Qb + t * 512 + h * 64 + 8 * g;
                const bf16x8 qf0 = *(const bf16x8*)qrow, qf1 = *(const bf16x8*)(qrow + 32);
                float m = NEG, l = 0.f; f32x4 o[4];
#pragma unroll
                for (int dt = 0; dt < 4; ++dt) o[dt] = (f32x4){0.f, 0.f, 0.f, 0.f};
                chunk128<true, false>(lds, 0, qf0, qf1, lane, q, m, l, o);
                if (w >= 4) chunk128<true, false>(lds, 1, qf0, qf1, lane, q - 128, m, l, o);
                write_partial(POa, POc, PM, PL, 3, t * NH + h, true, lane, m, l, o);
            }
        } else {
            const unsigned short* gl = GLIST + (size_t)bh * TRI_TOTAL + tri(n);
            int gq = G0 + w;
            auto ent = [&](int grp) -> int { const int c = 16 * grp + li; return (grp < G1) ? (int)gl[c < cnt ? c : 0] | ((c < cnt) ? 0 : 0x8000) : 0x8000; };
            int e0 = ent(gq), e1 = ent(gq + 8);
            const bf16* qr0 = Qb + ((size_t)b * SEQ + (e0 & 0x1FFF)) * 512 + h * 64 + 8 * g;
            bf16x8 q00 = *(const bf16x8*)qr0, q01 = *(const bf16x8*)(qr0 + 32);
#pragma unroll 1
            for (; gq < G1; gq += 8) {
                const int e2 = ent(gq + 16);
                const bf16* qr1 = Qb + ((size_t)b * SEQ + (e1 & 0x1FFF)) * 512 + h * 64 + 8 * g;
                const bf16x8 q10 = *(const bf16x8*)qr1, q11 = *(const bf16x8*)(qr1 + 32);
                const int s = e0 & 0x1FFF, slot = (e0 >> 13) & 3; const bool valid = (e0 & 0x8000) == 0;
                float m = NEG, l = 0.f; f32x4 o[4];
#pragma unroll
                for (int dt = 0; dt < 4; ++dt) o[dt] = (f32x4){0.f, 0.f, 0.f, 0.f};
                const int relq = s - 256 * n;
                const bool far = __all(!valid || relq - 255 >= 1513);
                if (far) { chunk128<false, true>(lds, 0, q00, q01, lane, relq, m, l, o); chunk128<false, true>(lds, 1, q00, q01, lane, relq - 128, m, l, o); }
                else { chunk128<false, false>(lds, 0, q00, q01, lane, relq, m, l, o); chunk128<false, false>(lds, 1, q00, q01, lane, relq - 128, m, l, o); }
                write_partial(POa, POc, PM, PL, slot, ((size_t)b * SEQ + s) * NH + h, valid, lane, m, l, o);
                e0 = e1; e1 = e2; q00 = q10; q01 = q11;
            }
        }
        slot ^= 1;
        if (tid == 0) MISC[16 + slot] = next_tk;
    }
}

DEVI void merge_partials(const unsigned char* __restrict__ POa, const unsigned char* __restrict__ POc, const float* __restrict__ PM, const float* __restrict__ PL, bf16* __restrict__ YA,
                         int gw, int nw, int lane) {
    const int hh = lane >> 3, pc = lane & 7;
    for (int t = gw; t < NT; t += nw) {
        const int qb = (t & (SEQ - 1)) >> 8; const size_t th = (size_t)t * NH + hh;
        float mj[4], lj[4]; v4u oj[4]; bool vj[4];
#pragma unroll
        for (int j = 0; j < 4; ++j) { vj[j] = (j == 3) || (j < qb);
            const unsigned char* base = (j < 2 ? POa + (size_t)j * ((size_t)NT * NH * 128) : POc + (size_t)(j - 2) * ((size_t)NT * NH * 128)) + th * 128 + 16 * pc;
            if (vj[j]) { mj[j] = PM[(size_t)j * NT * NH + th]; lj[j] = PL[(size_t)j * NT * NH + th]; oj[j] = *(const v4u*)base; }
            else { mj[j] = NEG; lj[j] = 0.f; oj[j] = (v4u){0u, 0u, 0u, 0u}; } }
        const float M = fmaxf(fmaxf(mj[0], mj[1]), fmaxf(mj[2], mj[3]));
        float L = 0.f; float acc[8] = {0.f, 0.f, 0.f, 0.f, 0.f, 0.f, 0.f, 0.f};
#pragma unroll
        for (int j = 0; j < 4; ++j) { const float a = vj[j] ? __builtin_amdgcn_exp2f(mj[j] - M) : 0.f; L += lj[j] * a;
            acc[0] += a * bflo(oj[j].x); acc[1] += a * bfhi(oj[j].x); acc[2] += a * bflo(oj[j].y); acc[3] += a * bfhi(oj[j].y);
            acc[4] += a * bflo(oj[j].z); acc[5] += a * bfhi(oj[j].z); acc[6] += a * bflo(oj[j].w); acc[7] += a * bfhi(oj[j].w); }
        const float inv = 1.0f / L;
        v4u w; w.x = pk2(acc[0] * inv, acc[1] * inv); w.y = pk2(acc[2] * inv, acc[3] * inv); w.z = pk2(acc[4] * inv, acc[5] * inv); w.w = pk2(acc[6] * inv, acc[7] * inv);
        *(v4u*)(YA + (size_t)t * 1024 + hh * 64 + 8 * pc) = w;
    }
}
}
typedef float f32x2_t __attribute__((ext_vector_type(2)));
DEVI void p4_gmlp_unit(int unit, const bf16* __restrict__ U, const bf16* __restrict__ GV, const float* __restrict__ lng, const float* __restrict__ lnb,
                       const float* __restrict__ ws_, const float* __restrict__ bs_, bf16* __restrict__ YG, unsigned char* lds, int tid) {
    typedef short bf16x8_t __attribute__((ext_vector_type(8)));
    typedef short s16x4_t __attribute__((ext_vector_type(4)));
    constexpr int VNP = 1040;
    const int wv = tid >> 6, lane = tid & 63;
    const size_t row0 = (size_t)unit * 128;
    {
        float gg[8], bb[8];
#pragma unroll
        for (int j = 0; j < 8; ++j) { gg[j] = lng[8 * lane + j]; bb[j] = lnb[8 * lane + j]; }
        for (int r = 0; r < 16; ++r) {
            const int tt = 16 * wv + r;
            const v4u w = *(const v4u*)(GV + (row0 + tt) * 512 + 8 * lane);
            float v[8] = {bflo(w.x), bfhi(w.x), bflo(w.y), bfhi(w.y), bflo(w.z), bfhi(w.z), bflo(w.w), bfhi(w.w)};
            float s = 0.f;
#pragma unroll
            for (int j = 0; j < 8; ++j) s += v[j];
            const float mu = wave_sum(s) * (1.0f / 512.0f);
            float q = 0.f;
#pragma unroll
            for (int j = 0; j < 8; ++j) { v[j] -= mu; q += v[j] * v[j]; }
            const float rs = rsqrtf(wave_sum(q) * (1.0f / 512.0f) + EPS);
#pragma unroll
            for (int j = 0; j < 8; ++j) v[j] = v[j] * rs * gg[j] + bb[j];
            v4u o; o.x = pk2(v[0], v[1]); o.y = pk2(v[2], v[3]); o.z = pk2(v[4], v[5]); o.w = pk2(v[6], v[7]);
            *(v4u*)(lds + tt * VNP + 16 * lane) = o;
        }
    }
    __syncthreads();
    {
        const int g = wv, li = lane & 15, kg = lane >> 4;
        const float* wg = ws_ + (size_t)g * 128 * 128;
        const unsigned char* vbase = lds + (8 * kg + (li >> 2)) * VNP + (64 * g + 4 * (li & 3)) * 2;
#pragma unroll
        for (int tt = 0; tt < 8; ++tt) {
            constexpr int dummy = 0; (void)dummy;
            const int t = 16 * tt + li;
            const int nks = tt / 2 + 1;
            bf16x8_t bw[4];
#pragma unroll
            for (int ks = 0; ks < 4; ++ks) {
                if (ks < nks) {
                    const float* wp = wg + t * 128 + 32 * ks + 8 * kg;
                    const f32x4 a = *(const f32x4*)wp, b = *(const f32x4*)(wp + 4);
                    const int s0 = 32 * ks + 8 * kg;
                    float m[8] = {a[0], a[1], a[2], a[3], b[0], b[1], b[2], b[3]};
#pragma unroll
                    for (int j = 0; j < 8; ++j) m[j] = (s0 + j <= t) ? m[j] : 0.f;
                    bw[ks] = __builtin_bit_cast(bf16x8_t, (v4u){pk2(m[0], m[1]), pk2(m[2], m[3]), pk2(m[4], m[5]), pk2(m[6], m[7])});
                }
            }
            const float bias = bs_[g * 128 + t];
#pragma unroll
            for (int ct = 0; ct < 4; ++ct) {
                f32x4 acc = (f32x4){0.f, 0.f, 0.f, 0.f};
#pragma unroll
                for (int ks = 0; ks < 4; ++ks) {
                    if (ks < nks) {
                        const unsigned char* ap = vbase + (32 * ks) * VNP + 32 * ct;
                        const s16x4_t t0 = __builtin_bit_cast(s16x4_t, __builtin_amdgcn_ds_read_tr16_b64_v4i16((LAS s16x4_t*)(LAS unsigned char*)ap));
                        const s16x4_t t1 = __builtin_bit_cast(s16x4_t, __builtin_amdgcn_ds_read_tr16_b64_v4i16((LAS s16x4_t*)(LAS unsigned char*)(ap + 4 * VNP)));
                        const bf16x8_t af = (bf16x8_t){t0[0], t0[1], t0[2], t0[3], t1[0], t1[1], t1[2], t1[3]};
                        acc = __builtin_amdgcn_mfma_f32_16x16x32_bf16(af, bw[ks], acc, 0, 0, 0);
                    }
                }
                const size_t o = (row0 + t) * 512 + 64 * g + 16 * ct + 4 * kg;
                const uint2 uu = *(const uint2*)(U + o);
                uint2 y; y.x = pk2(bflo(uu.x) * (acc[0] + bias), bfhi(uu.x) * (acc[1] + bias)); y.y = pk2(bflo(uu.y) * (acc[2] + bias), bfhi(uu.y) * (acc[3] + bias));
                *(uint2*)(YG + (row0 + t) * 1024 + 512 + 64 * g + 16 * ct + 4 * kg) = y;
            }
        }
    }
    __syncthreads();
}

DEVI void p7_mid(const float* __restrict__ x, const bf16* __restrict__ Y, const float* __restrict__ post_g1, const float* __restrict__ pre_g2, const float* __restrict__ mod,
                 float* __restrict__ X1, bf16* __restrict__ H2, unsigned char* __restrict__ XH, unsigned char* __restrict__ XL, float* __restrict__ XSC, int gw, int nw, int lane) {
    uint2 nyw[4]; f32x4 nxx[4];
    if (gw < NT) {
#pragma unroll
        for (int i = 0; i < 4; ++i) { const int d = 4 * lane + 256 * i; nyw[i] = *(const uint2*)(Y + (size_t)gw * DM + d); nxx[i] = *(const f32x4*)(x + (size_t)gw * DM + d); } }
    for (int row = gw; row < NT; row += nw) {
        const int b = row >> 13; const float* mb = mod + b * 6144;
        float y[16], xv[16]; float ss = 0.f;
#pragma unroll
        for (int i = 0; i < 4; ++i) { const uint2 w = nyw[i];
            y[4 * i + 0] = bflo(w.x); y[4 * i + 1] = bfhi(w.x); y[4 * i + 2] = bflo(w.y); y[4 * i + 3] = bfhi(w.y);
            const f32x4 xx = nxx[i]; xv[4 * i + 0] = xx[0]; xv[4 * i + 1] = xx[1]; xv[4 * i + 2] = xx[2]; xv[4 * i + 3] = xx[3]; }
        { const int nrow = (row + nw < NT) ? row + nw : row;
#pragma unroll
          for (int i = 0; i < 4; ++i) { const int d = 4 * lane + 256 * i; nyw[i] = *(const uint2*)(Y + (size_t)nrow * DM + d); nxx[i] = *(const f32x4*)(x + (size_t)nrow * DM + d); } }
#pragma unroll
        for (int j = 0; j < 16; ++j) ss += y[j] * y[j];
        const float r1 = rsqrtf(wave_sum(ss) * (1.0f / DM) + EPS);
        float s2 = 0.f;
#pragma unroll
        for (int i = 0; i < 4; ++i) { const int d = 4 * lane + 256 * i; const f32x4 g1 = *(const f32x4*)(post_g1 + d), gt = *(const f32x4*)(mb + 2048 + d);
            f32x4 o;
#pragma unroll
            for (int j = 0; j < 4; ++j) { const float v = xv[4 * i + j] + gt[j] * (y[4 * i + j] * r1 * g1[j]); xv[4 * i + j] = v; o[j] = v; s2 += v * v; }
            (void)o; }
        const float r2 = rsqrtf(wave_sum(s2) * (1.0f / DM) + EPS);
        float hv[16]; float am = 0.f;
#pragma unroll
        for (int i = 0; i < 4; ++i) { const int d = 4 * lane + 256 * i; const f32x4 g2 = *(const f32x4*)(pre_g2 + d), sc = *(const f32x4*)(mb + 4096 + d), sh = *(const f32x4*)(mb + 3072 + d);
#pragma unroll
            for (int j = 0; j < 4; ++j) { const float o = xv[4 * i + j] * r2 * g2[j] * (1.0f + sc[j]) + sh[j]; hv[4 * i + j] = o; am = fmaxf(am, fabsf(o)); }
        }
        am = fmaxf(wave_max(am), 1e-30f);
        const float sx = 224.0f / am;
        if (lane == 0) XSC[row] = am * (1.0f / 224.0f);
#pragma unroll
        for (int i = 0; i < 4; ++i) { const int d = 4 * lane + 256 * i;
            const float v0 = hv[4 * i] * sx, v1 = hv[4 * i + 1] * sx, v2 = hv[4 * i + 2] * sx, v3 = hv[4 * i + 3] * sx;
            int ph = __builtin_amdgcn_cvt_pk_fp8_f32(v0, v1, 0, false); ph = __builtin_amdgcn_cvt_pk_fp8_f32(v2, v3, ph, true);
            *(int*)(XH + (size_t)row * DM + d) = ph; }
    }
}

DEVI unsigned f2ord(float f) { const unsigned u = __float_as_uint(f); return u ^ ((u >> 31) ? 0xFFFFFFFFu : 0x80000000u); }
DEVI float ord2f(unsigned u) { const unsigned b = (u & 0x80000000u) ? (u ^ 0x80000000u) : ~u; return __uint_as_float(b); }
#define BITONIC_SORT16(N) do { _Pragma("unroll") for (int k_ = 2; k_ <= 16; k_ <<= 1) _Pragma("unroll") for (int j_ = k_ >> 1; j_ > 0; j_ >>= 1) _Pragma("unroll") for (int i_ = 0; i_ < 16; ++i_) { const int l_ = i_ ^ j_; \
    if (l_ > i_) { const unsigned a_ = N[i_], b_ = N[l_]; const unsigned hi_ = a_ > b_ ? a_ : b_, lo_ = a_ > b_ ? b_ : a_; if ((i_ & k_) == 0) { N[i_] = hi_; N[l_] = lo_; } else { N[i_] = lo_; N[l_] = hi_; } } } } while (0)
#define BITONIC_MERGE16(L, N) do { _Pragma("unroll") for (int i_ = 0; i_ < 16; ++i_) { const unsigned a_ = L[i_], b_ = N[15 - i_]; L[i_] = a_ > b_ ? a_ : b_; } \
    _Pragma("unroll") for (int j_ = 8; j_ > 0; j_ >>= 1) _Pragma("unroll") for (int i_ = 0; i_ < 16; ++i_) { const int l_ = i_ ^ j_; if (l_ > i_) { const unsigned a_ = L[i_], b_ = L[l_]; L[i_] = a_ > b_ ? a_ : b_; L[l_] = a_ > b_ ? b_ : a_; } } } while (0)
#define INSERT16(L, key) do { unsigned _k = (key); _Pragma("unroll") for (int _i = 0; _i < 16; ++_i) { const unsigned _h = L[_i] > _k ? L[_i] : _k; _k = L[_i] > _k ? _k : L[_i]; L[_i] = _h; } } while (0)
DEVI void p9_route(const bf16* __restrict__ QP, const float* __restrict__ subk, unsigned short* __restrict__ EID, float* __restrict__ GATE, unsigned char* lds, int tid, int bid, int G) {
    typedef short bf16x8_t __attribute__((ext_vector_type(8)));
    constexpr int SKROW = 144;
    unsigned char* skb = lds;
    const int lane = tid & 63, w = tid >> 6, li = lane & 15, g = lane >> 4;
    float* scr = (float*)(lds + 40960 + w * 5120);
    unsigned char* ixs = lds + 81920 + tid * 32;
    for (int i = tid; i < 2 * 128 * 8; i += NTHR) { const int row = i >> 3, c8 = i & 7; const float* sp = subk + row * 64 + c8 * 8;
        const f32x4 a = *(const f32x4*)sp, b = *(const f32x4*)(sp + 4);
        *(v4u*)(skb + row * SKROW + c8 * 16) = (v4u){pk2(a[0], a[1]), pk2(a[2], a[3]), pk2(b[0], b[1]), pk2(b[2], b[3])}; }
    __syncthreads();
    for (int base = bid * NTHR; base < NT * NH; base += G * NTHR) {
        const int idx = base + tid, t = idx >> 3, h = idx & 7;
        unsigned L[2][16];
#pragma unroll
        for (int hf = 0; hf < 2; ++hf) {
#pragma unroll
            for (int i = 0; i < 16; ++i) L[hf][i] = 0u;
            bf16x8_t af[4][2];
#pragma unroll
            for (int rt = 0; rt < 4; ++rt) { const int row = base + 64 * w + 16 * rt + li; const bf16* qp = QP + (size_t)(row >> 3) * 1024 + (row & 7) * 128 + hf * 64 + 8 * g;
                af[rt][0] = *(const bf16x8_t*)qp; af[rt][1] = *(const bf16x8_t*)(qp + 32); }
#pragma unroll 1
            for (int kt = 0; kt < 8; ++kt) {
                const unsigned char* bp = skb + (hf * 128 + 16 * kt + li) * SKROW + 16 * g;
                const bf16x8_t b0 = *(const bf16x8_t*)bp, b1 = *(const bf16x8_t*)(bp + 64);
#pragma unroll
                for (int rt = 0; rt < 4; ++rt) {
                    f32x4 d = __builtin_amdgcn_mfma_f32_16x16x32_bf16(af[rt][0], b0, (f32x4){0.f, 0.f, 0.f, 0.f}, 0, 0, 0);
                    d = __builtin_amdgcn_mfma_f32_16x16x32_bf16(af[rt][1], b1, d, 0, 0, 0);
#pragma unroll
                    for (int j = 0; j < 4; ++j) scr[(16 * rt + 4 * g + j) * 20 + li] = d[j];
                }
                asm volatile("s_waitcnt lgkmcnt(0)" ::: "memory");
                f32x4 sv[4];
#pragma unroll
                for (int c4 = 0; c4 < 4; ++c4) sv[c4] = *(const f32x4*)(scr + lane * 20 + 4 * c4);
                asm volatile("s_waitcnt lgkmcnt(0)" ::: "memory");
                unsigned N[16];
#pragma unroll
                for (int c = 0; c < 16; ++c) N[c] = (f2ord(sv[c >> 2][c & 3]) & ~0x7Fu) | (unsigned)(127 - (16 * kt + c));
#pragma unroll
                for (int k = 2; k <= 16; k <<= 1)
#pragma unroll
                    for (int j = k >> 1; j > 0; j >>= 1)
#pragma unroll
                        for (int i = 0; i < 16; ++i) { const int l = i ^ j;
                            if (l > i) { const unsigned a = N[i], b = N[l]; const unsigned hi = a > b ? a : b, lo = a > b ? b : a;
                                if ((i & k) == 0) { N[i] = hi; N[l] = lo; } else { N[i] = lo; N[l] = hi; } } }
                if (kt == 0) {
#pragma unroll
                    for (int i = 0; i < 16; ++i) L[hf][i] = N[i];
                } else {
#pragma unroll
                    for (int i = 0; i < 16; ++i) { const unsigned a = L[hf][i], b = N[15 - i]; L[hf][i] = a > b ? a : b; }
#pragma unroll
                    for (int j = 8; j > 0; j >>= 1)
#pragma unroll
                        for (int i = 0; i < 16; ++i) { const int l = i ^ j;
                            if (l > i) { const unsigned a = L[hf][i], b = L[hf][l]; L[hf][i] = a > b ? a : b; L[hf][l] = a > b ? b : a; } }
                }
            }
        }
        float v1[16], v2[16];
#pragma unroll
        for (int i = 0; i < 16; ++i) { v1[i] = ord2f(L[0][i] & ~0x7Fu); v2[i] = ord2f(L[1][i] & ~0x7Fu); ixs[i] = (unsigned char)(127u - (L[0][i] & 0x7Fu)); ixs[16 + i] = (unsigned char)(127u - (L[1][i] & 0x7Fu)); }
        unsigned C[16];
        {
            unsigned N0[16] = {(f2ord(v1[0] + v2[0]) & ~0xFFu) | 255u, (f2ord(v1[0] + v2[1]) & ~0xFFu) | 254u, (f2ord(v1[0] + v2[2]) & ~0xFFu) | 253u, (f2ord(v1[0] + v2[3]) & ~0xFFu) | 252u, (f2ord(v1[0] + v2[4]) & ~0xFFu) | 251u, (f2ord(v1[0] + v2[5]) & ~0xFFu) | 250u, (f2ord(v1[0] + v2[6]) & ~0xFFu) | 249u, (f2ord(v1[0] + v2[7]) & ~0xFFu) | 248u, (f2ord(v1[0] + v2[8]) & ~0xFFu) | 247u, (f2ord(v1[0] + v2[9]) & ~0xFFu) | 246u, (f2ord(v1[0] + v2[10]) & ~0xFFu) | 245u, (f2ord(v1[0] + v2[11]) & ~0xFFu) | 244u, (f2ord(v1[0] + v2[12]) & ~0xFFu) | 243u, (f2ord(v1[0] + v2[13]) & ~0xFFu) | 242u, (f2ord(v1[0] + v2[14]) & ~0xFFu) | 241u, (f2ord(v1[0] + v2[15]) & ~0xFFu) | 240u};
            BITONIC_SORT16(N0);
            unsigned N1[16] = {(f2ord(v1[1] + v2[0]) & ~0xFFu) | 239u, (f2ord(v1[1] + v2[1]) & ~0xFFu) | 238u, (f2ord(v1[1] + v2[2]) & ~0xFFu) | 237u, (f2ord(v1[1] + v2[3]) & ~0xFFu) | 236u, (f2ord(v1[1] + v2[4]) & ~0xFFu) | 235u, (f2ord(v1[1] + v2[5]) & ~0xFFu) | 234u, (f2ord(v1[1] + v2[6]) & ~0xFFu) | 233u, (f2ord(v1[1] + v2[7]) & ~0xFFu) | 232u, (f2ord(v1[2] + v2[0]) & ~0xFFu) | 223u, (f2ord(v1[2] + v2[1]) & ~0xFFu) | 222u, (f2ord(v1[2] + v2[2]) & ~0xFFu) | 221u, (f2ord(v1[2] + v2[3]) & ~0xFFu) | 220u, (f2ord(v1[2] + v2[4]) & ~0xFFu) | 219u, (f2ord(v1[3] + v2[0]) & ~0xFFu) | 207u, (f2ord(v1[3] + v2[1]) & ~0xFFu) | 206u, (f2ord(v1[3] + v2[2]) & ~0xFFu) | 205u};
            BITONIC_SORT16(N1);
            unsigned N2[16] = {(f2ord(v1[3] + v2[3]) & ~0xFFu) | 204u, (f2ord(v1[4] + v2[0]) & ~0xFFu) | 191u, (f2ord(v1[4] + v2[1]) & ~0xFFu) | 190u, (f2ord(v1[4] + v2[2]) & ~0xFFu) | 189u, (f2ord(v1[5] + v2[0]) & ~0xFFu) | 175u, (f2ord(v1[5] + v2[1]) & ~0xFFu) | 174u, (f2ord(v1[6] + v2[0]) & ~0xFFu) | 159u, (f2ord(v1[6] + v2[1]) & ~0xFFu) | 158u, (f2ord(v1[7] + v2[0]) & ~0xFFu) | 143u, (f2ord(v1[7] + v2[1]) & ~0xFFu) | 142u, (f2ord(v1[8] + v2[0]) & ~0xFFu) | 127u, (f2ord(v1[9] + v2[0]) & ~0xFFu) | 111u, (f2ord(v1[10] + v2[0]) & ~0xFFu) | 95u, (f2ord(v1[11] + v2[0]) & ~0xFFu) | 79u, (f2ord(v1[12] + v2[0]) & ~0xFFu) | 63u, (f2ord(v1[13] + v2[0]) & ~0xFFu) | 47u};
            BITONIC_SORT16(N2);
            unsigned N3[16] = {(f2ord(v1[14] + v2[0]) & ~0xFFu) | 31u, (f2ord(v1[15] + v2[0]) & ~0xFFu) | 15u, 0u, 0u, 0u, 0u, 0u, 0u, 0u, 0u, 0u, 0u, 0u, 0u, 0u, 0u};
            BITONIC_SORT16(N3);
#pragma unroll
            for (int i = 0; i < 16; ++i) C[i] = N0[i];
            BITONIC_MERGE16(C, N1);
            BITONIC_MERGE16(C, N2);
            BITONIC_MERGE16(C, N3);
        }
        const float m = ord2f(C[0] & ~0xFFu);
        float p[16]; float sum = 0.f;
#pragma unroll
        for (int k = 0; k < 16; ++k) { p[k] = __expf(ord2f(C[k] & ~0xFFu) - m); sum += p[k]; }
        const float inv = 1.0f / sum;
        unsigned ev[16];
#pragma unroll
        for (int k = 0; k < 16; ++k) { const unsigned code = 255u - (C[k] & 0xFFu); ev[k] = (unsigned)ixs[code >> 4] * 128u + (unsigned)ixs[16 + (code & 15u)]; }
        { v4u* eo = (v4u*)(EID + (size_t)t * 128 + h * 16);
          eo[0] = (v4u){ev[0] | (ev[1] << 16), ev[2] | (ev[3] << 16), ev[4] | (ev[5] << 16), ev[6] | (ev[7] << 16)};
          eo[1] = (v4u){ev[8] | (ev[9] << 16), ev[10] | (ev[11] << 16), ev[12] | (ev[13] << 16), ev[14] | (ev[15] << 16)};
          f32x4* go = (f32x4*)(GATE + (size_t)t * 128 + h * 16);
#pragma unroll
          for (int k4 = 0; k4 < 4; ++k4) go[k4] = (f32x4){p[4 * k4] * inv, p[4 * k4 + 1] * inv, p[4 * k4 + 2] * inv, p[4 * k4 + 3] * inv}; }
    }
    __syncthreads();
}

constexpr int NSL = 8, SLD = 128, PCH = 256, NPCH = NT / PCH;
template <int CTRL> DEVI float dppf(float x) { return __builtin_bit_cast(float, __builtin_amdgcn_mov_dpp(__builtin_bit_cast(int, x), CTRL, 0xf, 0xf, true)); }
DEVI int shfl_i(int v, int srclane) { return __builtin_amdgcn_ds_bpermute(srclane << 2, v); }

DEVI void dma16(const void* gsrc, LAS unsigned char* lds_wave_base) { __builtin_amdgcn_global_load_lds((const unsigned*)gsrc, (LAS unsigned*)lds_wave_base, 16, 0, 0); }
DEVI long mk64(unsigned lo, unsigned hi) { return (long)(((unsigned long long)hi << 32) | (unsigned long long)lo); }
DEVI void peer_u_issue_half(unsigned e01, int h, const unsigned char* __restrict__ tb, LAS unsigned char* buf, int lane) {
#pragma unroll
    for (int i = 0; i < 8; ++i) {
        const unsigned ee = (unsigned)shfl_i((int)e01, 32 * h + 4 * i + (lane >> 4)); const unsigned e = (ee >> (16 * ((lane >> 3) & 1))) & 0xFFFFu;
        const unsigned c = (unsigned)(lane & 7) ^ (unsigned)((4 * i + (lane >> 4)) & 7);
        dma16(tb + (e * (unsigned)SLD + c * 16u), buf + 1024 * i);
    }
}
DEVI void peer_u_compute_half(LAS unsigned char* buf, int h, const long (&bh)[4], f32x4& sel, int lane) {
    const int r = lane & 15, kg = lane >> 4, swz = (r >> 1) & 7;
    const unsigned aA = (unsigned)(size_t)(buf + r * 128 + (((2 * kg) ^ swz) << 4)), aB = (unsigned)(size_t)(buf + r * 128 + (((2 * kg + 1) ^ swz) << 4));
    v4u pa[4], pb[4];
    asm volatile("ds_read_b128 %0, %8\n\tds_read_b128 %1, %9\n\tds_read_b128 %2, %8 offset:2048\n\tds_read_b128 %3, %9 offset:2048\n\t"
                 "ds_read_b128 %4, %8 offset:4096\n\tds_read_b128 %5, %9 offset:4096\n\tds_read_b128 %6, %8 offset:6144\n\tds_read_b128 %7, %9 offset:6144\n\ts_waitcnt lgkmcnt(0)"
                 : "=&v"(pa[0]), "=&v"(pb[0]), "=&v"(pa[1]), "=&v"(pb[1]), "=&v"(pa[2]), "=&v"(pb[2]), "=&v"(pa[3]), "=&v"(pb[3]) : "v"(aA), "v"(aB) : "memory");
    typedef int i32x8_u __attribute__((ext_vector_type(8)));
    const i32x8_u bx = {(int)(unsigned)bh[0], (int)(unsigned)(bh[0] >> 32), (int)(unsigned)bh[1], (int)(unsigned)(bh[1] >> 32), (int)(unsigned)bh[2], (int)(unsigned)(bh[2] >> 32), (int)(unsigned)bh[3], (int)(unsigned)(bh[3] >> 32)};
#pragma unroll
    for (int T = 0; T < 4; ++T) {
        const i32x8_u a8 = {(int)pa[T].x, (int)pa[T].y, (int)pa[T].z, (int)pa[T].w, (int)pb[T].x, (int)pb[T].y, (int)pb[T].z, (int)pb[T].w};
        const f32x4 ah = __builtin_amdgcn_mfma_scale_f32_16x16x128_f8f6f4(a8, bx, (f32x4){0.f, 0.f, 0.f, 0.f}, 0, 0, 0, 0, 0, 0);
        sel = (r == 4 * h + T) ? ah : sel;
    }
}
DEVI void rec_issue(const unsigned char* p_eid, const unsigned char* p_aux, const unsigned char* p_sc, LAS unsigned char* rec, int lane) {
    const unsigned char* src = lane < 16 ? p_eid + 16 * lane : (lane < 24 ? p_aux + 16 * (lane - 16) : (lane == 24 ? p_sc : p_eid));
    dma16(src, rec);
}
DEVI void rec_read(LAS unsigned char* rec, int lane, unsigned& e01, v4u& a0, v4u& a1, unsigned (&sc4)[1], int scsel) {
    const unsigned ae = (unsigned)(size_t)(rec + 4 * lane), aa = (unsigned)(size_t)(rec + 256 + 32 * (lane >> 4)), as = (unsigned)(size_t)(rec + 384 + 4 * scsel);
    asm volatile("ds_read_b32 %0, %4\n\tds_read_b128 %1, %5\n\tds_read_b128 %2, %5 offset:16\n\tds_read_b32 %3, %6\n\ts_waitcnt lgkmcnt(0)"
                 : "=&v"(e01), "=&v"(a0), "=&v"(a1), "=&v"(sc4[0]) : "v"(ae), "v"(aa), "v"(as) : "memory");
}
DEVI void peer_u_tokens(int t0, int sl, const unsigned char* __restrict__ XH, const unsigned* __restrict__ EID32, const unsigned char* __restrict__ PUs, float* __restrict__ PART,
                        LAS unsigned char* wbuf, LAS unsigned char* rbuf, int lane) {
    constexpr int NTK = PCH / NWAVES;
    const int kg = lane >> 4;
    const unsigned char* tb = PUs + (size_t)sl * NEXP * SLD;
    LAS unsigned char* buf0 = wbuf; LAS unsigned char* buf1 = wbuf + 8192;
    unsigned e_cur; v4u x0, x1; unsigned scd[1];
    asm volatile("s_waitcnt lgkmcnt(0)" ::: "memory");
    rec_issue((const unsigned char*)(EID32 + (size_t)t0 * 64), XH + (size_t)t0 * DM + sl * SLD, (const unsigned char*)EID32, rbuf, lane);
    asm volatile("s_waitcnt vmcnt(0)" ::: "memory");
    rec_read(rbuf, lane, e_cur, x0, x1, scd, 0);
    peer_u_issue_half(e_cur, 0, tb, buf0, lane);
#pragma unroll 1
    for (int j = 0; j < NTK; ++j) {
        const int t = t0 + j; const int tn = (t + 1 < NT) ? t + 1 : t;
        LAS unsigned char* rnext = rbuf + 1024 * ((j + 1) & 1);
        rec_issue((const unsigned char*)(EID32 + (size_t)tn * 64), XH + (size_t)tn * DM + sl * SLD, (const unsigned char*)EID32, rnext, lane);
        peer_u_issue_half(e_cur, 1, tb, buf1, lane);
        asm volatile("s_waitcnt vmcnt(9)" ::: "memory");
        const long bh[4] = {mk64(x0.x, x0.y), mk64(x0.z, x0.w), mk64(x1.x, x1.y), mk64(x1.z, x1.w)};
        f32x4 sel = (f32x4){0.f, 0.f, 0.f, 0.f};
        peer_u_compute_half(buf0, 0, bh, sel, lane);
        asm volatile("s_waitcnt vmcnt(8)" ::: "memory");
        unsigned e_nn; v4u y0, y1;
        rec_read(rnext, lane, e_nn, y0, y1, scd, 0);
        peer_u_issue_half(e_nn, 0, tb, buf0, lane);
        asm volatile("s_waitcnt vmcnt(8)" ::: "memory");
        peer_u_compute_half(buf1, 1, bh, sel, lane);
        if ((lane & 15) < 8) { uint2 pw; pw.x = pk2(sel[0], sel[1]); pw.y = pk2(sel[2], sel[3]);
            *(uint2*)((bf16*)PART + ((size_t)sl * NT + t) * 128 + 16 * (lane & 15) + 4 * kg) = pw; }
        e_cur = e_nn; x0 = y0; x1 = y1;
    }
    asm volatile("s_waitcnt vmcnt(0)" ::: "memory");
}
DEVI void peer_v_compute_half(LAS unsigned char* buf, int h, const v4u& wa, const v4u& wb, f32x4 (&acc)[8], int lane) {
    const int li = lane & 15, kg = lane >> 4, q = li >> 1, p = li & 1;
    const int row = 8 * kg + q, swz = (row >> 1) & 7;
    const unsigned ab = (unsigned)(size_t)(buf + row * 128 + 8 * p);
    unsigned ad[8];
#pragma unroll
    for (int mt = 0; mt < 8; ++mt) ad[mt] = ab + (unsigned)((mt ^ swz) << 4);
    const unsigned w8[8] = {wa.x, wa.y, wa.z, wa.w, wb.x, wb.y, wb.z, wb.w};
#pragma unroll
    for (int sp = 0; sp < 2; ++sp) {
        long a[8];
        if (sp == 0) asm volatile("ds_read_b64_tr_b8 %0, %8\n\tds_read_b64_tr_b8 %1, %9\n\tds_read_b64_tr_b8 %2, %10\n\tds_read_b64_tr_b8 %3, %11\n\t"
                                  "ds_read_b64_tr_b8 %4, %12\n\tds_read_b64_tr_b8 %5, %13\n\tds_read_b64_tr_b8 %6, %14\n\tds_read_b64_tr_b8 %7, %15\n\ts_waitcnt lgkmcnt(0)"
                                  : "=&v"(a[0]), "=&v"(a[1]), "=&v"(a[2]), "=&v"(a[3]), "=&v"(a[4]), "=&v"(a[5]), "=&v"(a[6]), "=&v"(a[7])
                                  : "v"(ad[0]), "v"(ad[1]), "v"(ad[2]), "v"(ad[3]), "v"(ad[4]), "v"(ad[5]), "v"(ad[6]), "v"(ad[7]) : "memory");
        else asm volatile("ds_read_b64_tr_b8 %0, %8 offset:4096\n\tds_read_b64_tr_b8 %1, %9 offset:4096\n\tds_read_b64_tr_b8 %2, %10 offset:4096\n\tds_read_b64_tr_b8 %3, %11 offset:4096\n\t"
                          "ds_read_b64_tr_b8 %4, %12 offset:4096\n\tds_read_b64_tr_b8 %5, %13 offset:4096\n\tds_read_b64_tr_b8 %6, %14 offset:4096\n\tds_read_b64_tr_b8 %7, %15 offset:4096\n\ts_waitcnt lgkmcnt(0)"
                          : "=&v"(a[0]), "=&v"(a[1]), "=&v"(a[2]), "=&v"(a[3]), "=&v"(a[4]), "=&v"(a[5]), "=&v"(a[6]), "=&v"(a[7])
                          : "v"(ad[0]), "v"(ad[1]), "v"(ad[2]), "v"(ad[3]), "v"(ad[4]), "v"(ad[5]), "v"(ad[6]), "v"(ad[7]) : "memory");
        const int s = 2 * h + sp;
        const long bw = mk64(w8[2 * s], w8[2 * s + 1]);
#pragma unroll
        for (int mt = 0; mt < 8; ++mt) acc[mt] = __builtin_amdgcn_mfma_f32_16x16x32_fp8_fp8(a[mt], bw, acc[mt], 0, 0, 0);
    }
}
DEVI void peer_v_tokens(int t0, int sl, const unsigned char* __restrict__ WQ8, const float* __restrict__ WSC, const unsigned* __restrict__ EID32, const unsigned char* __restrict__ PVs,
                        bf16* __restrict__ Y2, LAS unsigned char* wbuf, LAS unsigned char* rbuf, int lane) {
    constexpr int NTK = PCH / NWAVES;
    const int kg = lane >> 4, n = lane & 15;
    const unsigned char* tb = PVs + (size_t)sl * NEXP * SLD;
    LAS unsigned char* buf0 = wbuf; LAS unsigned char* buf1 = wbuf + 8192;
    unsigned e_cur; v4u x0, x1; unsigned scb[1];
    asm volatile("s_waitcnt lgkmcnt(0)" ::: "memory");
    rec_issue((const unsigned char*)(EID32 + (size_t)t0 * 64), WQ8 + (size_t)t0 * 128, (const unsigned char*)(WSC + (t0 & ~3)), rbuf, lane);
    asm volatile("s_waitcnt vmcnt(0)" ::: "memory");
    rec_read(rbuf, lane, e_cur, x0, x1, scb, t0 & 3);
    unsigned sc_bits = scb[0];
    peer_u_issue_half(e_cur, 0, tb, buf0, lane);
#pragma unroll 1
    for (int j = 0; j < NTK; ++j) {
        const int t = t0 + j; const int tn = (t + 1 < NT) ? t + 1 : t;
        LAS unsigned char* rnext = rbuf + 1024 * ((j + 1) & 1);
        rec_issue((const unsigned char*)(EID32 + (size_t)tn * 64), WQ8 + (size_t)tn * 128, (const unsigned char*)(WSC + (tn & ~3)), rnext, lane);
        peer_u_issue_half(e_cur, 1, tb, buf1, lane);
        asm volatile("s_waitcnt vmcnt(9)" ::: "memory");
        f32x4 acc[8];
#pragma unroll
        for (int mt = 0; mt < 8; ++mt) acc[mt] = (f32x4){0.f, 0.f, 0.f, 0.f};
        peer_v_compute_half(buf0, 0, x0, x1, acc, lane);
        asm volatile("s_waitcnt vmcnt(8)" ::: "memory");
        unsigned e_nn; v4u y0, y1;
        rec_read(rnext, lane, e_nn, y0, y1, scb, tn & 3);
        peer_u_issue_half(e_nn, 0, tb, buf0, lane);
        asm volatile("s_waitcnt vmcnt(8)" ::: "memory");
        peer_v_compute_half(buf1, 1, x0, x1, acc, lane);
        f32x4 sel = acc[0];
#pragma unroll
        for (int mt = 1; mt < 8; ++mt) sel = (n == mt) ? acc[mt] : sel;
        const float sc = __uint_as_float(sc_bits);
        if (n < 8) { uint2 o; o.x = pk2(sel[0] * sc, sel[1] * sc); o.y = pk2(sel[2] * sc, sel[3] * sc);
            *(uint2*)(Y2 + (size_t)t * DM + sl * SLD + 16 * n + 4 * kg) = o; }
        e_cur = e_nn; x0 = y0; x1 = y1; sc_bits = scb[0];
    }
    asm volatile("s_waitcnt vmcnt(0)" ::: "memory");
}
template <bool UPASS>
DEVI void peer_pass(unsigned* __restrict__ qcnt, const unsigned char* __restrict__ XH, const unsigned char* __restrict__ XL, const float* __restrict__ W, const unsigned* __restrict__ EID32, const unsigned char* __restrict__ TAB,
                    float* __restrict__ PART, bf16* __restrict__ Y2, volatile LAS unsigned* MISC, unsigned char* ldsbase, int tid) {
    const int lane = tid & 63, wv = tid >> 6;
    const int pref = (int)(xb_xcc_id() & 7u);
    constexpr int NTK = PCH / NWAVES;
    unsigned live = 0xFFu;
#pragma unroll 1
    for (int k = 0; k < NSL; ++k) {
        const int sl = (pref + k) & (NSL - 1);
        if (k == 1) {
            __syncthreads();
            if (tid < 64) { const unsigned c = (tid < NSL) ? __hip_atomic_load(qcnt + 64 * tid, __ATOMIC_RELAXED, __HIP_MEMORY_SCOPE_AGENT) : (unsigned)NPCH;
                const unsigned long long m = __ballot(c < (unsigned)NPCH); if (tid == 0) MISC[17] = (unsigned)m; }
            __syncthreads();
            live = MISC[17];
        }
        if (!((live >> sl) & 1u)) continue;
#pragma unroll 1
        for (;;) {
            __syncthreads();
            if (tid == 0) MISC[16] = __hip_atomic_fetch_add(qcnt + 64 * sl, 1u, __ATOMIC_RELAXED, __HIP_MEMORY_SCOPE_AGENT);
            __syncthreads();
            const int it = (int)MISC[16];
            if (it >= NPCH) break;
            const int t0 = it * PCH + wv * NTK;
            if (UPASS) {
                peer_u_tokens(t0, sl, XH, EID32, TAB, PART, (LAS unsigned char*)ldsbase + wv * 16384, (LAS unsigned char*)ldsbase + 131072 + wv * 2048, lane);
            } else {
                peer_v_tokens(t0, sl, XH  , (const float*)XL  , EID32, TAB, Y2, (LAS unsigned char*)ldsbase + wv * 16384, (LAS unsigned char*)ldsbase + 131072 + wv * 2048, lane);
            }
        }
    }
}
DEVI void peer_reduce(const float* __restrict__ PART, const float* __restrict__ GATE, const unsigned short* __restrict__ EID, const float* __restrict__ USC, const float* __restrict__ VSC, const float* __restrict__ XSC,
                      unsigned char* __restrict__ WQ8, float* __restrict__ WSC, int gw, int nw, int lane) {
    for (int tp = gw; tp < NT / 2; tp += nw) {
        const int t = 2 * tp + (lane >> 5), i4 = lane & 31;
        const size_t i = (size_t)t * 32 + i4;
        f32x4 s = (f32x4){0.f, 0.f, 0.f, 0.f};
#pragma unroll
        for (int sl = 0; sl < NSL; ++sl) { const uint2 pw = *(const uint2*)((const bf16*)PART + (size_t)sl * NT * 128 + i * 4); s += (f32x4){bflo(pw.x), bfhi(pw.x), bflo(pw.y), bfhi(pw.y)}; }
        const f32x4 g = *(const f32x4*)(GATE + i * 4);
        const uint2 ee = *(const uint2*)(EID + i * 4);
        const unsigned e[4] = {ee.x & 0xFFFFu, ee.x >> 16, ee.y & 0xFFFFu, ee.y >> 16};
        const float xs = XSC[t];
        float o[4]; float am = 0.f;
#pragma unroll
        for (int j = 0; j < 4; ++j) { o[j] = g[j] * gelu_tanh(s[j] * USC[e[j]] * xs) * VSC[e[j]]; am = fmaxf(am, fabsf(o[j])); }
#pragma unroll
        for (int m = 16; m > 0; m >>= 1) am = fmaxf(am, __shfl_xor(am, m));
        am = fmaxf(am, 1e-30f);
        const float inv = 224.0f / am;
        int pk = __builtin_amdgcn_cvt_pk_fp8_f32(o[0] * inv, o[1] * inv, 0, false); pk = __builtin_amdgcn_cvt_pk_fp8_f32(o[2] * inv, o[3] * inv, pk, true);
        const int p0 = 4 * i4, sK = p0 >> 5, kgK = (p0 >> 3) & 3, jK = p0 & 7;
        *(int*)(WQ8 + (size_t)t * 128 + kgK * 32 + sK * 8 + jK) = pk;
        if (i4 == 0) WSC[t] = am * (1.0f / 224.0f);
    }
}
DEVI void p10_final(const float* __restrict__ x, const bf16* __restrict__ Y1, const bf16* __restrict__ Y2, const float* __restrict__ post_g1, const float* __restrict__ post_g2,
                    const float* __restrict__ mod, float* __restrict__ OUT, int gw, int nw, int lane) {
    uint2 n1[4], n2[4]; f32x4 nx[4];
    if (gw < NT) {
#pragma unroll
        for (int i = 0; i < 4; ++i) { const size_t o = (size_t)gw * DM + 4 * lane + 256 * i; n1[i] = *(const uint2*)(Y1 + o); n2[i] = *(const uint2*)(Y2 + o); nx[i] = *(const f32x4*)(x + o); } }
    for (int row = gw; row < NT; row += nw) {
        const int b = row >> 13; const float* mb = mod + b * 6144;
        float y1[16], y2[16]; float s1 = 0.f, s2 = 0.f; f32x4 cx[4];
#pragma unroll
        for (int i = 0; i < 4; ++i) cx[i] = nx[i];
#pragma unroll
        for (int i = 0; i < 4; ++i) { const uint2 w1 = n1[i], w2 = n2[i];
            y1[4 * i + 0] = bflo(w1.x); y1[4 * i + 1] = bfhi(w1.x); y1[4 * i + 2] = bflo(w1.y); y1[4 * i + 3] = bfhi(w1.y);
            y2[4 * i + 0] = bflo(w2.x); y2[4 * i + 1] = bfhi(w2.x); y2[4 * i + 2] = bflo(w2.y); y2[4 * i + 3] = bfhi(w2.y); }
#pragma unroll
        for (int j = 0; j < 16; ++j) { s1 += y1[j] * y1[j]; s2 += y2[j] * y2[j]; }
        { const int nrow = (row + nw < NT) ? row + nw : row;
#pragma unroll
          for (int i = 0; i < 4; ++i) { const size_t o = (size_t)nrow * DM + 4 * lane + 256 * i; n1[i] = *(const uint2*)(Y1 + o); n2[i] = *(const uint2*)(Y2 + o); nx[i] = *(const f32x4*)(x + o); } }
        const float r1 = rsqrtf(wave_sum(s1) * (1.0f / DM) + EPS), r2 = rsqrtf(wave_sum(s2) * (1.0f / DM) + EPS);
#pragma unroll
        for (int i = 0; i < 4; ++i) { const int d = 4 * lane + 256 * i;
            const f32x4 xx = cx[i], g1 = *(const f32x4*)(post_g1 + d), g2 = *(const f32x4*)(post_g2 + d), gt1 = *(const f32x4*)(mb + 2048 + d), gt2 = *(const f32x4*)(mb + 5120 + d);
            f32x4 res;
#pragma unroll
            for (int j = 0; j < 4; ++j) { const float x1 = xx[j] + gt1[j] * (y1[4 * i + j] * r1 * g1[j]); res[j] = x1 + gt2[j] * (y2[4 * i + j] * r2 * g2[j]); }
            *(f32x4*)(OUT + (size_t)row * DM + d) = res; }
    }
}

__global__ void __launch_bounds__(NTHR, 2) fwd_kernel(Args args) {
    extern __shared__ __attribute__((aligned(16))) unsigned char lds[];
    const int tid = threadIdx.x, lane = tid & 63, wave = __builtin_amdgcn_readfirstlane(tid >> 6);
    const int G = gridDim.x, bid = blockIdx.x;
    const int gw = __builtin_amdgcn_readfirstlane(bid * NWAVES + wave), nw = G * NWAVES;
    unsigned char* ws = args.ws;
    volatile LAS unsigned* MISC = (volatile LAS unsigned*)((LAS unsigned char*)lds + MISC_OFF);
    if (tid < 64) MISC[tid] = 0u;
    __syncthreads();
#if MK_ONE_LAUNCH
    XcdBarrier bar = xcd_barrier_post((unsigned*)(ws + WS_CTL) + 1024, MISC + 8);
#define GRID_BAR() xcd_barrier(bar)
#else
#define GRID_BAR() do { } while (0)
#endif
    const int lo = args.ph_lo, hi = args.ph_hi;
#define IN(k) (lo <= (k) && (k) < hi)
#define SEAM(k) do { if (IN(k) && IN((k) + 1)) GRID_BAR(); } while (0)

    float* MOD = (float*)(ws + WS_MOD); float* KM = (float*)(ws + WS_KM); float* BIAS = (float*)(ws + WS_BIAS);
    bf16* WIN = (bf16*)(ws + WS_WIN); bf16* WBA = (bf16*)(ws + WS_WBA); bf16* WBG = (bf16*)(ws + WS_WBG); bf16* WOUT = (bf16*)(ws + WS_WOUT); bf16* WQ = (bf16*)(ws + WS_WQ);
    const unsigned char* PU = ws + WS_PU; const unsigned char* PV = ws + WS_PV; const float* USC = (const float*)(ws + WS_USC); const float* VSC = (const float*)(ws + WS_VSC);
    bf16* H1 = (bf16*)(ws + WS_A); bf16* MERGED = H1; bf16* H2 = H1;
    bf16* Qb = (bf16*)(ws + WS_B); bf16* Kb = Qb + (size_t)NT * 512; bf16* Vb = Kb + (size_t)NT * 512;
    bf16* Yb = Qb; bf16* QP = (bf16*)(ws + WS_QP);
    bf16* Ub = (bf16*)(ws + WS_C); bf16* GVb = Ub + (size_t)NT * 512;
    float* PART = (float*)(ws + WS_PART); float* PW = (float*)(ws + WS_PW); unsigned short* EID = (unsigned short*)(ws + WS_EID); float* GATE = (float*)(ws + WS_GATE); bf16* Y2 = H1;
    unsigned* QCNT = (unsigned*)(ws + WS_CTL) + 8192; unsigned* GCNT = (unsigned*)(ws + WS_CTL) + 12288; unsigned* QATT = (unsigned*)(ws + WS_CTL) + 13376;
    unsigned char* WQ8 = ws + WS_PW; float* WSC = (float*)(ws + WS_XSC + 131072);
    unsigned short* GLIST = (unsigned short*)(ws + WS_WIN); unsigned char* POa = ws + WS_A; unsigned char* POc = ws + WS_C; float* PMp = (float*)(ws + 500 * MiB); float* PLp = (float*)(ws + 504 * MiB);
    unsigned char* XH = ws + WS_XH; unsigned char* XL = ws + WS_XL; float* XSC = (float*)(ws + WS_XSC);
    bf16* GA = (bf16*)(ws + WS_D); bf16* GG = GA + (size_t)NT * 1024;
    bf16* YA = (bf16*)(ws + WS_E); bf16* YG = YA;
    LAS unsigned char* ring = (LAS unsigned char*)lds;
#define LV(x) ({ int t_ = (x); asm volatile("" : "+v"(t_)); t_; })
#define LS(x) ({ int t_ = (x); asm volatile("" : "+s"(t_)); t_; })

    if (IN(0)) { p0_prologue(args, lds, LV(tid), bid, G); }
    SEAM(0);
    if (IN(1)) { p1_prenorm(args.in[0], args.in[4], MOD, 0, 1024, H1, ws + WS_H8, (float*)(ws + WS_HS), LS(gw), nw, LV(lane)); }
    SEAM(1);
    if (IN(2)) {
        { pg8::Gemm g{H1, WIN, NT, 1024, DM}; pg8::StaticOrder S; S.init(NT, 1024, G, bid); pg8::EpiIn E{Qb, Kb, Vb, Ub, GVb, GA, GG, KM, ring + RING_BYTES};
          pg8::gemm_phase<pg8::EpiIn, pg8::StaticOrder, true, true>(ring, g, S, E); }
        { pg8::Gemm g{(const bf16*)(ws + WS_H8), (const bf16*)(ws + WS_WIN8), NT, INW - 1024, DM / 2}; pg8::StaticOrder S; S.init(NT, INW - 1024, G, bid);
          pg8::EpiIn8 E{Vb, Ub, GVb, GA, GG, (const float*)(ws + WS_HS), (const float*)(ws + WS_WIN8S), ring + RING_BYTES};
          pg8::gemm_phase<pg8::EpiIn8, pg8::StaticOrder, true, true, true>(ring, g, S, E); }
    }
    SEAM(2);
    if (IN(3)) {
        for (int u = bid; u < NB * 64; u += G) p4_gmlp_unit(u, Ub, GVb, args.in[7], args.in[8], args.in[9], args.in[10], YG, lds, LV(tid));
#pragma unroll 1
        for (int u = bid; u < NB * NH * 32; u += G) kbs::select_unit(u >> 5, (u + (u >> 8) * 8) & 31, Qb, KM, GCNT, GLIST, lds, LV(tid));
    }
    SEAM(3);
    if (IN(4)) { kbs::attn_items(Qb, Kb, Vb, BIAS, GCNT, GLIST, QATT, POa, POc, PMp, PLp, lds, MISC, LV(tid)); }
    SEAM(4);
    if (IN(5)) { kbs::merge_partials(POa, POc, PMp, PLp, YA, LS(gw), nw, LV(lane)); }
    SEAM(5);
    if (IN(6)) {
        pg8::Gemm g{YA, WBA, NT, DM, DM}; pg8::StaticOrder S; S.init(NT, DM, G, bid); pg8::EpiMerge E{GA, GG, MERGED, ring + RING_BYTES};
        pg8::gemm_phase<pg8::EpiMerge, pg8::StaticOrder, true, true>(ring, g, S, E);
    }
    SEAM(6);
    if (IN(7)) {
        pg8::Gemm g{MERGED, WOUT, NT, DM, DM}; pg8::StaticOrder S; S.init(NT, DM, G, bid); pg8::EpiPlain E{Yb, DM, ring + RING_BYTES};
        pg8::gemm_phase<pg8::EpiPlain, pg8::StaticOrder, true, true>(ring, g, S, E);
    }
    SEAM(7);
    if (IN(8)) { p7_mid(args.in[0], Yb, args.in[5], args.in[15], MOD, args.out, H2, XH, XL, XSC, LS(gw), nw, LV(lane)); }
    SEAM(8);
    if (IN(9)) {
        pg8::Gemm g{(const bf16*)XH, (const bf16*)(ws + WS_WQ), NT, DM, DM / 2}; pg8::StaticOrder S; S.init(NT, DM, G, bid);
        pg8::EpiPlain8 E{QP, DM, XSC, (const float*)(ws + WS_WQ + MiB), ring + RING_BYTES};
        pg8::gemm_phase<pg8::EpiPlain8, pg8::StaticOrder, true, true, true>(ring, g, S, E);
    }
    SEAM(9);
    if (IN(10)) { p9_route(QP, args.in[18], EID, GATE, lds, LV(tid), bid, G); }
    SEAM(10);
    if (IN(11)) { peer_pass<true>(QCNT, XH, XL, nullptr, (const unsigned*)EID, PU, PART, nullptr, MISC, lds, LV(tid)); }
    SEAM(11);
    if (IN(12)) { peer_reduce(PART, GATE, EID, USC, VSC, XSC, WQ8, WSC, LS(gw), nw, LV(lane)); }
    SEAM(12);
    if (IN(13)) { peer_pass<false>(QCNT + 64 * NSL, WQ8, (const unsigned char*)WSC, nullptr, (const unsigned*)EID, PV, nullptr, Y2, MISC, lds, LV(tid)); }
    SEAM(13);
    if (IN(14)) { p10_final(args.in[0], Yb, Y2, args.in[5], args.in[16], MOD, args.out, LS(gw), nw, LV(lane)); }
#undef IN
#undef SEAM
}

extern "C" void kernel_launch(void* const* d_in, const int* in_sizes, int n_in, void* d_out, int out_size, void* d_ws, size_t ws_size, hipStream_t stream) {
    static int grid = 0;
    if (grid == 0) {
        if (n_in != 21 || out_size != NT * DM || ws_size < WS_END) { fprintf(stderr, "kernel_launch: unexpected shapes (n_in %d out %d ws %zu)\n", n_in, out_size, ws_size); grid = -1; return; }
        int dev = 0, cus = 0, per_cu = 0;
        if (hipGetDevice(&dev) != hipSuccess || hipDeviceGetAttribute(&cus, hipDeviceAttributeMultiprocessorCount, dev) != hipSuccess) { grid = -1; return; }
        if (hipFuncSetAttribute((const void*)fwd_kernel, hipFuncAttributeMaxDynamicSharedMemorySize, LDS_BYTES) != hipSuccess) { fprintf(stderr, "kernel_launch: hipFuncSetAttribute failed\n"); grid = -1; return; }
        if (hipOccupancyMaxActiveBlocksPerMultiprocessor(&per_cu, (const void*)fwd_kernel, NTHR, LDS_BYTES) != hipSuccess || per_cu < 1) { fprintf(stderr, "kernel_launch: occupancy query says %d\n", per_cu); (void)hipGetLastError(); per_cu = 1; }
        grid = cus;
    }
    if (grid < 0) return;
    (void)hipMemsetAsync((char*)d_ws + WS_CTL, 0, CTL_ZERO_BYTES, stream);
    Args a{};
    for (int i = 0; i < 21; ++i) a.in[i] = (const float*)d_in[i];
    a.out = (float*)d_out; a.ws = (unsigned char*)d_ws;
#if MK_ONE_LAUNCH
    a.ph_lo = 0; a.ph_hi = NPH;
    hipLaunchKernelGGL(fwd_kernel, dim3(grid), dim3(NTHR), LDS_BYTES, stream, a);
#else
    for (int p = 0; p < NPH; ++p) { a.ph_lo = p; a.ph_hi = p + 1; hipLaunchKernelGGL(fwd_kernel, dim3(grid), dim3(NTHR), LDS_BYTES, stream, a); }
#endif
}
```

```cpp
#include <hip/hip_runtime.h>
#include <cstdio>
#include <cstdint>
namespace pg8 {
#define PG8_LAS __attribute__((address_space(3)))
typedef unsigned short bf16_t;
typedef short bf16x8 __attribute__((ext_vector_type(8)));
typedef float f32x4 __attribute__((ext_vector_type(4)));
typedef unsigned u32x4 __attribute__((ext_vector_type(4)));
constexpr int BM = 256, BK = 64, HALF = 128, HTB = HALF * BK * 2  , STAGE_BYTES = 8 * HTB, NXCD = 8, WGM = 8;

__host__ __device__ __forceinline__ int lds_byte(int r, int c) { const int st = (r >> 4) * 2 + (c >> 5), rr = r & 15, cc = c & 31, ob = rr * 64 + cc * 2; return st * 1024 + (ob ^ (((ob >> 9) & 1) << 5)); }
__host__ __device__ __forceinline__ void stage_rc(int b, int& R, int& C) { const int st = b / 1024, sb = b % 1024, swz = sb ^ (((sb >> 9) & 1) << 5); R = (st >> 1) * 16 + swz / 64; C = (st & 1) * 32 + (swz % 64) / 2; }
__host__ __device__ __forceinline__ int perm32(int rho) { const int n = rho >> 4, i = rho & 15; return 8 * (i >> 2) + 4 * n + (i & 3); }

struct Unit { int pm, pn; };
struct Gemm { const bf16_t* A; const bf16_t* Bt; int M, N, K; };

struct StaticOrder {
    int nM, nN, nwg, G, c;
    __host__ __device__ void init(int M, int N, int G_, int c_) { nM = M / BM; nN = N / BM; nwg = nM * nN; G = G_; c = c_; }
    __host__ __device__ bool next(int i, Unit& u) const {
        const long L = (long)i * G + c; if (L >= nwg) return false;
        int wgid = (int)L; { const int q = nwg / NXCD, r = nwg % NXCD, xcd = wgid % NXCD, off = wgid / NXCD; wgid = (xcd < r ? xcd * (q + 1) : r * (q + 1) + (xcd - r) * q) + off; }
        const int nig = WGM * nN, gid = wgid / nig, fm = gid * WGM, gsz = (nM - fm) < WGM ? (nM - fm) : WGM;
        u.pm = fm + ((wgid % nig) % gsz); u.pn = (wgid % nig) / gsz; return true;
    }
    __device__ __forceinline__ void a_ready(const Unit&) const {}
    __device__ __forceinline__ void done(const Unit&) const {}
};

typedef __bf16 bf16x2_cv __attribute__((ext_vector_type(2)));
typedef float f32x2_cv __attribute__((ext_vector_type(2)));
__device__ __forceinline__ unsigned cvt_pk_bf16(float lo, float hi) { const f32x2_cv v = {lo, hi}; return __builtin_bit_cast(unsigned, __builtin_convertvector(v, bf16x2_cv)); }
__device__ __forceinline__ float bflo(unsigned u) { return __uint_as_float(u << 16); }
__device__ __forceinline__ float bfhi(unsigned u) { return __uint_as_float(u & 0xffff0000u); }
__device__ __forceinline__ float act_sigmoid(float x) { return __builtin_amdgcn_rcpf(1.0f + __builtin_amdgcn_exp2f(-1.4426950408889634f * x)); }
__device__ __forceinline__ float act_gelu(float x) { const float z = 1.5957691216057308f * (x + 0.044715f * x * x * x); return x * __builtin_amdgcn_rcpf(1.0f + __builtin_amdgcn_exp2f(-1.4426950408889634f * z)); }

struct RowStore {
    unsigned wofs, rofs; int r_, p_;
    __device__ __forceinline__ void init(PG8_LAS unsigned char* stg, int wr, int wc, int fr, int fq) {
        PG8_LAS unsigned char* sb = stg + (wr * 4 + wc) * 2048; const int l = fq * 16 + fr; r_ = l >> 2; p_ = l & 3;
        wofs = (unsigned)(size_t)(sb + fr * 64 + (((fq + (fr >> 2)) & 3) << 4)); rofs = (unsigned)(size_t)(sb + r_ * 64 + (((p_ + (r_ >> 2)) & 3) << 4));
    }
    template <int SLOT> __device__ __forceinline__ void get(const u32x4& g, u32x4& t) const {
        if constexpr (SLOT == 0) asm volatile("ds_write_b128 %1, %2\n\tds_read_b128 %0, %3" : "=&v"(t) : "v"(rofs), "v"(g), "v"(wofs));
        else asm volatile("ds_write_b128 %1, %2 offset:1024\n\tds_read_b128 %0, %3 offset:1024" : "=&v"(t) : "v"(rofs), "v"(g), "v"(wofs));
    }
    template <int SLOT> __device__ __forceinline__ void put(const u32x4& w, u32x4& t) const {
        if constexpr (SLOT == 0) asm volatile("ds_write_b128 %1, %2\n\tds_read_b128 %0, %3" : "=&v"(t) : "v"(wofs), "v"(w), "v"(rofs));
        else asm volatile("ds_write_b128 %1, %2 offset:1024\n\tds_read_b128 %0, %3 offset:1024" : "=&v"(t) : "v"(wofs), "v"(w), "v"(rofs));
    }
};
#define PG8_RS_WAIT(n, t) asm volatile("s_waitcnt lgkmcnt(" #n ")" : "+v"(t))
#define PG8_RS_EMIT(first, w, newptr) do { u32x4 t_; if (bj == 0) R.put<0>(w, t_); else R.put<1>(w, t_); \
        if (!(first)) { PG8_RS_WAIT(2, tprev); *(u32x4*)pprev = tprev; } tprev = t_; pprev = (newptr); } while (0)
#define PG8_RS_FLUSH() do { PG8_RS_WAIT(0, tprev); *(u32x4*)pprev = tprev; } while (0)

struct EpiIn {
    static constexpr bool PERM = true, AFTER_DRAIN = false, MIDK = false;
    bf16_t *Q, *Kk, *V, *U, *GV, *GA, *GG; float* KM; PG8_LAS unsigned char* stg;
    __device__ __forceinline__ void operator()(const f32x4 (&acc)[2][2][4][2], const Unit& u, int wr, int wc, int fr, int fq) const {
        const int pn = u.pn; bf16_t* base; int ldc, colt, act;
        if (pn < 2) { base = Q; ldc = 512; colt = pn * 256; act = 0; }
        else if (pn < 4) { base = Kk; ldc = 512; colt = (pn - 2) * 256; act = 0; }
        else if (pn < 6) { base = V; ldc = 512; colt = (pn - 4) * 256; act = 0; }
        else if (pn < 8) { base = U; ldc = 512; colt = (pn - 6) * 256; act = 1; }
        else if (pn < 10) { base = GV; ldc = 512; colt = (pn - 8) * 256; act = 1; }
        else if (pn < 14) { base = GA; ldc = 1024; colt = (pn - 10) * 256; act = 2; }
        else { base = GG; ldc = 1024; colt = (pn - 14) * 256; act = 2; }
        const int row0 = u.pm * BM + wr * 64 + fr, col0 = colt + wc * 32 + 8 * fq;
        if (pn == 2 || pn == 3) {
#pragma unroll
            for (int bj = 0; bj < 2; ++bj)
#pragma unroll
                for (int n = 0; n < 2; ++n) { f32x4 s = (f32x4){0.f, 0.f, 0.f, 0.f};
#pragma unroll
                    for (int ai = 0; ai < 2; ++ai)
#pragma unroll
                        for (int m = 0; m < 4; ++m) s += acc[ai][bj][m][n];
#pragma unroll
                    for (int j = 0; j < 4; ++j) { float t = s[j]; t += __shfl_xor(t, 1); t += __shfl_xor(t, 2); t += __shfl_xor(t, 4); t += __shfl_xor(t, 8); s[j] = t; }
                    if (fr == 0) { const int col = colt + bj * HALF + wc * 32 + 8 * fq + 4 * n;
                        float* kp = KM + ((size_t)(((u.pm >> 5) * 8 + (col >> 6)) * 32 + (u.pm & 31))) * 64 + (col & 63);
#pragma unroll
                        for (int j = 0; j < 4; ++j) atomicAdd(kp + j, s[j] * (1.0f / 256.0f)); } }
        }
        const float qs = pn < 2 ? 0.125f * 1.4426950408889634f : 1.0f;
        RowStore R; R.init(stg, wr, wc, fr, fq); bf16_t* pprev = nullptr; u32x4 tprev = (u32x4){0u, 0u, 0u, 0u};
        const int rowt0 = u.pm * BM + wr * 64 + R.r_, colw = colt + wc * 32 + 8 * R.p_;
#pragma unroll
        for (int ai = 0; ai < 2; ++ai)
#pragma unroll
            for (int m = 0; m < 4; ++m) {
#pragma unroll
                for (int bj = 0; bj < 2; ++bj) { f32x4 v0 = acc[ai][bj][m][0] * qs, v1 = acc[ai][bj][m][1] * qs;
                    u32x4 w; w.x = cvt_pk_bf16(v0[0], v0[1]); w.y = cvt_pk_bf16(v0[2], v0[3]); w.z = cvt_pk_bf16(v1[0], v1[1]); w.w = cvt_pk_bf16(v1[2], v1[3]);
                    PG8_RS_EMIT(ai + m + bj == 0, w, base + (size_t)(rowt0 + ai * HALF + m * 16) * ldc + colw + bj * HALF); } }
        PG8_RS_FLUSH();
    }
};
struct EpiGate {
    static constexpr bool PERM = true, AFTER_DRAIN = false, MIDK = false;
    const bf16_t* Gt; const bf16_t* Tin; bf16_t* O;
    __device__ __forceinline__ void operator()(const f32x4 (&acc)[2][2][4][2], const Unit& u, int wr, int wc, int fr, int fq) const {
        const int row0 = u.pm * BM + wr * 64 + fr, col0 = u.pn * BM + wc * 32 + 8 * fq;
#pragma unroll
        for (int ai = 0; ai < 2; ++ai)
#pragma unroll
            for (int m = 0; m < 4; ++m) { const size_t ro = (size_t)(row0 + ai * HALF + m * 16) * 1024 + col0;
#pragma unroll
                for (int bj = 0; bj < 2; ++bj) { const f32x4 v0 = acc[ai][bj][m][0], v1 = acc[ai][bj][m][1];
                    const u32x4 g = *(const u32x4*)(Gt + ro + bj * HALF);
                    float o[8];
                    o[0] = bflo(g.x) * v0[0]; o[1] = bfhi(g.x) * v0[1]; o[2] = bflo(g.y) * v0[2]; o[3] = bfhi(g.y) * v0[3];
                    o[4] = bflo(g.z) * v1[0]; o[5] = bfhi(g.z) * v1[1]; o[6] = bflo(g.w) * v1[2]; o[7] = bfhi(g.w) * v1[3];
                    if (Tin) { const u32x4 t = *(const u32x4*)(Tin + ro + bj * HALF);
                        o[0] += bflo(t.x); o[1] += bfhi(t.x); o[2] += bflo(t.y); o[3] += bfhi(t.y); o[4] += bflo(t.z); o[5] += bfhi(t.z); o[6] += bflo(t.w); o[7] += bfhi(t.w); }
                    u32x4 w; w.x = cvt_pk_bf16(o[0], o[1]); w.y = cvt_pk_bf16(o[2], o[3]); w.z = cvt_pk_bf16(o[4], o[5]); w.w = cvt_pk_bf16(o[6], o[7]);
                    *(u32x4*)(O + ro + bj * HALF) = w; } }
    }
};
struct EpiPlain {
    static constexpr bool PERM = true, AFTER_DRAIN = false, MIDK = false;
    bf16_t* O; int ldc; PG8_LAS unsigned char* stg;
    __device__ __forceinline__ void operator()(const f32x4 (&acc)[2][2][4][2], const Unit& u, int wr, int wc, int fr, int fq) const {
        RowStore R; R.init(stg, wr, wc, fr, fq); bf16_t* pprev = nullptr; u32x4 tprev = (u32x4){0u, 0u, 0u, 0u};
        const int rowt0 = u.pm * BM + wr * 64 + R.r_, colw = u.pn * BM + wc * 32 + 8 * R.p_;
#pragma unroll
        for (int ai = 0; ai < 2; ++ai)
#pragma unroll
            for (int m = 0; m < 4; ++m) {
#pragma unroll
                for (int bj = 0; bj < 2; ++bj) { const f32x4 v0 = acc[ai][bj][m][0], v1 = acc[ai][bj][m][1];
                    u32x4 w; w.x = cvt_pk_bf16(v0[0], v0[1]); w.y = cvt_pk_bf16(v0[2], v0[3]); w.z = cvt_pk_bf16(v1[0], v1[1]); w.w = cvt_pk_bf16(v1[2], v1[3]);
                    PG8_RS_EMIT(ai + m + bj == 0, w, O + (size_t)(rowt0 + ai * HALF + m * 16) * ldc + colw + bj * HALF); } }
        PG8_RS_FLUSH();
    }
};

struct EpiMerge {
    static constexpr bool PERM = true, AFTER_DRAIN = false, MIDK = true;
    const bf16_t* GA; const bf16_t* GG; bf16_t* O; PG8_LAS unsigned char* stg;
    __device__ __forceinline__ void mid(f32x4 (&acc)[2][2][4][2], const Unit& u, int wr, int wc, int fr, int fq) const {
        RowStore R; R.init(stg, wr, wc, fr, fq);
        int rowt = u.pm * BM + wr * 64 + R.r_, colw = u.pn * BM + wc * 32 + 8 * R.p_;
        asm volatile("" : "+v"(rowt), "+v"(colw));
        const bf16_t* pa = GA + (size_t)rowt * 1024 + colw; const bf16_t* pg = GG + (size_t)rowt * 1024 + colw;
        u32x4 ca[2], cg[2];
#pragma unroll
        for (int bj = 0; bj < 2; ++bj) { ca[bj] = *(const u32x4*)(pa + bj * HALF); cg[bj] = *(const u32x4*)(pg + bj * HALF); }
#pragma unroll
        for (int it = 0; it < 8; ++it) { const int ai = it >> 2, m = it & 3;
            u32x4 na[2], ng[2];
            if (it < 7) { const size_t ro = (size_t)(((it + 1) >> 2) * HALF + ((it + 1) & 3) * 16) * 1024;
#pragma unroll
                for (int bj = 0; bj < 2; ++bj) { na[bj] = *(const u32x4*)(pa + ro + bj * HALF); ng[bj] = *(const u32x4*)(pg + ro + bj * HALF); } }
#pragma unroll
            for (int bj = 0; bj < 2; ++bj) {
                u32x4 a, g; R.get<0>(ca[bj], a); R.get<1>(cg[bj], g);
                asm volatile("s_waitcnt lgkmcnt(0)" : "+v"(a), "+v"(g));
                f32x4 r0, r1;
                r0[0] = bflo(a.x) * __builtin_amdgcn_rcpf(fmaxf(bflo(g.x), 1e-30f)); r0[1] = bfhi(a.x) * __builtin_amdgcn_rcpf(fmaxf(bfhi(g.x), 1e-30f));
                r0[2] = bflo(a.y) * __builtin_amdgcn_rcpf(fmaxf(bflo(g.y), 1e-30f)); r0[3] = bfhi(a.y) * __builtin_amdgcn_rcpf(fmaxf(bfhi(g.y), 1e-30f));
                r1[0] = bflo(a.z) * __builtin_amdgcn_rcpf(fmaxf(bflo(g.z), 1e-30f)); r1[1] = bfhi(a.z) * __builtin_amdgcn_rcpf(fmaxf(bfhi(g.z), 1e-30f));
                r1[2] = bflo(a.w) * __builtin_amdgcn_rcpf(fmaxf(bflo(g.w), 1e-30f)); r1[3] = bfhi(a.w) * __builtin_amdgcn_rcpf(fmaxf(bfhi(g.w), 1e-30f));
                acc[ai][bj][m][0] = acc[ai][bj][m][0] * r0; acc[ai][bj][m][1] = acc[ai][bj][m][1] * r1;
            }
            if (it < 7) {
#pragma unroll
                for (int bj = 0; bj < 2; ++bj) { ca[bj] = na[bj]; cg[bj] = ng[bj]; } }
        }
        asm volatile("s_waitcnt vmcnt(0)" ::: "memory");
    }
    __device__ __forceinline__ void operator()(const f32x4 (&acc)[2][2][4][2], const Unit& u, int wr, int wc, int fr, int fq) const {
        RowStore R; R.init(stg, wr, wc, fr, fq);
        const int rowt = u.pm * BM + wr * 64 + R.r_, colw = u.pn * BM + wc * 32 + 8 * R.p_;
        const bf16_t* pg = GG + (size_t)rowt * 1024 + colw; bf16_t* po = O + (size_t)rowt * 1024 + colw;
        bf16_t* pprev = nullptr; u32x4 tprev = (u32x4){0u, 0u, 0u, 0u};
        u32x4 cg[16];
#pragma unroll
        for (int it = 0; it < 8; ++it)
#pragma unroll
            for (int bj = 0; bj < 2; ++bj) cg[2 * it + bj] = *(const u32x4*)(pg + (size_t)((it >> 2) * HALF + (it & 3) * 16) * 1024 + bj * HALF);
        asm volatile("s_waitcnt vmcnt(0)" ::: "memory");
#pragma unroll
        for (int it = 0; it < 8; ++it) { const int ai = it >> 2, m = it & 3; const size_t rc = (size_t)(ai * HALF + m * 16) * 1024;
#pragma unroll
            for (int bj = 0; bj < 2; ++bj) { const f32x4 v0 = acc[ai][bj][m][0], v1 = acc[ai][bj][m][1];
                u32x4 g; R.get<0>(cg[2 * it + bj], g);
                asm volatile("s_waitcnt lgkmcnt(0)" : "+v"(g), "+v"(tprev));
                if (it + bj > 0) *(u32x4*)pprev = tprev;
                u32x4 w; w.x = cvt_pk_bf16(bflo(g.x) * v0[0], bfhi(g.x) * v0[1]); w.y = cvt_pk_bf16(bflo(g.y) * v0[2], bfhi(g.y) * v0[3]);
                w.z = cvt_pk_bf16(bflo(g.z) * v1[0], bfhi(g.z) * v1[1]); w.w = cvt_pk_bf16(bflo(g.w) * v1[2], bfhi(g.w) * v1[3]);
                u32x4 t_; R.put<1>(w, t_); tprev = t_; pprev = po + rc + bj * HALF; }
        }
        PG8_RS_FLUSH();
    }
};


struct EpiIn8 {
    static constexpr bool PERM = true, AFTER_DRAIN = false, MIDK = false;
    bf16_t *V, *U, *GV, *GA, *GG; const float* rs; const float* cs; PG8_LAS unsigned char* stg;
    template <int ACT> __device__ __forceinline__ void body(const f32x4 (&acc)[2][2][4][2], const Unit& u, bf16_t* base, int ldc, int colt, int wr, int wc, int fr, int fq) const {
        const int row0 = u.pm * BM + wr * 64 + fr, ccol0 = u.pn * BM + wc * 32 + 8 * fq;
        f32x4 cv[2][2];
#pragma unroll
        for (int bj = 0; bj < 2; ++bj)
#pragma unroll
            for (int n = 0; n < 2; ++n) cv[bj][n] = *(const f32x4*)(cs + ccol0 + bj * HALF + 4 * n);
        float rsv[8];
#pragma unroll
        for (int i = 0; i < 8; ++i) rsv[i] = rs[row0 + (i >> 2) * HALF + (i & 3) * 16];
        asm volatile("s_waitcnt vmcnt(0)" : "+v"(rsv[0]), "+v"(rsv[1]), "+v"(rsv[2]), "+v"(rsv[3]), "+v"(rsv[4]), "+v"(rsv[5]), "+v"(rsv[6]), "+v"(rsv[7]), "+v"(cv[0][0]), "+v"(cv[0][1]), "+v"(cv[1][0]), "+v"(cv[1][1]) :: "memory");
        RowStore R; R.init(stg, wr, wc, fr, fq); bf16_t* pprev = nullptr; u32x4 tprev = (u32x4){0u, 0u, 0u, 0u};
        const int rowt0 = u.pm * BM + wr * 64 + R.r_, colw = colt + wc * 32 + 8 * R.p_;
        constexpr float C1 = -1.4426950408889634f * 1.5957691216057308f, C2 = C1 * 0.044715f;
#pragma unroll
        for (int ai = 0; ai < 2; ++ai)
#pragma unroll
            for (int m = 0; m < 4; ++m) { const float rsc = ACT == 2 ? rsv[ai * 4 + m] * -1.4426950408889634f : rsv[ai * 4 + m];
#pragma unroll
                for (int bj = 0; bj < 2; ++bj) { f32x4 v0 = acc[ai][bj][m][0] * cv[bj][0] * rsc, v1 = acc[ai][bj][m][1] * cv[bj][1] * rsc;
                    if constexpr (ACT == 1) {
#pragma unroll
                        for (int j = 0; j < 4; ++j) { const float x0 = v0[j], x1 = v1[j];
                            v0[j] = x0 * __builtin_amdgcn_rcpf(1.0f + __builtin_amdgcn_exp2f(x0 * __builtin_fmaf(x0 * x0, C2, C1)));
                            v1[j] = x1 * __builtin_amdgcn_rcpf(1.0f + __builtin_amdgcn_exp2f(x1 * __builtin_fmaf(x1 * x1, C2, C1))); } }
                    else if constexpr (ACT == 2) {
#pragma unroll
                        for (int j = 0; j < 4; ++j) { v0[j] = __builtin_amdgcn_rcpf(1.0f + __builtin_amdgcn_exp2f(v0[j])); v1[j] = __builtin_amdgcn_rcpf(1.0f + __builtin_amdgcn_exp2f(v1[j])); } }
                    u32x4 w; w.x = cvt_pk_bf16(v0[0], v0[1]); w.y = cvt_pk_bf16(v0[2], v0[3]); w.z = cvt_pk_bf16(v1[0], v1[1]); w.w = cvt_pk_bf16(v1[2], v1[3]);
                    PG8_RS_EMIT(ai + m + bj == 0, w, base + (size_t)(rowt0 + ai * HALF + m * 16) * ldc + colw + bj * HALF); } }
        PG8_RS_FLUSH();
    }
    __device__ __forceinline__ void operator()(const f32x4 (&acc)[2][2][4][2], const Unit& u, int wr, int wc, int fr, int fq) const {
        const int pn = u.pn;
        if (pn < 2) body<0>(acc, u, V, 512, pn * 256, wr, wc, fr, fq);
        else if (pn < 6) body<1>(acc, u, pn < 4 ? U : GV, 512, ((pn - 2) & 1) * 256, wr, wc, fr, fq);
        else body<2>(acc, u, pn < 10 ? GA : GG, 1024, ((pn - 6) & 3) * 256, wr, wc, fr, fq);
    }
};

struct EpiPlain8 {
    static constexpr bool PERM = true, AFTER_DRAIN = false, MIDK = false;
    bf16_t* O; int ldc; const float* rs; const float* cs; PG8_LAS unsigned char* stg;
    __device__ __forceinline__ void operator()(const f32x4 (&acc)[2][2][4][2], const Unit& u, int wr, int wc, int fr, int fq) const {
        const int row0 = u.pm * BM + wr * 64 + fr, ccol0 = u.pn * BM + wc * 32 + 8 * fq;
        f32x4 cv[2][2];
#pragma unroll
        for (int bj = 0; bj < 2; ++bj)
#pragma unroll
            for (int n = 0; n < 2; ++n) cv[bj][n] = *(const f32x4*)(cs + ccol0 + bj * HALF + 4 * n);
        float rsv[8];
#pragma unroll
        for (int i = 0; i < 8; ++i) rsv[i] = rs[row0 + (i >> 2) * HALF + (i & 3) * 16];
        asm volatile("s_waitcnt vmcnt(0)" : "+v"(rsv[0]), "+v"(rsv[1]), "+v"(rsv[2]), "+v"(rsv[3]), "+v"(rsv[4]), "+v"(rsv[5]), "+v"(rsv[6]), "+v"(rsv[7]), "+v"(cv[0][0]), "+v"(cv[0][1]), "+v"(cv[1][0]), "+v"(cv[1][1]) :: "memory");
        RowStore R; R.init(stg, wr, wc, fr, fq); bf16_t* pprev = nullptr; u32x4 tprev = (u32x4){0u, 0u, 0u, 0u};
        const int rowt0 = u.pm * BM + wr * 64 + R.r_, colw = u.pn * BM + wc * 32 + 8 * R.p_;
#pragma unroll
        for (int ai = 0; ai < 2; ++ai)
#pragma unroll
            for (int m = 0; m < 4; ++m) { const float rsc = rsv[ai * 4 + m];
#pragma unroll
                for (int bj = 0; bj < 2; ++bj) { const f32x4 v0 = acc[ai][bj][m][0] * cv[bj][0] * rsc, v1 = acc[ai][bj][m][1] * cv[bj][1] * rsc;
                    u32x4 w; w.x = cvt_pk_bf16(v0[0], v0[1]); w.y = cvt_pk_bf16(v0[2], v0[3]); w.z = cvt_pk_bf16(v1[0], v1[1]); w.w = cvt_pk_bf16(v1[2], v1[3]);
                    PG8_RS_EMIT(ai + m + bj == 0, w, O + (size_t)(rowt0 + ai * HALF + m * 16) * ldc + colw + bj * HALF); } }
        PG8_RS_FLUSH();
    }
};
typedef int i32x8 __attribute__((ext_vector_type(8)));
typedef short s16x16 __attribute__((ext_vector_type(16)));
template <bool F8> __device__ __forceinline__ void mma_blk(f32x4 (&acc)[4][2], const bf16x8 (&At)[4][2], const bf16x8 (&Bt)[2][2]) {
    __builtin_amdgcn_s_setprio(1);
    if constexpr (!F8) {
#pragma unroll
        for (int m = 0; m < 4; ++m)
#pragma unroll
            for (int n = 0; n < 2; ++n)
#pragma unroll
                for (int k = 0; k < 2; ++k) acc[m][n] = __builtin_amdgcn_mfma_f32_16x16x32_bf16(Bt[n][k], At[m][k], acc[m][n], 0, 0, 0);
    } else {
#pragma unroll
        for (int m = 0; m < 4; ++m)
#pragma unroll
            for (int n = 0; n < 2; ++n) {
                const i32x8 b = __builtin_bit_cast(i32x8, __builtin_shufflevector(Bt[n][0], Bt[n][1], 0, 1, 2, 3, 4, 5, 6, 7, 8, 9, 10, 11, 12, 13, 14, 15));
                const i32x8 a = __builtin_bit_cast(i32x8, __builtin_shufflevector(At[m][0], At[m][1], 0, 1, 2, 3, 4, 5, 6, 7, 8, 9, 10, 11, 12, 13, 14, 15));
                asm volatile("v_mfma_f32_16x16x128_f8f6f4 %0, %1, %2, %0" : "+v"(acc[m][n]) : "v"(b), "v"(a));
            }
    }
    __builtin_amdgcn_s_setprio(0);
}
template <class Epi, class Sched, bool ALIGN_EPI = false, bool SP2 = false, bool F8 = false>
__device__ __forceinline__ void gemm_phase(PG8_LAS unsigned char* lds, const Gemm g, const Sched& S, const Epi& E) {
    const int tid = threadIdx.x, wid = __builtin_amdgcn_readfirstlane(tid >> 6), lane = tid & 63, wr = wid >> 2, wc = wid & 3, fr = lane & 15, fq = lane >> 4;
    const int K = g.K, nt = K / BK;
    unsigned voffA[2], voffB[2];
#pragma unroll
    for (int i = 0; i < 2; ++i) { int R, C; stage_rc(tid * 16 + i * 8192, R, C); const int Rb = Epi::PERM ? ((R & ~31) + perm32(R & 31)) : R;
        voffA[i] = (unsigned)(R * K + C) * 2u; voffB[i] = (unsigned)(Rb * K + C) * 2u; }
    const size_t kstep = (size_t)(BK * 2);
    const size_t hstep = (size_t)HALF * K * 2;
    const size_t tstep = 2 * hstep;
    const unsigned ldsw = (unsigned)wid * 1024u;
    const int aoff = lds_byte(wr * 64 + fr, fq * 8), boff = lds_byte(wc * 32 + fr, fq * 8);
#define PG8_SA(b, h) (((b) * 2 + (h)) * HTB)
#define PG8_SB(b, h) ((4 + (b) * 2 + (h)) * HTB)
#define PG8_STAGE(bufoff, gbase, voff) do { _Pragma("unroll") for (int _i = 0; _i < 2; ++_i) \
        __builtin_amdgcn_global_load_lds((const unsigned*)((const char*)(gbase) + (voff)[_i]), (PG8_LAS unsigned*)(lds + (bufoff) + ldsw + _i * 8192), 16, 0, 0); } while (0)
#define PG8_LDA(dst, b, h) do { _Pragma("unroll") for (int m = 0; m < 4; ++m) _Pragma("unroll") for (int k = 0; k < 2; ++k) dst[m][k] = *(const PG8_LAS bf16x8*)(lds + PG8_SA(b, h) + aoff + m * 2048 + k * 1024); } while (0)
#define PG8_LDB(dst, b, h) do { _Pragma("unroll") for (int n = 0; n < 2; ++n) _Pragma("unroll") for (int k = 0; k < 2; ++k) dst[n][k] = *(const PG8_LAS bf16x8*)(lds + PG8_SB(b, h) + boff + n * 2048 + k * 1024); } while (0)
#define PG8_MMA(ai, bj, At, Bt) mma_blk<F8>(acc[ai][bj], At, Bt)
#define PG8_WAIT_V(n) asm volatile("s_waitcnt vmcnt(" #n ")" ::: "memory")
#define PG8_WAIT_L(n) asm volatile("s_waitcnt lgkmcnt(" #n ")" ::: "memory")
#define PG8_BAR __builtin_amdgcn_s_barrier()
#define PG8_SCHED __builtin_amdgcn_sched_barrier(0)
    Unit cur, nxt; int ui = 0;
    if (!S.next(0, cur)) return;
    f32x4 acc[2][2][4][2];
#pragma unroll
    for (int a = 0; a < 2; ++a)
#pragma unroll
        for (int b = 0; b < 2; ++b)
#pragma unroll
            for (int m = 0; m < 4; ++m)
#pragma unroll
                for (int n = 0; n < 2; ++n) acc[a][b][m][n] = (f32x4){0.f, 0.f, 0.f, 0.f};
    bf16x8 At[4][2], B0[2][2], B1[2][2];
    const char* cA = (const char*)g.A + (size_t)cur.pm * tstep; const char* cB = (const char*)g.Bt + (size_t)cur.pn * tstep;
    S.a_ready(cur);
    if constexpr (SP2) {
        PG8_STAGE(PG8_SB(0, 0), cB, voffB); PG8_STAGE(PG8_SB(0, 1), cB + hstep, voffB); PG8_STAGE(PG8_SA(0, 0), cA, voffA); PG8_STAGE(PG8_SA(0, 1), cA + hstep, voffA);
        if (wr == 1) PG8_BAR;
        PG8_WAIT_V(2); PG8_BAR;
        PG8_STAGE(PG8_SB(1, 0), cB + kstep, voffB); PG8_STAGE(PG8_SA(1, 0), cA + kstep, voffA); PG8_STAGE(PG8_SB(1, 1), cB + hstep + kstep, voffB);
        PG8_WAIT_V(6); PG8_BAR;
    } else {
        PG8_STAGE(PG8_SB(0, 0), cB, voffB); PG8_STAGE(PG8_SA(0, 0), cA, voffA); PG8_STAGE(PG8_SB(0, 1), cB + hstep, voffB); PG8_STAGE(PG8_SA(0, 1), cA + hstep, voffA);
        if (wr == 1) PG8_BAR;
        PG8_WAIT_V(4); PG8_BAR;
        PG8_STAGE(PG8_SB(1, 0), cB + kstep, voffB); PG8_STAGE(PG8_SA(1, 0), cA + kstep, voffA); PG8_STAGE(PG8_SB(1, 1), cB + hstep + kstep, voffB);
        PG8_WAIT_V(6); PG8_BAR;
    }
    for (;;) {
        const bool has_next = S.next(ui + 1, nxt);
        const char* nA = has_next ? (const char*)g.A + (size_t)nxt.pm * tstep : cA; const char* nB = has_next ? (const char*)g.Bt + (size_t)nxt.pn * tstep : cB;
#pragma unroll 1
        for (int t = 0; t < nt; t += 2) {
            const bool last = (t == nt - 2);
            const char* a1 = cA + (size_t)(t + 1) * kstep;
            const char* a2 = last ? nA : cA + (size_t)(t + 2) * kstep; const char* b2 = last ? nB : cB + (size_t)(t + 2) * kstep;
            const char* a3 = a2 + kstep; const char* b3 = b2 + kstep;
            if (last && has_next) S.a_ready(nxt);
            if constexpr (SP2) {
            PG8_LDB(B0, 0, 0); PG8_LDB(B1, 0, 1); PG8_SCHED; PG8_LDA(At, 0, 0); PG8_STAGE(PG8_SA(1, 1), a1 + hstep, voffA);
            PG8_WAIT_V(8); PG8_WAIT_L(0); PG8_BAR; PG8_MMA(0, 0, At, B0); PG8_MMA(0, 1, At, B1); PG8_BAR; PG8_SCHED;
            PG8_LDA(At, 0, 1); PG8_STAGE(PG8_SB(0, 0), b2, voffB); PG8_STAGE(PG8_SB(0, 1), b2 + hstep, voffB); PG8_STAGE(PG8_SA(0, 0), a2, voffA);
            PG8_WAIT_V(8); PG8_WAIT_L(0); PG8_BAR; PG8_MMA(1, 0, At, B0); PG8_MMA(1, 1, At, B1); PG8_BAR; PG8_SCHED;
            PG8_LDB(B0, 1, 0); PG8_LDB(B1, 1, 1); PG8_SCHED; PG8_LDA(At, 1, 0); PG8_STAGE(PG8_SA(0, 1), a2 + hstep, voffA);
            PG8_WAIT_V(8); PG8_WAIT_L(0); PG8_BAR; PG8_MMA(0, 0, At, B0); PG8_MMA(0, 1, At, B1); PG8_BAR; PG8_SCHED;
            PG8_LDA(At, 1, 1); PG8_STAGE(PG8_SB(1, 0), b3, voffB); PG8_STAGE(PG8_SB(1, 1), b3 + hstep, voffB); PG8_STAGE(PG8_SA(1, 0), a3, voffA);
            PG8_WAIT_V(8); PG8_WAIT_L(0); PG8_BAR; PG8_MMA(1, 0, At, B0); PG8_MMA(1, 1, At, B1); PG8_BAR; PG8_SCHED;
            } else {
            PG8_LDB(B0, 0, 0); PG8_SCHED; PG8_LDA(At, 0, 0); PG8_STAGE(PG8_SA(1, 1), a1 + hstep, voffA);
            PG8_WAIT_L(8); PG8_BAR; PG8_WAIT_L(0); PG8_MMA(0, 0, At, B0); PG8_BAR; PG8_SCHED;
            PG8_LDB(B1, 0, 1); PG8_STAGE(PG8_SB(0, 0), b2, voffB);
            PG8_BAR; PG8_WAIT_L(0); PG8_MMA(0, 1, At, B1); PG8_BAR;
            PG8_LDA(At, 0, 1); PG8_STAGE(PG8_SA(0, 0), a2, voffA);
            PG8_BAR; PG8_WAIT_L(0); PG8_MMA(1, 0, At, B0); PG8_BAR; PG8_SCHED;
            PG8_STAGE(PG8_SB(0, 1), b2 + hstep, voffB);
            PG8_WAIT_V(6); PG8_BAR; PG8_MMA(1, 1, At, B1); PG8_BAR;
            PG8_LDB(B0, 1, 0); PG8_SCHED; PG8_LDA(At, 1, 0); PG8_STAGE(PG8_SA(0, 1), a2 + hstep, voffA);
            PG8_WAIT_L(8); PG8_BAR; PG8_WAIT_L(0); PG8_MMA(0, 0, At, B0); PG8_BAR; PG8_SCHED;
            PG8_LDB(B1, 1, 1); PG8_STAGE(PG8_SB(1, 0), b3, voffB);
            PG8_BAR; PG8_WAIT_L(0); PG8_MMA(0, 1, At, B1); PG8_BAR;
            PG8_LDA(At, 1, 1); PG8_STAGE(PG8_SA(1, 0), a3, voffA);
            PG8_BAR; PG8_WAIT_L(0); PG8_MMA(1, 0, At, B0); PG8_BAR; PG8_SCHED;
            PG8_STAGE(PG8_SB(1, 1), b3 + hstep, voffB);
            PG8_WAIT_V(6); PG8_BAR; PG8_MMA(1, 1, At, B1); PG8_BAR;
            }
            if constexpr (Epi::MIDK) { if (t + 2 == nt / 2) E.mid(acc, cur, wr, wc, fr, fq); }
        }
        if constexpr (F8) asm volatile("s_nop 15\n\ts_nop 15" ::: "memory");
        if constexpr (ALIGN_EPI) { if (wr == 0) PG8_BAR; }
        if constexpr (!Epi::AFTER_DRAIN) { E(acc, cur, wr, wc, fr, fq); S.done(cur); }
        if (!has_next) break;
#pragma unroll
        for (int a = 0; a < 2; ++a)
#pragma unroll
            for (int b = 0; b < 2; ++b)
#pragma unroll
                for (int m = 0; m < 4; ++m)
#pragma unroll
                    for (int n = 0; n < 2; ++n) acc[a][b][m][n] = (f32x4){0.f, 0.f, 0.f, 0.f};
        cur = nxt; cA = nA; cB = nB; ++ui;
        if constexpr (ALIGN_EPI) { if (wr == 1) PG8_BAR; }
    }
    PG8_WAIT_V(0);
    if constexpr (!ALIGN_EPI) { if (wr == 0) PG8_BAR; }
    PG8_BAR;
    if constexpr (Epi::AFTER_DRAIN) { E.fused(acc, cur, wr, wc, fr, fq, lds, wid, lane); S.done(cur); }
#undef PG8_SA
#undef PG8_SB
#undef PG8_STAGE
#undef PG8_LDA
#undef PG8_LDB
#undef PG8_MMA
#undef PG8_WAIT_V
#undef PG8_WAIT_L
#undef PG8_BAR
#undef PG8_SCHED
}
}

constexpr int NB = 4, SEQ = 8192, DM = 1024, NT = NB * SEQ;
constexpr int NH = 8, HD = 64, AW = 512, GW = 512, INW = 4608;
constexpr int NEXP = 16384;
constexpr float EPS = 1e-6f;
constexpr int NWAVES = 8, NTHR = 512;

#ifndef MK_ONE_LAUNCH
#define MK_ONE_LAUNCH 1
#endif
constexpr int NPH = 15;

constexpr size_t MiB = 1u << 20;
constexpr size_t WS_CTL = 0, CTL_ZERO_BYTES = 64 * 1024;
constexpr size_t WS_MOD = 1 * MiB;
constexpr size_t WS_KM = 1 * MiB + 128 * 1024;
constexpr size_t WS_BIAS = 1 * MiB + 512 * 1024;
constexpr size_t WS_WIN = 4 * MiB;
constexpr size_t WS_WIN8 = 6 * MiB;
constexpr size_t WS_WIN8S = 10 * MiB;
constexpr size_t WS_H8 = 436 * MiB;
constexpr size_t WS_HS = 2 * MiB + 262144;
constexpr size_t WS_WBA = 13 * MiB, WS_WBG = 14 * MiB, WS_WOUT = 15 * MiB, WS_WQ = 17 * MiB;
constexpr size_t WS_PU = 20 * MiB, WS_PV = 36 * MiB;
constexpr size_t WS_USC = 52 * MiB, WS_VSC = 52 * MiB + 65536;
constexpr size_t WS_A = 84 * MiB;
constexpr size_t WS_B = 148 * MiB;
constexpr size_t WS_C = 244 * MiB;
constexpr size_t WS_D = 308 * MiB;
constexpr size_t WS_E = 436 * MiB;
constexpr size_t WS_QP = 212 * MiB;
constexpr size_t WS_PART = 276 * MiB;
constexpr size_t WS_PW = 404 * MiB;
constexpr size_t WS_EID = 420 * MiB;
constexpr size_t WS_GATE = 428 * MiB;
constexpr size_t WS_XH = 444 * MiB, WS_XL = 476 * MiB;
constexpr size_t WS_XSC = 2 * MiB;
constexpr size_t WS_END = 508 * MiB;

constexpr int RING_BYTES = 131072;
constexpr int MISC_OFF = 155648;
constexpr int LDS_BYTES = 159744;

#define GAS __attribute__((address_space(1)))
#define LAS __attribute__((address_space(3)))
typedef unsigned short bf16;
typedef unsigned v4u __attribute__((ext_vector_type(4)));
typedef float f32x4 __attribute__((ext_vector_type(4)));
#define DEVI __device__ __forceinline__
DEVI float bf2f(bf16 v) { return __uint_as_float(((unsigned)v) << 16); }
DEVI float bflo(unsigned u) { return __uint_as_float(u << 16); }
DEVI float bfhi(unsigned u) { return __uint_as_float(u & 0xffff0000u); }
DEVI unsigned pk2(float lo, float hi) { unsigned r; asm volatile("s_nop 0\n\tv_cvt_pk_bf16_f32 %0, %1, %2" : "=v"(r) : "v"(lo), "v"(hi)); return r; }
DEVI float wave_sum(float v) {
#pragma unroll
    for (int o = 32; o > 0; o >>= 1) v += __shfl_xor(v, o);
    return v; }
DEVI float wave_max(float v) {
#pragma unroll
    for (int o = 32; o > 0; o >>= 1) v = fmaxf(v, __shfl_xor(v, o));
    return v; }
DEVI float gelu_tanh(float x) { return pg8::act_gelu(x); }

#define XB_TMO      128
#define XB_XCNT(j)  (256  + 64 * (j))
#define XB_XSUB(j)  (1280 + 64 * (j))
#define XB_XGEN(j)  (2304 + 64 * (j))
#define XB_TOP      3328
#define XB_TOPGEN   3392
#define XCD_BAR_WORDS 3456
#define XB_SPIN_CAP (1u << 18)

__device__ __forceinline__ unsigned xb_ld(unsigned* p)              { return __hip_atomic_load(p, __ATOMIC_RELAXED, __HIP_MEMORY_SCOPE_AGENT); }
__device__ __forceinline__ unsigned xb_add(unsigned* p, unsigned v) { return __hip_atomic_fetch_add(p, v, __ATOMIC_RELAXED, __HIP_MEMORY_SCOPE_AGENT); }
__device__ __forceinline__ unsigned xb_xcc_id() { return (unsigned)__builtin_amdgcn_s_getreg((3 << 11) | 20) & 0xFu; }
#define XB_SPIN(cond, bar) do { unsigned _sp = 0; while (cond) { __builtin_amdgcn_s_sleep(1); \
    if ((++_sp & 255u) == 0u) { if (xb_ld(&(bar)[XB_TMO])) break; if (_sp > XB_SPIN_CAP) { atomicAdd(&(bar)[XB_TMO], 1u); break; } } } } while (0)

struct XcdBarrier {
    unsigned* bar; unsigned x;
    volatile LAS unsigned* st;
};

__device__ __forceinline__ XcdBarrier xcd_barrier_post(unsigned* bar, volatile LAS unsigned* st) {
    XcdBarrier b; b.bar = bar; b.x = xb_xcc_id(); b.st = st;
    if (threadIdx.x == 0) (void)xb_add(&bar[XB_XCNT(b.x)], 1u);
    return b;
}
__device__ __forceinline__ void xcd_barrier_complete(unsigned* bar, unsigned x, unsigned& nloc, unsigned& nx) {
    const unsigned G = gridDim.x * gridDim.y * gridDim.z;
    unsigned sum, cnt, mine, sp = 0u;
    for (;;) {
        sum = 0u; cnt = 0u; mine = 0u;
#pragma unroll
        for (unsigned j = 0; j < 16; ++j) { const unsigned c = xb_ld(&bar[XB_XCNT(j)]); sum += c; cnt += (c > 0u) ? 1u : 0u; mine = (j == x) ? c : mine; }
        if (sum == G) break;
        __builtin_amdgcn_s_sleep(1);
        if ((++sp & 255u) == 0u) { if (xb_ld(&bar[XB_TMO])) break; if (sp > XB_SPIN_CAP) { atomicAdd(&bar[XB_TMO], 1u); break; } }
    }
    nloc = mine > 0u ? mine : 1u; nx = cnt > 0u ? cnt : 1u;
}

__device__ __forceinline__ void xcd_barrier(const XcdBarrier& b) {
    asm volatile("s_waitcnt vmcnt(0)" ::: "memory");
    __syncthreads();
    if (threadIdx.x == 0) {
        unsigned* bar = b.bar;
        __builtin_amdgcn_s_waitcnt(0);
        unsigned nloc = b.st[0], nx = b.st[1];
        if (nloc == 0u) { xcd_barrier_complete(bar, b.x, nloc, nx); b.st[0] = nloc; b.st[1] = nx; }
        const unsigned old = xb_add(&bar[XB_XSUB(b.x)], 1u);
        const unsigned gen = old / nloc;
        if (old + 1u == (gen + 1u) * nloc) {
            __builtin_amdgcn_fence(__ATOMIC_RELEASE, "agent");
            asm volatile("s_waitcnt vmcnt(0)" ::: "memory");
            const unsigned og = xb_add(&bar[XB_TOP], 1u);
            const unsigned tg = og / nx;
            if (og + 1u == (tg + 1u) * nx) xb_add(&bar[XB_TOPGEN], 1u);
            else XB_SPIN(xb_ld(&bar[XB_TOPGEN]) == tg, bar);
            __builtin_amdgcn_fence(__ATOMIC_ACQUIRE, "agent");
            xb_add(&bar[XB_XGEN(b.x)], 1u);
            asm volatile("s_waitcnt vmcnt(0)" ::: "memory");
        } else {
            XB_SPIN(xb_ld(&bar[XB_XGEN(b.x)]) == gen, bar);
            __builtin_amdgcn_fence(__ATOMIC_ACQUIRE, "agent");
            asm volatile("s_waitcnt vmcnt(0)" ::: "memory");
        }
    }
    __syncthreads();
}
struct Args { const float* in[21]; float* out; unsigned char* ws; int ph_lo, ph_hi; };

DEVI void p0_transpose_tile(const float* __restrict__ W, int K, int N, bf16* __restrict__ WT, int tk, int tn, float* tile, int tid, int ldk = 0, int koff = 0) {
    if (ldk == 0) ldk = K;
    const int k0 = tk * 64, n0 = tn * 64;
    { const int r = tid >> 4, c4 = (tid & 15) * 4;
#pragma unroll
      for (int hh = 0; hh < 2; ++hh) { const int rr = r + 32 * hh; const f32x4 v = *(const f32x4*)(W + (size_t)(k0 + rr) * N + n0 + c4);
          tile[rr * 65 + c4 + 0] = v[0]; tile[rr * 65 + c4 + 1] = v[1]; tile[rr * 65 + c4 + 2] = v[2]; tile[rr * 65 + c4 + 3] = v[3]; } }
    __syncthreads();
    { const int n = tid >> 3, kc = (tid & 7) * 8; float v[8];
#pragma unroll
      for (int j = 0; j < 8; ++j) v[j] = tile[(kc + j) * 65 + n];
      v4u w; w.x = pk2(v[0], v[1]); w.y = pk2(v[2], v[3]); w.z = pk2(v[4], v[5]); w.w = pk2(v[6], v[7]);
      *(v4u*)(WT + (size_t)(n0 + n) * ldk + koff + k0 + kc) = w; }
    __syncthreads();
}
DEVI int t5_bucket(int rel) {
    const int n = rel < 0 ? 0 : rel;
    if (n < 16) return n;
    int b = 16;
    b = n >= 22 ? 17 : b; b = n >= 30 ? 18 : b; b = n >= 40 ? 19 : b; b = n >= 54 ? 20 : b; b = n >= 73 ? 21 : b; b = n >= 99 ? 22 : b; b = n >= 134 ? 23 : b; b = n >= 182 ? 24 : b;
    b = n >= 246 ? 25 : b; b = n >= 332 ? 26 : b; b = n >= 450 ? 27 : b; b = n >= 609 ? 28 : b; b = n >= 825 ? 29 : b; b = n >= 1117 ? 30 : b; b = n >= 1513 ? 31 : b;
    return b;
}
DEVI void p0_fp8_strip(const float* __restrict__ W, int ldw, int c0, unsigned char* __restrict__ dst, float* __restrict__ dsc, int r0, unsigned char* lds, int tid) {
    unsigned char* t8 = (unsigned char*)lds;
    unsigned* cm = (unsigned*)(lds + 16 * 1040);
    if (tid < 16) cm[tid] = 0u;
    const int kq = tid >> 2, c4 = (tid & 3) * 4;
    f32x4 v[8];
#pragma unroll
    for (int j = 0; j < 8; ++j) v[j] = *(const f32x4*)(W + (size_t)(kq + 128 * j) * ldw + c0 + c4);
    __syncthreads();
    f32x4 m = {0.f, 0.f, 0.f, 0.f};
#pragma unroll
    for (int j = 0; j < 8; ++j)
#pragma unroll
        for (int c = 0; c < 4; ++c) m[c] = fmaxf(m[c], fabsf(v[j][c]));
#pragma unroll
    for (int off = 4; off < 64; off <<= 1)
#pragma unroll
        for (int c = 0; c < 4; ++c) m[c] = fmaxf(m[c], __shfl_xor(m[c], off));
    if ((tid & 63) < 4) {
#pragma unroll
        for (int c = 0; c < 4; ++c) atomicMax(&cm[c4 + c], __float_as_uint(m[c])); }
    __syncthreads();
    float inv[4];
#pragma unroll
    for (int c = 0; c < 4; ++c) inv[c] = 224.0f / fmaxf(__uint_as_float(cm[c4 + c]), 1e-30f);
    if (tid < 16) dsc[r0 + tid] = fmaxf(__uint_as_float(cm[tid]), 1e-30f) * (1.0f / 224.0f);
#pragma unroll
    for (int j = 0; j < 8; ++j)
#pragma unroll
        for (int c = 0; c < 4; ++c) { const int p = __builtin_amdgcn_cvt_pk_fp8_f32(v[j][c] * inv[c], 0.f, 0, false); t8[(c4 + c) * 1040 + kq + 128 * j] = (unsigned char)(p & 0xff); }
    __syncthreads();
    { const int n = tid >> 5, kb = (tid & 31) * 32; const v4u q0 = *(const v4u*)(t8 + n * 1040 + kb), q1 = *(const v4u*)(t8 + n * 1040 + kb + 16);
      unsigned char* d = dst + (size_t)(r0 + n) * 1024 + kb; *(v4u*)d = q0; *(v4u*)(d + 16) = q1; }
    __syncthreads();
}
DEVI void p0_prologue(const Args& a, unsigned char* lds, int tid, int bid, int G) {
    unsigned char* ws = a.ws;
    float* tile = (float*)lds;
    float* silu = (float*)(lds + 32768);
    float* part = (float*)(lds + 49152);
    constexpr int N_WIN = 16 * 16 + 224, N_WB = 8 * 16, N_SQ = 16 * 16;
    constexpr int I1 = N_WIN, I2 = I1 + N_WB, I3 = I2 + N_WB, I4 = I3 + N_SQ, I5 = I4 + 64, I6 = I5 + 96;
    bool have_silu = false;
    for (int it = bid; it < I6; it += G) {
        if (it < 256) { p0_transpose_tile(a.in[6], 1024, INW, (bf16*)(ws + WS_WIN), it / 16, it % 16, tile, tid); }
        else if (it < I1) { const int j = it - 256; p0_fp8_strip(a.in[6], INW, 1024 + 16 * j, ws + WS_WIN8, (float*)(ws + WS_WIN8S), 16 * j, lds, tid); }
        else if (it < I2) { const int j = it - I1; p0_transpose_tile(a.in[12], 512, 1024, (bf16*)(ws + WS_WBA), j / 16, j % 16, tile, tid, 1024, 0); }
        else if (it < I3) { const int j = it - I2; p0_transpose_tile(a.in[13], 512, 1024, (bf16*)(ws + WS_WBA), j / 16, j % 16, tile, tid, 1024, 512); }
        else if (it < I4) { const int j = it - I3; p0_transpose_tile(a.in[14], 1024, 1024, (bf16*)(ws + WS_WOUT), j / 16, j % 16, tile, tid); }
        else if (it < I5) { const int j = it - I4; p0_fp8_strip(a.in[17], 1024, 16 * j, ws + WS_WQ, (float*)(ws + WS_WQ + MiB), 16 * j, lds, tid); }
        else {
            const int i = it - I5;
            if (!have_silu) { for (int idx = tid; idx < 4096; idx += NTHR) { const float c = a.in[1][idx]; silu[idx] = c / (1.0f + expf(-c)); } have_silu = true; }
            __syncthreads();
            const int w = tid >> 6, l = tid & 63, j = 64 * i + l;
            float acc[4] = {0.f, 0.f, 0.f, 0.f};
            const float* aw = a.in[2];
#pragma unroll 1
            for (int k0 = 128 * w; k0 < 128 * w + 128; k0 += 32) {
                float wv[32];
#pragma unroll
                for (int u = 0; u < 32; ++u) wv[u] = aw[(size_t)(k0 + u) * 6144 + j];
#pragma unroll
                for (int u = 0; u < 32; ++u)
#pragma unroll
                    for (int b = 0; b < 4; ++b) acc[b] += silu[b * 1024 + k0 + u] * wv[u];
            }
#pragma unroll
            for (int b = 0; b < 4; ++b) part[(w * 4 + b) * 64 + l] = acc[b];
            __syncthreads();
            if (tid < 256) { const int b = tid >> 6; float s = a.in[3][j];
#pragma unroll
                for (int ww = 0; ww < 8; ++ww) s += part[(ww * 4 + b) * 64 + l];
                ((float*)(ws + WS_MOD))[b * 6144 + j] = s; }
            asm volatile("s_waitcnt vmcnt(0)" ::: "memory");
            __syncthreads();
            if (tid == 0) { __builtin_amdgcn_fence(__ATOMIC_RELEASE, "agent"); asm volatile("s_waitcnt vmcnt(0)" ::: "memory");
                (void)__hip_atomic_fetch_add((unsigned*)(ws + WS_CTL) + 11600, 1u, __ATOMIC_RELAXED, __HIP_MEMORY_SCOPE_AGENT); }
        }
    }
    {
        const int lane = tid & 63;
        int rr0, rstep, rend;
        if (G == 256) { const int nmod = 96 * NWAVES, nA = nmod * 11;
            const bool is_mod = bid >= 32 && bid < 128;
            if (is_mod) { rr0 = (bid - 32) * NWAVES + (tid >> 6); rstep = nmod; rend = nA; }
            else { const int ob = bid < 32 ? bid : bid - 96; rr0 = nA + ob * NWAVES + (tid >> 6); rstep = 160 * NWAVES; rend = 2 * NEXP; } }
        else { rr0 = bid * NWAVES + (tid >> 6); rstep = G * NWAVES; rend = 2 * NEXP; }
        for (int rr = rr0; rr < rend; rr += rstep) {
            const bool second = rr >= NEXP; const int e = second ? rr - NEXP : rr;
            const float* src = (second ? a.in[20] : a.in[19]) + (size_t)e * 1024;
            unsigned char* dst = ws + (second ? WS_PV : WS_PU);
            f32x4 v[4]; float am = 0.f;
#pragma unroll
            for (int i = 0; i < 4; ++i) { v[i] = *(const f32x4*)(src + 4 * lane + 256 * i); am = fmaxf(am, fmaxf(fmaxf(fabsf(v[i][0]), fabsf(v[i][1])), fmaxf(fabsf(v[i][2]), fabsf(v[i][3])))); }
            am = wave_max(am); am = fmaxf(am, 1e-30f);
            const float inv = 224.0f / am;
            if (lane == 0) ((float*)(ws + (second ? WS_VSC : WS_USC)))[e] = am * (1.0f / 224.0f);
#pragma unroll
            for (int i = 0; i < 4; ++i) { int p = __builtin_amdgcn_cvt_pk_fp8_f32(v[i][0] * inv, v[i][1] * inv, 0, false); p = __builtin_amdgcn_cvt_pk_fp8_f32(v[i][2] * inv, v[i][3] * inv, p, true);
                const int sl = 2 * i + (lane >> 5);
                *(int*)(dst + ((size_t)sl * NEXP + e) * 128 + 4 * (lane & 31)) = p; }
        }
    }
    for (int i = bid * NTHR + tid; i < NB * 8 * 32 * 64; i += G * NTHR) ((float*)(ws + WS_KM))[i] = 0.f;
    for (int i = bid * NTHR + tid; i < 8 * 2048; i += G * NTHR) { const int h = i >> 11, rel = i & 2047; ((float*)(ws + WS_BIAS))[i] = a.in[11][t5_bucket(rel) * 8 + h]; }
}

DEVI void p1_prenorm(const float* __restrict__ x, const float* __restrict__ g, const float* __restrict__ mod, int sh_off, int sc_off, bf16* __restrict__ H, unsigned char* __restrict__ H8,
                     float* __restrict__ HS, int gw, int nw, int lane) {
    for (int row = gw; row < NT; row += nw) {
        const int b = row >> 13; const float* xr = x + (size_t)row * DM; const float* mb = mod + b * 6144;
        f32x4 v[4]; float ss = 0.f;
#pragma unroll
        for (int i = 0; i < 4; ++i) { v[i] = *(const f32x4*)(xr + 4 * lane + 256 * i); ss += v[i][0] * v[i][0] + v[i][1] * v[i][1] + v[i][2] * v[i][2] + v[i][3] * v[i][3]; }
        ss = wave_sum(ss);
        const float r = rsqrtf(ss * (1.0f / DM) + EPS);
        float o[16]; float am = 0.f;
#pragma unroll
        for (int i = 0; i < 4; ++i) { const int d = 4 * lane + 256 * i;
            const f32x4 gg = *(const f32x4*)(g + d), sc = *(const f32x4*)(mb + sc_off + d), sh = *(const f32x4*)(mb + sh_off + d);
#pragma unroll
            for (int j = 0; j < 4; ++j) { o[4 * i + j] = v[i][j] * r * gg[j] * (1.0f + sc[j]) + sh[j]; am = fmaxf(am, fabsf(o[4 * i + j])); }
            uint2 w; w.x = pk2(o[4 * i], o[4 * i + 1]); w.y = pk2(o[4 * i + 2], o[4 * i + 3]);
            *(uint2*)(H + (size_t)row * DM + d) = w; }
        am = fmaxf(wave_max(am), 1e-30f);
        const float inv = 224.0f / am;
        if (lane == 0) HS[row] = am * (1.0f / 224.0f);
#pragma unroll
        for (int i = 0; i < 4; ++i) { int p = __builtin_amdgcn_cvt_pk_fp8_f32(o[4 * i] * inv, o[4 * i + 1] * inv, 0, false); p = __builtin_amdgcn_cvt_pk_fp8_f32(o[4 * i + 2] * inv, o[4 * i + 3] * inv, p, true);
            *(int*)(H8 + (size_t)row * DM + 4 * lane + 256 * i) = p; }
    }
}


namespace kbs {
typedef short bf16x8 __attribute__((ext_vector_type(8)));
typedef short s16x4 __attribute__((ext_vector_type(4)));
constexpr int KROWB = 144;
constexpr int OFF_K = 0, OFF_V = 256 * KROWB, OFF_TAB = 2 * 256 * KROWB;
constexpr int TABN = 1600;
constexpr int OFF_SEL = OFF_TAB + TABN * 4;
constexpr int OFF_CNT = OFF_SEL + 1024;
constexpr int OFF_GB = OFF_CNT + 256;
constexpr int OFF_PFX = OFF_TAB + TABN * 4;
constexpr int END = OFF_PFX + 4112;
constexpr float SC2 = 0.125f * 1.4426950408889634f;
constexpr float NEG = -1.0e30f;
constexpr int TRI_TOTAL = 256 * 496;
constexpr int NGI = 32 * 136;
__host__ __device__ constexpr int tri(int n) { return 256 * (31 * n - n * (n - 1) / 2); }

DEVI s16x4 vtr(const unsigned char* p) { return __builtin_bit_cast(s16x4, __builtin_amdgcn_ds_read_tr16_b64_v4i16((LAS s16x4*)(LAS unsigned char*)p)); }

DEVI void select_unit(int bh, int qb, const bf16* __restrict__ Qb, const float* __restrict__ KM, unsigned* __restrict__ GCNT, unsigned short* __restrict__ GLIST, unsigned char* lds, int tid) {
    if (qb == 0) return;
    const int b = bh >> 3, h = bh & 7;
    const bf16* Qg = Qb + ((size_t)b * SEQ + 256 * qb) * 512 + h * 64;
    int* CNT = (int*)(lds + OFF_CNT); int* FIL = CNT + 32; int* GB = (int*)(lds + OFF_GB);
    if (tid < 64) CNT[tid] = 0;
    {
        const int lane = tid & 63, w = tid >> 6, li = lane & 15, g = lane >> 4;
        bf16x8 ah[2][2], al[2][2];
#pragma unroll
        for (int tl = 0; tl < 2; ++tl)
#pragma unroll
            for (int ks = 0; ks < 2; ++ks) {
                const float* kp = KM + ((size_t)(bh * 32 + 16 * tl + li)) * 64 + 8 * g + 32 * ks;
                const f32x4 a = *(const f32x4*)kp, c = *(const f32x4*)(kp + 4);
                const float v[8] = {a[0], a[1], a[2], a[3], c[0], c[1], c[2], c[3]};
                unsigned hi[4], lo[4];
#pragma unroll
                for (int k = 0; k < 4; ++k) { hi[k] = pk2(v[2 * k], v[2 * k + 1]); lo[k] = pk2(v[2 * k] - bflo(hi[k]), v[2 * k + 1] - bfhi(hi[k])); }
                ah[tl][ks] = __builtin_bit_cast(bf16x8, (v4u){hi[0], hi[1], hi[2], hi[3]}); al[tl][ks] = __builtin_bit_cast(bf16x8, (v4u){lo[0], lo[1], lo[2], lo[3]});
            }
#pragma unroll 1
        for (int gi = 0; gi < 2; ++gi) {
            const int q = 32 * w + 16 * gi + li;
            const bf16* qrow = Qg + (size_t)q * 512 + 8 * g;
            const bf16x8 qf0 = *(const bf16x8*)qrow, qf1 = *(const bf16x8*)(qrow + 32);
            f32x4 sc[2];
#pragma unroll
            for (int tl = 0; tl < 2; ++tl) {
                f32x4 d = __builtin_amdgcn_mfma_f32_16x16x32_bf16(ah[tl][0], qf0, (f32x4){0.f, 0.f, 0.f, 0.f}, 0, 0, 0);
                d = __builtin_amdgcn_mfma_f32_16x16x32_bf16(ah[tl][1], qf1, d, 0, 0, 0);
                d = __builtin_amdgcn_mfma_f32_16x16x32_bf16(al[tl][0], qf0, d, 0, 0, 0);
                d = __builtin_amdgcn_mfma_f32_16x16x32_bf16(al[tl][1], qf1, d, 0, 0, 0);
                sc[tl] = d;
            }
            float v0 = -3.0e38f, v1 = -3.0e38f, v2 = -3.0e38f; int i0 = 255, i1 = 255, i2 = 255;
#define KBS_INS(a_, n_) do { const float xa_ = (a_); const int xn_ = (n_); \
                if (xa_ > v0 || (xa_ == v0 && xn_ < i0)) { v2 = v1; i2 = i1; v1 = v0; i1 = i0; v0 = xa_; i0 = xn_; } \
                else if (xa_ > v1 || (xa_ == v1 && xn_ < i1)) { v2 = v1; i2 = i1; v1 = xa_; i1 = xn_; } \
                else if (xa_ > v2 || (xa_ == v2 && xn_ < i2)) { v2 = xa_; i2 = xn_; } } while (0)
#pragma unroll
            for (int tl = 0; tl < 2; ++tl)
#pragma unroll
                for (int j = 0; j < 4; ++j) { const int n = 16 * tl + 4 * g + j; if (n < qb) KBS_INS(sc[tl][j], n); }
#pragma unroll
            for (int st = 16; st <= 32; st <<= 1) {
                const float p0 = __shfl_xor(v0, st), p1 = __shfl_xor(v1, st), p2 = __shfl_xor(v2, st);
                const int j0 = __shfl_xor(i0, st), j1 = __shfl_xor(i1, st), j2 = __shfl_xor(i2, st);
                if (j0 != 255) KBS_INS(p0, j0);
                if (j1 != 255) KBS_INS(p1, j1);
                if (j2 != 255) KBS_INS(p2, j2);
            }
#undef KBS_INS
            if (g == 0) { unsigned char* sp = lds + OFF_SEL + q * 4; sp[0] = (unsigned char)i0; sp[1] = (unsigned char)i1; sp[2] = (unsigned char)i2; sp[3] = 255; }
        }
    }
    __syncthreads();
    const unsigned char* sp = lds + OFF_SEL + (tid & 255) * 4;
    if (tid < 256) {
#pragma unroll
        for (int j = 0; j < 3; ++j) { const int n = sp[j]; if (n != 255) atomicAdd(&CNT[n], 1); } }
    __syncthreads();
    if (tid < 32) { const int c = CNT[tid]; GB[tid] = c > 0 ? (int)atomicAdd(GCNT + bh * 32 + tid, (unsigned)c) : 0; }
    __syncthreads();
    if (tid < 256) {
        unsigned short* gl = GLIST + (size_t)bh * TRI_TOTAL;
#pragma unroll
        for (int j = 0; j < 3; ++j) { const int n = sp[j];
            if (n != 255) { const int pos = atomicAdd(&FIL[n], 1); gl[tri(n) + GB[n] + pos] = (unsigned short)((qb * 256 + tid) | (j << 13)); } } }
    __syncthreads();
}

DEVI void tile_load(const bf16* __restrict__ Kg, const bf16* __restrict__ Vg, size_t rowbase, unsigned char* lds, int tid) {
    v4u kr[4], vr[4];
#pragma unroll
    for (int i = 0; i < 4; ++i) { const int ch = tid + 512 * i, row = ch >> 3, c8 = ch & 7;
        kr[i] = *(const v4u*)(Kg + (rowbase + row) * 512 + c8 * 8); vr[i] = *(const v4u*)(Vg + (rowbase + row) * 512 + c8 * 8); }
#pragma unroll
    for (int i = 0; i < 4; ++i) { const int ch = tid + 512 * i, row = ch >> 3, c8 = ch & 7;
        *(v4u*)(lds + OFF_K + row * KROWB + c8 * 16) = kr[i]; *(v4u*)(lds + OFF_V + row * KROWB + c8 * 16) = vr[i]; }
}

template <bool OWN, bool FAR>
DEVI void chunk128_base(const unsigned char* lds, int ch, const bf16x8 qf0, const bf16x8 qf1, int lane, int relq, float& m, float& l, f32x4 (&o)[4]) {
    const int li = lane & 15, g = lane >> 4;
    const float* tab = (const float*)(lds + OFF_TAB);
    const float farb = tab[TABN - 1];
    f32x4 s[8];
    const unsigned char* kb = lds + OFF_K + (128 * ch + li) * KROWB + 16 * g;
#pragma unroll
    for (int kt = 0; kt < 8; ++kt)
#pragma unroll
        for (int j = 0; j < 4; ++j) { const int rel = relq - (16 * kt + 4 * g + j);
            s[kt][j] = OWN ? tab[rel < 0 ? 0 : rel] : (FAR ? farb : tab[rel > TABN - 1 ? TABN - 1 : rel]); }
#pragma unroll
    for (int kt = 0; kt < 8; ++kt) {
        const bf16x8 a0 = *(const bf16x8*)(kb + kt * 16 * KROWB), a1 = *(const bf16x8*)(kb + kt * 16 * KROWB + 64);
        s[kt] = __builtin_amdgcn_mfma_f32_16x16x32_bf16(a0, qf0, s[kt], 0, 0, 0);
        s[kt] = __builtin_amdgcn_mfma_f32_16x16x32_bf16(a1, qf1, s[kt], 0, 0, 0);
    }
    float mx = NEG;
#pragma unroll
    for (int kt = 0; kt < 8; ++kt) {
#pragma unroll
        for (int j = 0; j < 4; ++j) {
            const int rel = relq - (16 * kt + 4 * g + j);
            const float x = (!OWN || rel >= 0) ? s[kt][j] : NEG;
            s[kt][j] = x; mx = fmaxf(mx, x);
        }
    }
    mx = fmaxf(mx, __shfl_xor(mx, 16)); mx = fmaxf(mx, __shfl_xor(mx, 32));
    const float mnew = fmaxf(m, mx);
    const float alpha = __builtin_amdgcn_exp2f(m - mnew);
    float psum = 0.f;
#pragma unroll
    for (int kt = 0; kt < 8; ++kt) {
#pragma unroll
        for (int j = 0; j < 4; ++j) { const float p = __builtin_amdgcn_exp2f(s[kt][j] - mnew); s[kt][j] = p; psum += p; }
    }
    psum += __shfl_xor(psum, 16); psum += __shfl_xor(psum, 32);
    m = mnew; l = l * alpha + psum;
#pragma unroll
    for (int dt = 0; dt < 4; ++dt) o[dt] = o[dt] * alpha;
    const unsigned char* vb = lds + OFF_V + (128 * ch + 4 * g + (li >> 2)) * KROWB + 8 * (li & 3);
#pragma unroll
    for (int ks = 0; ks < 4; ++ks) {
        const bf16x8 pf = __builtin_bit_cast(bf16x8, (v4u){pk2(s[2 * ks][0], s[2 * ks][1]), pk2(s[2 * ks][2], s[2 * ks][3]), pk2(s[2 * ks + 1][0], s[2 * ks + 1][1]), pk2(s[2 * ks + 1][2], s[2 * ks + 1][3])});
#pragma unroll
        for (int dt = 0; dt < 4; ++dt) {
            const s16x4 t0 = vtr(vb + (32 * ks) * KROWB + 32 * dt), t1 = vtr(vb + (32 * ks + 16) * KROWB + 32 * dt);
            const bf16x8 vf = (bf16x8){t0[0], t0[1], t0[2], t0[3], t1[0], t1[1], t1[2], t1[3]};
            o[dt] = __builtin_amdgcn_mfma_f32_16x16x32_bf16(vf, pf, o[dt], 0, 0, 0);
        }
    }
}
template <bool FAR>
DEVI void chunk128_pair(const unsigned char* lds, int ch, const bf16x8 qf0, const bf16x8 qf1, int lane, int relq, float& m, float& l, f32x4 (&o)[4]) {
    const int li = lane & 15, g = lane >> 4;
    const float* tab = (const float*)(lds + OFF_TAB);
    const float farb = tab[TABN - 1];
    f32x4 s[8];
    const unsigned char* kb = lds + OFF_K + (128 * ch + li) * KROWB + 16 * g;
    const unsigned char* vb = lds + OFF_V + (128 * ch + 4 * g + (li >> 2)) * KROWB + 8 * (li & 3);
#pragma unroll
    for (int kt = 0; kt < 8; ++kt)
#pragma unroll
        for (int j = 0; j < 4; ++j) { const int rel = relq - (16 * kt + 4 * g + j); s[kt][j] = FAR ? farb : tab[rel > TABN - 1 ? TABN - 1 : rel]; }
    bf16x8 r0[2], r1[2];
#pragma unroll
    for (int kt = 0; kt < 2; ++kt) { r0[kt] = *(const bf16x8*)(kb + kt * 16 * KROWB); r1[kt] = *(const bf16x8*)(kb + kt * 16 * KROWB + 64); }
    __builtin_amdgcn_sched_barrier(0);
#pragma unroll
    for (int kt = 0; kt < 8; ++kt) {
        s[kt] = __builtin_amdgcn_mfma_f32_16x16x32_bf16(r0[kt & 1], qf0, s[kt], 0, 0, 0);
        s[kt] = __builtin_amdgcn_mfma_f32_16x16x32_bf16(r1[kt & 1], qf1, s[kt], 0, 0, 0);
        if (kt + 2 < 8) { r0[kt & 1] = *(const bf16x8*)(kb + (kt + 2) * 16 * KROWB); r1[kt & 1] = *(const bf16x8*)(kb + (kt + 2) * 16 * KROWB + 64); }
        __builtin_amdgcn_sched_barrier(0);
    }
    s16x4 va[2][4][2];
#pragma unroll
    for (int dt = 0; dt < 4; ++dt) { va[0][dt][0] = vtr(vb + 32 * dt); va[0][dt][1] = vtr(vb + 16 * KROWB + 32 * dt); }
    __builtin_amdgcn_sched_barrier(0);
    float mx = NEG;
#pragma unroll
    for (int kt = 0; kt < 8; ++kt) {
#pragma unroll
        for (int j = 0; j < 4; ++j) {
            mx = fmaxf(mx, s[kt][j]);
        }
    }
    mx = fmaxf(mx, __shfl_xor(mx, 16)); mx = fmaxf(mx, __shfl_xor(mx, 32));
    const float mnew = fmaxf(m, mx);
    const float alpha = __builtin_amdgcn_exp2f(m - mnew);
    float psum = 0.f;
#pragma unroll
    for (int kt = 0; kt < 8; ++kt) {
#pragma unroll
        for (int j = 0; j < 4; ++j) { const float p = __builtin_amdgcn_exp2f(s[kt][j] - mnew); s[kt][j] = p; psum += p; }
    }
    psum += __shfl_xor(psum, 16); psum += __shfl_xor(psum, 32);
    m = mnew; l = l * alpha + psum;
#pragma unroll
    for (int dt = 0; dt < 4; ++dt) o[dt] = o[dt] * alpha;
    __builtin_amdgcn_sched_barrier(0);
#pragma unroll
    for (int ks = 0; ks < 4; ++ks) {
        if (ks + 1 < 4) {
#pragma unroll
            for (int dt = 0; dt < 2; ++dt) { va[(ks + 1) & 1][dt][0] = vtr(vb + (32 * (ks + 1)) * KROWB + 32 * dt); va[(ks + 1) & 1][dt][1] = vtr(vb + (32 * (ks + 1) + 16) * KROWB + 32 * dt); } }
        const bf16x8 pf = __builtin_bit_cast(bf16x8, (v4u){pk2(s[2 * ks][0], s[2 * ks][1]), pk2(s[2 * ks][2], s[2 * ks][3]), pk2(s[2 * ks + 1][0], s[2 * ks + 1][1]), pk2(s[2 * ks + 1][2], s[2 * ks + 1][3])});
#pragma unroll
        for (int dt = 0; dt < 4; ++dt) {
            const s16x4 t0 = va[ks & 1][dt][0], t1 = va[ks & 1][dt][1];
            const bf16x8 vf = (bf16x8){t0[0], t0[1], t0[2], t0[3], t1[0], t1[1], t1[2], t1[3]};
            o[dt] = __builtin_amdgcn_mfma_f32_16x16x32_bf16(vf, pf, o[dt], 0, 0, 0);
            if (dt == 1 && ks + 1 < 4) {
#pragma unroll
                for (int d2 = 2; d2 < 4; ++d2) { va[(ks + 1) & 1][d2][0] = vtr(vb + (32 * (ks + 1)) * KROWB + 32 * d2); va[(ks + 1) & 1][d2][1] = vtr(vb + (32 * (ks + 1) + 16) * KROWB + 32 * d2); } }
        }
        __builtin_amdgcn_sched_barrier(0);
    }
}
template <bool OWN, bool FAR>
DEVI void chunk128(const unsigned char* lds, int ch, const bf16x8 qf0, const bf16x8 qf1, int lane, int relq, float& m, float& l, f32x4 (&o)[4]) {
    if constexpr (OWN) chunk128_base<true, false>(lds, ch, qf0, qf1, lane, relq, m, l, o);
    else chunk128_pair<FAR>(lds, ch, qf0, qf1, lane, relq, m, l, o);
}
DEVI void write_partial(unsigned char* __restrict__ POa, unsigned char* __restrict__ POc, float* __restrict__ PM, float* __restrict__ PL, int slot, size_t th, bool valid, int lane,
                        float m, float l, const f32x4 (&o)[4]) {
    if (!valid) return;
    const int g = lane >> 4;
    unsigned char* base = (slot < 2 ? POa + (size_t)slot * ((size_t)NT * NH * 128) : POc + (size_t)(slot - 2) * ((size_t)NT * NH * 128)) + th * 128 + 8 * g;
#pragma unroll
    for (int dt = 0; dt < 4; ++dt) { uint2 w; w.x = pk2(o[dt][0], o[dt][1]); w.y = pk2(o[dt][2], o[dt][3]); *(uint2*)(base + 32 * dt) = w; }
    if (g == 0) { PM[(size_t)slot * NT * NH + th] = m; PL[(size_t)slot * NT * NH + th] = l; }
}

DEVI void attn_items(const bf16* __restrict__ Qb, const bf16* __restrict__ Kb, const bf16* __restrict__ Vb, const float* __restrict__ BIAS, const unsigned* __restrict__ GCNT,
                     const unsigned short* __restrict__ GLIST, unsigned* __restrict__ queue, unsigned char* __restrict__ POa, unsigned char* __restrict__ POc, float* __restrict__ PM, float* __restrict__ PL,
                     unsigned char* lds, volatile LAS unsigned* MISC, int tid) {
    const int lane = tid & 63, w = __builtin_amdgcn_readfirstlane(tid >> 6), li = lane & 15, g = lane >> 4;
    int cur_h = -1;
    int* PFX = (int*)(lds + OFF_PFX);
    for (int p = tid; p < 1024; p += NTHR) { int parts = 0;
        if (p < 992) { const int c = (int)__hip_atomic_load(GCNT + (p & 31) * 32 + (p >> 5), __ATOMIC_RELAXED, __HIP_MEMORY_SCOPE_AGENT); parts = (((c + 15) >> 4) + 63) >> 6; }
        PFX[p + 1] = parts; }
    __syncthreads();
    if (tid < 64) { int v[16]; int sum = 0;
#pragma unroll
        for (int i = 0; i < 16; ++i) { v[i] = PFX[1 + 16 * tid + i]; sum += v[i]; }
        int incl = sum;
#pragma unroll
        for (int o = 1; o < 64; o <<= 1) { const int t = __shfl_up(incl, o); if (lane >= o) incl += t; }
        int run = incl - sum;
#pragma unroll
        for (int i = 0; i < 16; ++i) { run += v[i]; v[i] = run; }
#pragma unroll
        for (int i = 0; i < 16; ++i) PFX[1 + 16 * tid + i] = v[i];
        if (tid == 0) PFX[0] = 0; }
    __syncthreads();
    const int NG = PFX[992];
    if (tid == 0) MISC[16] = __hip_atomic_fetch_add(queue, 1u, __ATOMIC_RELAXED, __HIP_MEMORY_SCOPE_AGENT);
    int slot = 0;
#pragma unroll 1
    for (;;) {
        __syncthreads();
        const int it = (int)MISC[16 + slot];
        if (it >= NG + 1024) break;
        unsigned next_tk = 0;
        if (tid == 0) next_tk = __hip_atomic_fetch_add(queue, 1u, __ATOMIC_RELAXED, __HIP_MEMORY_SCOPE_AGENT);
        int bh, n, part = 0; bool own;
        if (it < NG) { own = false; int lo = 0, hi = 992;
            while (hi - lo > 1) { const int mid = (lo + hi) >> 1; if (PFX[mid] <= it) lo = mid; else hi = mid; }
            n = lo >> 5; bh = lo & 31; part = it - PFX[lo];
        } else { own = true; const int j = it - NG; bh = j & 31; n = j >> 5; }
        const int b = bh >> 3, h = bh & 7;
        int cnt = 0, G0 = 0, G1 = 0;
        if (!own) { cnt = (int)__hip_atomic_load(GCNT + bh * 32 + n, __ATOMIC_RELAXED, __HIP_MEMORY_SCOPE_AGENT); const int Gt = (cnt + 15) >> 4; G0 = 64 * part; G1 = G0 + 64 < Gt ? G0 + 64 : Gt; }
        if (h != cur_h) { int t_ = tid; asm volatile("" : "+v"(t_));
            float* tab = (float*)(lds + OFF_TAB); for (int i = t_; i < TABN; i += NTHR) tab[i] = BIAS[h * 2048 + i] * 1.4426950408889634f; cur_h = h; }
        tile_load(Kb + h * 64, Vb + h * 64, (size_t)b * SEQ + 256 * n, lds, tid);
        __syncthreads();
        if (own) {
            const int qb = n;
#pragma unroll 1
            for (int gi = 0; gi < 2; ++gi) {
                const int q = 32 * w + 16 * gi + li; const size_t t = (size_t)b * SEQ + 256 * qb + q;
                const bf16* qrow = Qb + t * 512 + h * 64 + 8 * g;
                const bf16x8 qf0 = *(const bf16x8*)qrow, qf1 = *(const bf16x8*)(qrow + 32);
                float m = NEG, l = 0.f; f32x4 o[4];
#pragma unroll
                for (int dt = 0; dt < 4; ++dt) o[dt] = (f32x4){0.f, 0.f, 0.f, 0.f};
                chunk128<true, false>(lds, 0, qf0, qf1, lane, q, m, l, o);
                if (w >= 4) chunk128<true, false>(lds, 1, qf0, qf1, lane, q - 128, m, l, o);
                write_partial(POa, POc, PM, PL, 3, t * NH + h, true, lane, m, l, o);
            }
        } else {
            const unsigned short* gl = GLIST + (size_t)bh * TRI_TOTAL + tri(n);
            int gq = G0 + w;
            auto ent = [&](int grp) -> int { const int c = 16 * grp + li; return (grp < G1) ? (int)gl[c < cnt ? c : 0] | ((c < cnt) ? 0 : 0x8000) : 0x8000; };
            int e0 = ent(gq), e1 = ent(gq + 8);
            const bf16* qr0 = Qb + ((size_t)b * SEQ + (e0 & 0x1FFF)) * 512 + h * 64 + 8 * g;
            bf16x8 q00 = *(const bf16x8*)qr0, q01 = *(const bf16x8*)(qr0 + 32);
#pragma unroll 1
            for (; gq < G1; gq += 8) {
                const int e2 = ent(gq + 16);
                const bf16* qr1 = Qb + ((size_t)b * SEQ + (e1 & 0x1FFF)) * 512 + h * 64 + 8 * g;
                const bf16x8 q10 = *(const bf16x8*)qr1, q11 = *(const bf16x8*)(qr1 + 32);
                const int s = e0 & 0x1FFF, slot = (e0 >> 13) & 3; const bool valid = (e0 & 0x8000) == 0;
                float m = NEG, l = 0.f; f32x4 o[4];
#pragma unroll
                for (int dt = 0; dt < 4; ++dt) o[dt] = (f32x4){0.f, 0.f, 0.f, 0.f};
                const int relq = s - 256 * n;
                const bool far = __all(!valid || relq - 255 >= 1513);
                if (far) { chunk128<false, true>(lds, 0, q00, q01, lane, relq, m, l, o); chunk128<false, true>(lds, 1, q00, q01, lane, relq - 128, m, l, o); }
                else { chunk128<false, false>(lds, 0, q00, q01, lane, relq, m, l, o); chunk128<false, false>(lds, 1, q00, q01, lane, relq - 128, m, l, o); }
                write_partial(POa, POc, PM, PL, slot, ((size_t)b * SEQ + s) * NH + h, valid, lane, m, l, o);
                e0 = e1; e1 = e2; q00 = q10; q01 = q11;
            }
        }
        slot ^= 1;
        if (tid == 0) MISC[16 + slot] = next_tk;
    }
}

DEVI void merge_partials(const unsigned char* __restrict__ POa, const unsigned char* __restrict__ POc, const float* __restrict__ PM, const float* __restrict__ PL, bf16* __restrict__ YA,
                         int gw, int nw, int lane) {
    const int hh = lane >> 3, pc = lane & 7;
    for (int t = gw; t < NT; t += nw) {
        const int qb = (t & (SEQ - 1)) >> 8; const size_t th = (size_t)t * NH + hh;
        float mj[4], lj[4]; v4u oj[4]; bool vj[4];
#pragma unroll
        for (int j = 0; j < 4; ++j) { vj[j] = (j == 3) || (j < qb);
            const unsigned char* base = (j < 2 ? POa + (size_t)j * ((size_t)NT * NH * 128) : POc + (size_t)(j - 2) * ((size_t)NT * NH * 128)) + th * 128 + 16 * pc;
            if (vj[j]) { mj[j] = PM[(size_t)j * NT * NH + th]; lj[j] = PL[(size_t)j * NT * NH + th]; oj[j] = *(const v4u*)base; }
            else { mj[j] = NEG; lj[j] = 0.f; oj[j] = (v4u){0u, 0u, 0u, 0u}; } }
        const float M = fmaxf(fmaxf(mj[0], mj[1]), fmaxf(mj[2], mj[3]));
        float L = 0.f; float acc[8] = {0.f, 0.f, 0.f, 0.f, 0.f, 0.f, 0.f, 0.f};
#pragma unroll
        for (int j = 0; j < 4; ++j) { const float a = vj[j] ? __builtin_amdgcn_exp2f(mj[j] - M) : 0.f; L += lj[j] * a;
            acc[0] += a * bflo(oj[j].x); acc[1] += a * bfhi(oj[j].x); acc[2] += a * bflo(oj[j].y); acc[3] += a * bfhi(oj[j].y);
            acc[4] += a * bflo(oj[j].z); acc[5] += a * bfhi(oj[j].z); acc[6] += a * bflo(oj[j].w); acc[7] += a * bfhi(oj[j].w); }
        const float inv = 1.0f / L;
        v4u w; w.x = pk2(acc[0] * inv, acc[1] * inv); w.y = pk2(acc[2] * inv, acc[3] * inv); w.z = pk2(acc[4] * inv, acc[5] * inv); w.w = pk2(acc[6] * inv, acc[7] * inv);
        *(v4u*)(YA + (size_t)t * 1024 + hh * 64 + 8 * pc) = w;
    }
}
}
typedef float f32x2_t __attribute__((ext_vector_type(2)));
DEVI void p4_gmlp_unit(int unit, const bf16* __restrict__ U, const bf16* __restrict__ GV, const float* __restrict__ lng, const float* __restrict__ lnb,
                       const float* __restrict__ ws_, const float* __restrict__ bs_, bf16* __restrict__ YG, unsigned char* lds, int tid) {
    typedef short bf16x8_t __attribute__((ext_vector_type(8)));
    typedef short s16x4_t __attribute__((ext_vector_type(4)));
    constexpr int VNP = 1040;
    const int wv = tid >> 6, lane = tid & 63;
    const size_t row0 = (size_t)unit * 128;
    {
        float gg[8], bb[8];
#pragma unroll
        for (int j = 0; j < 8; ++j) { gg[j] = lng[8 * lane + j]; bb[j] = lnb[8 * lane + j]; }
        for (int r = 0; r < 16; ++r) {
            const int tt = 16 * wv + r;
            const v4u w = *(const v4u*)(GV + (row0 + tt) * 512 + 8 * lane);
            float v[8] = {bflo(w.x), bfhi(w.x), bflo(w.y), bfhi(w.y), bflo(w.z), bfhi(w.z), bflo(w.w), bfhi(w.w)};
            float s = 0.f;
#pragma unroll
            for (int j = 0; j < 8; ++j) s += v[j];
            const float mu = wave_sum(s) * (1.0f / 512.0f);
            float q = 0.f;
#pragma unroll
            for (int j = 0; j < 8; ++j) { v[j] -= mu; q += v[j] * v[j]; }
            const float rs = rsqrtf(wave_sum(q) * (1.0f / 512.0f) + EPS);
#pragma unroll
            for (int j = 0; j < 8; ++j) v[j] = v[j] * rs * gg[j] + bb[j];
            v4u o; o.x = pk2(v[0], v[1]); o.y = pk2(v[2], v[3]); o.z = pk2(v[4], v[5]); o.w = pk2(v[6], v[7]);
            *(v4u*)(lds + tt * VNP + 16 * lane) = o;
        }
    }
    __syncthreads();
    {
        const int g = wv, li = lane & 15, kg = lane >> 4;
        const float* wg = ws_ + (size_t)g * 128 * 128;
        const unsigned char* vbase = lds + (8 * kg + (li >> 2)) * VNP + (64 * g + 4 * (li & 3)) * 2;
#pragma unroll
        for (int tt = 0; tt < 8; ++tt) {
            constexpr int dummy = 0; (void)dummy;
            const int t = 16 * tt + li;
            const int nks = tt / 2 + 1;
            bf16x8_t bw[4];
#pragma unroll
            for (int ks = 0; ks < 4; ++ks) {
                if (ks < nks) {
                    const float* wp = wg + t * 128 + 32 * ks + 8 * kg;
                    const f32x4 a = *(const f32x4*)wp, b = *(const f32x4*)(wp + 4);
                    const int s0 = 32 * ks + 8 * kg;
                    float m[8] = {a[0], a[1], a[2], a[3], b[0], b[1], b[2], b[3]};
#pragma unroll
                    for (int j = 0; j < 8; ++j) m[j] = (s0 + j <= t) ? m[j] : 0.f;
                    bw[ks] = __builtin_bit_cast(bf16x8_t, (v4u){pk2(m[0], m[1]), pk2(m[2], m[3]), pk2(m[4], m[5]), pk2(m[6], m[7])});
                }
            }
            const float bias = bs_[g * 128 + t];
#pragma unroll
            for (int ct = 0; ct < 4; ++ct) {
                f32x4 acc = (f32x4){0.f, 0.f, 0.f, 0.f};
#pragma unroll
                for (int ks = 0; ks < 4; ++ks) {
                    if (ks < nks) {
                        const unsigned char* ap = vbase + (32 * ks) * VNP + 32 * ct;
                        const s16x4_t t0 = __builtin_bit_cast(s16x4_t, __builtin_amdgcn_ds_read_tr16_b64_v4i16((LAS s16x4_t*)(LAS unsigned char*)ap));
                        const s16x4_t t1 = __builtin_bit_cast(s16x4_t, __builtin_amdgcn_ds_read_tr16_b64_v4i16((LAS s16x4_t*)(LAS unsigned char*)(ap + 4 * VNP)));
                        const bf16x8_t af = (bf16x8_t){t0[0], t0[1], t0[2], t0[3], t1[0], t1[1], t1[2], t1[3]};
                        acc = __builtin_amdgcn_mfma_f32_16x16x32_bf16(af, bw[ks], acc, 0, 0, 0);
                    }
                }
                const size_t o = (row0 + t) * 512 + 64 * g + 16 * ct + 4 * kg;
                const uint2 uu = *(const uint2*)(U + o);
                uint2 y; y.x = pk2(bflo(uu.x) * (acc[0] + bias), bfhi(uu.x) * (acc[1] + bias)); y.y = pk2(bflo(uu.y) * (acc[2] + bias), bfhi(uu.y) * (acc[3] + bias));
                *(uint2*)(YG + (row0 + t) * 1024 + 512 + 64 * g + 16 * ct + 4 * kg) = y;
            }
        }
    }
    __syncthreads();
}

DEVI void p7_mid(const float* __restrict__ x, const bf16* __restrict__ Y, const float* __restrict__ post_g1, const float* __restrict__ pre_g2, const float* __restrict__ mod,
                 float* __restrict__ X1, bf16* __restrict__ H2, unsigned char* __restrict__ XH, unsigned char* __restrict__ XL, float* __restrict__ XSC, int gw, int nw, int lane) {
    uint2 nyw[4]; f32x4 nxx[4];
    if (gw < NT) {
#pragma unroll
        for (int i = 0; i < 4; ++i) { const int d = 4 * lane + 256 * i; nyw[i] = *(const uint2*)(Y + (size_t)gw * DM + d); nxx[i] = *(const f32x4*)(x + (size_t)gw * DM + d); } }
    for (int row = gw; row < NT; row += nw) {
        const int b = row >> 13; const float* mb = mod + b * 6144;
        float y[16], xv[16]; float ss = 0.f;
#pragma unroll
        for (int i = 0; i < 4; ++i) { const uint2 w = nyw[i];
            y[4 * i + 0] = bflo(w.x); y[4 * i + 1] = bfhi(w.x); y[4 * i + 2] = bflo(w.y); y[4 * i + 3] = bfhi(w.y);
            const f32x4 xx = nxx[i]; xv[4 * i + 0] = xx[0]; xv[4 * i + 1] = xx[1]; xv[4 * i + 2] = xx[2]; xv[4 * i + 3] = xx[3]; }
        { const int nrow = (row + nw < NT) ? row + nw : row;
#pragma unroll
          for (int i = 0; i < 4; ++i) { const int d = 4 * lane + 256 * i; nyw[i] = *(const uint2*)(Y + (size_t)nrow * DM + d); nxx[i] = *(const f32x4*)(x + (size_t)nrow * DM + d); } }
#pragma unroll
        for (int j = 0; j < 16; ++j) ss += y[j] * y[j];
        const float r1 = rsqrtf(wave_sum(ss) * (1.0f / DM) + EPS);
        float s2 = 0.f;
#pragma unroll
        for (int i = 0; i < 4; ++i) { const int d = 4 * lane + 256 * i; const f32x4 g1 = *(const f32x4*)(post_g1 + d), gt = *(const f32x4*)(mb + 2048 + d);
            f32x4 o;
#pragma unroll
            for (int j = 0; j < 4; ++j) { const float v = xv[4 * i + j] + gt[j] * (y[4 * i + j] * r1 * g1[j]); xv[4 * i + j] = v; o[j] = v; s2 += v * v; }
            (void)o; }
        const float r2 = rsqrtf(wave_sum(s2) * (1.0f / DM) + EPS);
        float hv[16]; float am = 0.f;
#pragma unroll
        for (int i = 0; i < 4; ++i) { const int d = 4 * lane + 256 * i; const f32x4 g2 = *(const f32x4*)(pre_g2 + d), sc = *(const f32x4*)(mb + 4096 + d), sh = *(const f32x4*)(mb + 3072 + d);
#pragma unroll
            for (int j = 0; j < 4; ++j) { const float o = xv[4 * i + j] * r2 * g2[j] * (1.0f + sc[j]) + sh[j]; hv[4 * i + j] = o; am = fmaxf(am, fabsf(o)); }
        }
        am = fmaxf(wave_max(am), 1e-30f);
        const float sx = 224.0f / am;
        if (lane == 0) XSC[row] = am * (1.0f / 224.0f);
#pragma unroll
        for (int i = 0; i < 4; ++i) { const int d = 4 * lane + 256 * i;
            const float v0 = hv[4 * i] * sx, v1 = hv[4 * i + 1] * sx, v2 = hv[4 * i + 2] * sx, v3 = hv[4 * i + 3] * sx;
            int ph = __builtin_amdgcn_cvt_pk_fp8_f32(v0, v1, 0, false); ph = __builtin_amdgcn_cvt_pk_fp8_f32(v2, v3, ph, true);
            *(int*)(XH + (size_t)row * DM + d) = ph; }
    }
}

DEVI unsigned f2ord(float f) { const unsigned u = __float_as_uint(f); return u ^ ((u >> 31) ? 0xFFFFFFFFu : 0x80000000u); }
DEVI float ord2f(unsigned u) { const unsigned b = (u & 0x80000000u) ? (u ^ 0x80000000u) : ~u; return __uint_as_float(b); }
#define BITONIC_SORT16(N) do { _Pragma("unroll") for (int k_ = 2; k_ <= 16; k_ <<= 1) _Pragma("unroll") for (int j_ = k_ >> 1; j_ > 0; j_ >>= 1) _Pragma("unroll") for (int i_ = 0; i_ < 16; ++i_) { const int l_ = i_ ^ j_; \
    if (l_ > i_) { const unsigned a_ = N[i_], b_ = N[l_]; const unsigned hi_ = a_ > b_ ? a_ : b_, lo_ = a_ > b_ ? b_ : a_; if ((i_ & k_) == 0) { N[i_] = hi_; N[l_] = lo_; } else { N[i_] = lo_; N[l_] = hi_; } } } } while (0)
#define BITONIC_MERGE16(L, N) do { _Pragma("unroll") for (int i_ = 0; i_ < 16; ++i_) { const unsigned a_ = L[i_], b_ = N[15 - i_]; L[i_] = a_ > b_ ? a_ : b_; } \
    _Pragma("unroll") for (int j_ = 8; j_ > 0; j_ >>= 1) _Pragma("unroll") for (int i_ = 0; i_ < 16; ++i_) { const int l_ = i_ ^ j_; if (l_ > i_) { const unsigned a_ = L[i_], b_ = L[l_]; L[i_] = a_ > b_ ? a_ : b_; L[l_] = a_ > b_ ? b_ : a_; } } } while (0)
#define INSERT16(L, key) do { unsigned _k = (key); _Pragma("unroll") for (int _i = 0; _i < 16; ++_i) { const unsigned _h = L[_i] > _k ? L[_i] : _k; _k = L[_i] > _k ? _k : L[_i]; L[_i] = _h; } } while (0)
DEVI void p9_route(const bf16* __restrict__ QP, const float* __restrict__ subk, unsigned short* __restrict__ EID, float* __restrict__ GATE, unsigned char* lds, int tid, const pg8::StaticOrder& S) {
    typedef short bf16x8_t __attribute__((ext_vector_type(8)));
    constexpr int SKROW = 144;
    unsigned char* skb = lds;
    const int lane = tid & 63, w = tid >> 6, li = lane & 15, g = lane >> 4;
    float* scr = (float*)(lds + 40960 + w * 5120);
    unsigned char* ixs = lds + 81920 + tid * 32;
    for (int i = tid; i < 2 * 128 * 8; i += NTHR) { const int row = i >> 3, c8 = i & 7; const float* sp = subk + row * 64 + c8 * 8;
        const f32x4 a = *(const f32x4*)sp, b = *(const f32x4*)(sp + 4);
        *(v4u*)(skb + row * SKROW + c8 * 16) = (v4u){pk2(a[0], a[1]), pk2(a[2], a[3]), pk2(b[0], b[1]), pk2(b[2], b[3])}; }
    __syncthreads();
    for (int ui = 0; ; ++ui) { pg8::Unit un; if (!S.next(ui, un)) break;
        const int t = 256 * un.pm + (tid >> 1), h = 2 * un.pn + (tid & 1);
        unsigned L[2][16];
#pragma unroll
        for (int hf = 0; hf < 2; ++hf) {
#pragma unroll
            for (int i = 0; i < 16; ++i) L[hf][i] = 0u;
            bf16x8_t af[4][2];
#pragma unroll
            for (int rt = 0; rt < 4; ++rt) { const int row = 64 * w + 16 * rt + li; const bf16* qp = QP + (size_t)(256 * un.pm + (row >> 1)) * 1024 + (2 * un.pn + (row & 1)) * 128 + hf * 64 + 8 * g;
                af[rt][0] = *(const bf16x8_t*)qp; af[rt][1] = *(const bf16x8_t*)(qp + 32); }
#pragma unroll 1
            for (int kt = 0; kt < 8; ++kt) {
                const unsigned char* bp = skb + (hf * 128 + 16 * kt + li) * SKROW + 16 * g;
                const bf16x8_t b0 = *(const bf16x8_t*)bp, b1 = *(const bf16x8_t*)(bp + 64);
#pragma unroll
                for (int rt = 0; rt < 4; ++rt) {
                    f32x4 d = __builtin_amdgcn_mfma_f32_16x16x32_bf16(af[rt][0], b0, (f32x4){0.f, 0.f, 0.f, 0.f}, 0, 0, 0);
                    d = __builtin_amdgcn_mfma_f32_16x16x32_bf16(af[rt][1], b1, d, 0, 0, 0);
#pragma unroll
                    for (int j = 0; j < 4; ++j) scr[(16 * rt + 4 * g + j) * 20 + li] = d[j];
                }
                asm volatile("s_waitcnt lgkmcnt(0)" ::: "memory");
                f32x4 sv[4];
#pragma unroll
                for (int c4 = 0; c4 < 4; ++c4) sv[c4] = *(const f32x4*)(scr + lane * 20 + 4 * c4);
                asm volatile("s_waitcnt lgkmcnt(0)" ::: "memory");
                unsigned N[16];
#pragma unroll
                for (int c = 0; c < 16; ++c) N[c] = (f2ord(sv[c >> 2][c & 3]) & ~0x7Fu) | (unsigned)(127 - (16 * kt + c));
#pragma unroll
                for (int k = 2; k <= 16; k <<= 1)
#pragma unroll
                    for (int j = k >> 1; j > 0; j >>= 1)
#pragma unroll
                        for (int i = 0; i < 16; ++i) { const int l = i ^ j;
                            if (l > i) { const unsigned a = N[i], b = N[l]; const unsigned hi = a > b ? a : b, lo = a > b ? b : a;
                                if ((i & k) == 0) { N[i] = hi; N[l] = lo; } else { N[i] = lo; N[l] = hi; } } }
                if (kt == 0) {
#pragma unroll
                    for (int i = 0; i < 16; ++i) L[hf][i] = N[i];
                } else {
#pragma unroll
                    for (int i = 0; i < 16; ++i) { const unsigned a = L[hf][i], b = N[15 - i]; L[hf][i] = a > b ? a : b; }
#pragma unroll
                    for (int j = 8; j > 0; j >>= 1)
#pragma unroll
                        for (int i = 0; i < 16; ++i) { const int l = i ^ j;
                            if (l > i) { const unsigned a = L[hf][i], b = L[hf][l]; L[hf][i] = a > b ? a : b; L[hf][l] = a > b ? b : a; } }
                }
            }
        }
        float v1[16], v2[16];
#pragma unroll
        for (int i = 0; i < 16; ++i) { v1[i] = ord2f(L[0][i] & ~0x7Fu); v2[i] = ord2f(L[1][i] & ~0x7Fu); ixs[i] = (unsigned char)(127u - (L[0][i] & 0x7Fu)); ixs[16 + i] = (unsigned char)(127u - (L[1][i] & 0x7Fu)); }
        unsigned C[16];
        {
            unsigned N0[16] = {(f2ord(v1[0] + v2[0]) & ~0xFFu) | 255u, (f2ord(v1[0] + v2[1]) & ~0xFFu) | 254u, (f2ord(v1[0] + v2[2]) & ~0xFFu) | 253u, (f2ord(v1[0] + v2[3]) & ~0xFFu) | 252u, (f2ord(v1[0] + v2[4]) & ~0xFFu) | 251u, (f2ord(v1[0] + v2[5]) & ~0xFFu) | 250u, (f2ord(v1[0] + v2[6]) & ~0xFFu) | 249u, (f2ord(v1[0] + v2[7]) & ~0xFFu) | 248u, (f2ord(v1[0] + v2[8]) & ~0xFFu) | 247u, (f2ord(v1[0] + v2[9]) & ~0xFFu) | 246u, (f2ord(v1[0] + v2[10]) & ~0xFFu) | 245u, (f2ord(v1[0] + v2[11]) & ~0xFFu) | 244u, (f2ord(v1[0] + v2[12]) & ~0xFFu) | 243u, (f2ord(v1[0] + v2[13]) & ~0xFFu) | 242u, (f2ord(v1[0] + v2[14]) & ~0xFFu) | 241u, (f2ord(v1[0] + v2[15]) & ~0xFFu) | 240u};
            BITONIC_SORT16(N0);
            unsigned N1[16] = {(f2ord(v1[1] + v2[0]) & ~0xFFu) | 239u, (f2ord(v1[1] + v2[1]) & ~0xFFu) | 238u, (f2ord(v1[1] + v2[2]) & ~0xFFu) | 237u, (f2ord(v1[1] + v2[3]) & ~0xFFu) | 236u, (f2ord(v1[1] + v2[4]) & ~0xFFu) | 235u, (f2ord(v1[1] + v2[5]) & ~0xFFu) | 234u, (f2ord(v1[1] + v2[6]) & ~0xFFu) | 233u, (f2ord(v1[1] + v2[7]) & ~0xFFu) | 232u, (f2ord(v1[2] + v2[0]) & ~0xFFu) | 223u, (f2ord(v1[2] + v2[1]) & ~0xFFu) | 222u, (f2ord(v1[2] + v2[2]) & ~0xFFu) | 221u, (f2ord(v1[2] + v2[3]) & ~0xFFu) | 220u, (f2ord(v1[2] + v2[4]) & ~0xFFu) | 219u, (f2ord(v1[3] + v2[0]) & ~0xFFu) | 207u, (f2ord(v1[3] + v2[1]) & ~0xFFu) | 206u, (f2ord(v1[3] + v2[2]) & ~0xFFu) | 205u};
            BITONIC_SORT16(N1);
            unsigned N2[16] = {(f2ord(v1[3] + v2[3]) & ~0xFFu) | 204u, (f2ord(v1[4] + v2[0]) & ~0xFFu) | 191u, (f2ord(v1[4] + v2[1]) & ~0xFFu) | 190u, (f2ord(v1[4] + v2[2]) & ~0xFFu) | 189u, (f2ord(v1[5] + v2[0]) & ~0xFFu) | 175u, (f2ord(v1[5] + v2[1]) & ~0xFFu) | 174u, (f2ord(v1[6] + v2[0]) & ~0xFFu) | 159u, (f2ord(v1[6] + v2[1]) & ~0xFFu) | 158u, (f2ord(v1[7] + v2[0]) & ~0xFFu) | 143u, (f2ord(v1[7] + v2[1]) & ~0xFFu) | 142u, (f2ord(v1[8] + v2[0]) & ~0xFFu) | 127u, (f2ord(v1[9] + v2[0]) & ~0xFFu) | 111u, (f2ord(v1[10] + v2[0]) & ~0xFFu) | 95u, (f2ord(v1[11] + v2[0]) & ~0xFFu) | 79u, (f2ord(v1[12] + v2[0]) & ~0xFFu) | 63u, (f2ord(v1[13] + v2[0]) & ~0xFFu) | 47u};
            BITONIC_SORT16(N2);
            unsigned N3[16] = {(f2ord(v1[14] + v2[0]) & ~0xFFu) | 31u, (f2ord(v1[15] + v2[0]) & ~0xFFu) | 15u, 0u, 0u, 0u, 0u, 0u, 0u, 0u, 0u, 0u, 0u, 0u, 0u, 0u, 0u};
            BITONIC_SORT16(N3);
#pragma unroll
            for (int i = 0; i < 16; ++i) C[i] = N0[i];
            BITONIC_MERGE16(C, N1);
            BITONIC_MERGE16(C, N2);
            BITONIC_MERGE16(C, N3);
        }
        const float m = ord2f(C[0] & ~0xFFu);
        float p[16]; float sum = 0.f;
#pragma unroll
        for (int k = 0; k < 16; ++k) { p[k] = __expf(ord2f(C[k] & ~0xFFu) - m); sum += p[k]; }
        const float inv = 1.0f / sum;
        unsigned ev[16];
#pragma unroll
        for (int k = 0; k < 16; ++k) { const unsigned code = 255u - (C[k] & 0xFFu); ev[k] = (unsigned)ixs[code >> 4] * 128u + (unsigned)ixs[16 + (code & 15u)]; }
        { v4u* eo = (v4u*)(EID + (size_t)t * 128 + h * 16);
          eo[0] = (v4u){ev[0] | (ev[1] << 16), ev[2] | (ev[3] << 16), ev[4] | (ev[5] << 16), ev[6] | (ev[7] << 16)};
          eo[1] = (v4u){ev[8] | (ev[9] << 16), ev[10] | (ev[11] << 16), ev[12] | (ev[13] << 16), ev[14] | (ev[15] << 16)};
          f32x4* go = (f32x4*)(GATE + (size_t)t * 128 + h * 16);
#pragma unroll
          for (int k4 = 0; k4 < 4; ++k4) go[k4] = (f32x4){p[4 * k4] * inv, p[4 * k4 + 1] * inv, p[4 * k4 + 2] * inv, p[4 * k4 + 3] * inv}; }
    }
    __syncthreads();
}

constexpr int NSL = 8, SLD = 128, PCH = 256, NPCH = NT / PCH;
template <int CTRL> DEVI float dppf(float x) { return __builtin_bit_cast(float, __builtin_amdgcn_mov_dpp(__builtin_bit_cast(int, x), CTRL, 0xf, 0xf, true)); }
DEVI int shfl_i(int v, int srclane) { return __builtin_amdgcn_ds_bpermute(srclane << 2, v); }

DEVI void dma16(const void* gsrc, LAS unsigned char* lds_wave_base) { __builtin_amdgcn_global_load_lds((const unsigned*)gsrc, (LAS unsigned*)lds_wave_base, 16, 0, 0); }
DEVI long mk64(unsigned lo, unsigned hi) { return (long)(((unsigned long long)hi << 32) | (unsigned long long)lo); }
DEVI void peer_u_issue_half(unsigned e01, int h, const unsigned char* __restrict__ tb, LAS unsigned char* buf, int lane) {
#pragma unroll
    for (int i = 0; i < 8; ++i) {
        const unsigned ee = (unsigned)shfl_i((int)e01, 32 * h + 4 * i + (lane >> 4)); const unsigned e = (ee >> (16 * ((lane >> 3) & 1))) & 0xFFFFu;
        const unsigned c = (unsigned)(lane & 7) ^ (unsigned)((4 * i + (lane >> 4)) & 7);
        dma16(tb + (e * (unsigned)SLD + c * 16u), buf + 1024 * i);
    }
}
DEVI void peer_u_compute_half(LAS unsigned char* buf, int h, const long (&bh)[4], f32x4& sel, int lane) {
    const int r = lane & 15, kg = lane >> 4, swz = (r >> 1) & 7;
    const unsigned aA = (unsigned)(size_t)(buf + r * 128 + (((2 * kg) ^ swz) << 4)), aB = (unsigned)(size_t)(buf + r * 128 + (((2 * kg + 1) ^ swz) << 4));
    v4u pa[4], pb[4];
    asm volatile("ds_read_b128 %0, %8\n\tds_read_b128 %1, %9\n\tds_read_b128 %2, %8 offset:2048\n\tds_read_b128 %3, %9 offset:2048\n\t"
                 "ds_read_b128 %4, %8 offset:4096\n\tds_read_b128 %5, %9 offset:4096\n\tds_read_b128 %6, %8 offset:6144\n\tds_read_b128 %7, %9 offset:6144\n\ts_waitcnt lgkmcnt(0)"
                 : "=&v"(pa[0]), "=&v"(pb[0]), "=&v"(pa[1]), "=&v"(pb[1]), "=&v"(pa[2]), "=&v"(pb[2]), "=&v"(pa[3]), "=&v"(pb[3]) : "v"(aA), "v"(aB) : "memory");
    typedef int i32x8_u __attribute__((ext_vector_type(8)));
    const i32x8_u bx = {(int)(unsigned)bh[0], (int)(unsigned)(bh[0] >> 32), (int)(unsigned)bh[1], (int)(unsigned)(bh[1] >> 32), (int)(unsigned)bh[2], (int)(unsigned)(bh[2] >> 32), (int)(unsigned)bh[3], (int)(unsigned)(bh[3] >> 32)};
#pragma unroll
    for (int T = 0; T < 4; ++T) {
        const i32x8_u a8 = {(int)pa[T].x, (int)pa[T].y, (int)pa[T].z, (int)pa[T].w, (int)pb[T].x, (int)pb[T].y, (int)pb[T].z, (int)pb[T].w};
        const f32x4 ah = __builtin_amdgcn_mfma_scale_f32_16x16x128_f8f6f4(a8, bx, (f32x4){0.f, 0.f, 0.f, 0.f}, 0, 0, 0, 0, 0, 0);
        sel = (r == 4 * h + T) ? ah : sel;
    }
}
DEVI void rec_issue(const unsigned char* p_eid, const unsigned char* p_aux, const unsigned char* p_sc, LAS unsigned char* rec, int lane) {
    const unsigned char* src = lane < 16 ? p_eid + 16 * lane : (lane < 24 ? p_aux + 16 * (lane - 16) : (lane == 24 ? p_sc : p_eid));
    dma16(src, rec);
}
DEVI void rec_read(LAS unsigned char* rec, int lane, unsigned& e01, v4u& a0, v4u& a1, unsigned (&sc4)[1], int scsel) {
    const unsigned ae = (unsigned)(size_t)(rec + 4 * lane), aa = (unsigned)(size_t)(rec + 256 + 32 * (lane >> 4)), as = (unsigned)(size_t)(rec + 384 + 4 * scsel);
    asm volatile("ds_read_b32 %0, %4\n\tds_read_b128 %1, %5\n\tds_read_b128 %2, %5 offset:16\n\tds_read_b32 %3, %6\n\ts_waitcnt lgkmcnt(0)"
                 : "=&v"(e01), "=&v"(a0), "=&v"(a1), "=&v"(sc4[0]) : "v"(ae), "v"(aa), "v"(as) : "memory");
}
DEVI void peer_u_tokens(int t0, int sl, const unsigned char* __restrict__ XH, const unsigned* __restrict__ EID32, const unsigned char* __restrict__ PUs, float* __restrict__ PART,
                        LAS unsigned char* wbuf, LAS unsigned char* rbuf, int lane) {
    constexpr int NTK = PCH / NWAVES;
    const int kg = lane >> 4;
    const unsigned char* tb = PUs + (size_t)sl * NEXP * SLD;
    LAS unsigned char* buf0 = wbuf; LAS unsigned char* buf1 = wbuf + 8192;
    unsigned e_cur; v4u x0, x1; unsigned scd[1];
    asm volatile("s_waitcnt lgkmcnt(0)" ::: "memory");
    rec_issue((const unsigned char*)(EID32 + (size_t)t0 * 64), XH + (size_t)t0 * DM + sl * SLD, (const unsigned char*)EID32, rbuf, lane);
    asm volatile("s_waitcnt vmcnt(0)" ::: "memory");
    rec_read(rbuf, lane, e_cur, x0, x1, scd, 0);
    peer_u_issue_half(e_cur, 0, tb, buf0, lane);
#pragma unroll 1
    for (int j = 0; j < NTK; ++j) {
        const int t = t0 + j; const int tn = (t + 1 < NT) ? t + 1 : t;
        LAS unsigned char* rnext = rbuf + 1024 * ((j + 1) & 1);
        rec_issue((const unsigned char*)(EID32 + (size_t)tn * 64), XH + (size_t)tn * DM + sl * SLD, (const unsigned char*)EID32, rnext, lane);
        peer_u_issue_half(e_cur, 1, tb, buf1, lane);
        asm volatile("s_waitcnt vmcnt(9)" ::: "memory");
        const long bh[4] = {mk64(x0.x, x0.y), mk64(x0.z, x0.w), mk64(x1.x, x1.y), mk64(x1.z, x1.w)};
        f32x4 sel = (f32x4){0.f, 0.f, 0.f, 0.f};
        peer_u_compute_half(buf0, 0, bh, sel, lane);
        asm volatile("s_waitcnt vmcnt(8)" ::: "memory");
        unsigned e_nn; v4u y0, y1;
        rec_read(rnext, lane, e_nn, y0, y1, scd, 0);
        peer_u_issue_half(e_nn, 0, tb, buf0, lane);
        asm volatile("s_waitcnt vmcnt(8)" ::: "memory");
        peer_u_compute_half(buf1, 1, bh, sel, lane);
        if ((lane & 15) < 8) { uint2 pw; pw.x = pk2(sel[0], sel[1]); pw.y = pk2(sel[2], sel[3]);
            *(uint2*)((bf16*)PART + ((size_t)sl * NT + t) * 128 + 16 * (lane & 15) + 4 * kg) = pw; }
        e_cur = e_nn; x0 = y0; x1 = y1;
    }
    asm volatile("s_waitcnt vmcnt(0)" ::: "memory");
}
DEVI void peer_v_compute_half(LAS unsigned char* buf, int h, const v4u& wa, const v4u& wb, f32x4 (&acc)[8], int lane) {
    const int li = lane & 15, kg = lane >> 4, q = li >> 1, p = li & 1;
    const int row = 8 * kg + q, swz = (row >> 1) & 7;
    const unsigned ab = (unsigned)(size_t)(buf + row * 128 + 8 * p);
    unsigned ad[8];
#pragma unroll
    for (int mt = 0; mt < 8; ++mt) ad[mt] = ab + (unsigned)((mt ^ swz) << 4);
    const unsigned w8[8] = {wa.x, wa.y, wa.z, wa.w, wb.x, wb.y, wb.z, wb.w};
#pragma unroll
    for (int sp = 0; sp < 2; ++sp) {
        long a[8];
        if (sp == 0) asm volatile("ds_read_b64_tr_b8 %0, %8\n\tds_read_b64_tr_b8 %1, %9\n\tds_read_b64_tr_b8 %2, %10\n\tds_read_b64_tr_b8 %3, %11\n\t"
                                  "ds_read_b64_tr_b8 %4, %12\n\tds_read_b64_tr_b8 %5, %13\n\tds_read_b64_tr_b8 %6, %14\n\tds_read_b64_tr_b8 %7, %15\n\ts_waitcnt lgkmcnt(0)"
                                  : "=&v"(a[0]), "=&v"(a[1]), "=&v"(a[2]), "=&v"(a[3]), "=&v"(a[4]), "=&v"(a[5]), "=&v"(a[6]), "=&v"(a[7])
                                  : "v"(ad[0]), "v"(ad[1]), "v"(ad[2]), "v"(ad[3]), "v"(ad[4]), "v"(ad[5]), "v"(ad[6]), "v"(ad[7]) : "memory");
        else asm volatile("ds_read_b64_tr_b8 %0, %8 offset:4096\n\tds_read_b64_tr_b8 %1, %9 offset:4096\n\tds_read_b64_tr_b8 %2, %10 offset:4096\n\tds_read_b64_tr_b8 %3, %11 offset:4096\n\t"
                          "ds_read_b64_tr_b8 %4, %12 offset:4096\n\tds_read_b64_tr_b8 %5, %13 offset:4096\n\tds_read_b64_tr_b8 %6, %14 offset:4096\n\tds_read_b64_tr_b8 %7, %15 offset:4096\n\ts_waitcnt lgkmcnt(0)"
                          : "=&v"(a[0]), "=&v"(a[1]), "=&v"(a[2]), "=&v"(a[3]), "=&v"(a[4]), "=&v"(a[5]), "=&v"(a[6]), "=&v"(a[7])
                          : "v"(ad[0]), "v"(ad[1]), "v"(ad[2]), "v"(ad[3]), "v"(ad[4]), "v"(ad[5]), "v"(ad[6]), "v"(ad[7]) : "memory");
        const int s = 2 * h + sp;
        const long bw = mk64(w8[2 * s], w8[2 * s + 1]);
#pragma unroll
        for (int mt = 0; mt < 8; ++mt) acc[mt] = __builtin_amdgcn_mfma_f32_16x16x32_fp8_fp8(a[mt], bw, acc[mt], 0, 0, 0);
    }
}
DEVI void peer_v_tokens(int t0, int sl, const unsigned char* __restrict__ WQ8, const float* __restrict__ WSC, const unsigned* __restrict__ EID32, const unsigned char* __restrict__ PVs,
                        bf16* __restrict__ Y2, LAS unsigned char* wbuf, LAS unsigned char* rbuf, int lane) {
    constexpr int NTK = PCH / NWAVES;
    const int kg = lane >> 4, n = lane & 15;
    const unsigned char* tb = PVs + (size_t)sl * NEXP * SLD;
    LAS unsigned char* buf0 = wbuf; LAS unsigned char* buf1 = wbuf + 8192;
    unsigned e_cur; v4u x0, x1; unsigned scb[1];
    asm volatile("s_waitcnt lgkmcnt(0)" ::: "memory");
    rec_issue((const unsigned char*)(EID32 + (size_t)t0 * 64), WQ8 + (size_t)t0 * 128, (const unsigned char*)(WSC + (t0 & ~3)), rbuf, lane);
    asm volatile("s_waitcnt vmcnt(0)" ::: "memory");
    rec_read(rbuf, lane, e_cur, x0, x1, scb, t0 & 3);
    unsigned sc_bits = scb[0];
    peer_u_issue_half(e_cur, 0, tb, buf0, lane);
#pragma unroll 1
    for (int j = 0; j < NTK; ++j) {
        const int t = t0 + j; const int tn = (t + 1 < NT) ? t + 1 : t;
        LAS unsigned char* rnext = rbuf + 1024 * ((j + 1) & 1);
        rec_issue((const unsigned char*)(EID32 + (size_t)tn * 64), WQ8 + (size_t)tn * 128, (const unsigned char*)(WSC + (tn & ~3)), rnext, lane);
        peer_u_issue_half(e_cur, 1, tb, buf1, lane);
        asm volatile("s_waitcnt vmcnt(9)" ::: "memory");
        f32x4 acc[8];
#pragma unroll
        for (int mt = 0; mt < 8; ++mt) acc[mt] = (f32x4){0.f, 0.f, 0.f, 0.f};
        peer_v_compute_half(buf0, 0, x0, x1, acc, lane);
        asm volatile("s_waitcnt vmcnt(8)" ::: "memory");
        unsigned e_nn; v4u y0, y1;
        rec_read(rnext, lane, e_nn, y0, y1, scb, tn & 3);
        peer_u_issue_half(e_nn, 0, tb, buf0, lane);
        asm volatile("s_waitcnt vmcnt(8)" ::: "memory");
        peer_v_compute_half(buf1, 1, x0, x1, acc, lane);
        f32x4 sel = acc[0];
#pragma unroll
        for (int mt = 1; mt < 8; ++mt) sel = (n == mt) ? acc[mt] : sel;
        const float sc = __uint_as_float(sc_bits);
        if (n < 8) { uint2 o; o.x = pk2(sel[0] * sc, sel[1] * sc); o.y = pk2(sel[2] * sc, sel[3] * sc);
            *(uint2*)(Y2 + (size_t)t * DM + sl * SLD + 16 * n + 4 * kg) = o; }
        e_cur = e_nn; x0 = y0; x1 = y1; sc_bits = scb[0];
    }
    asm volatile("s_waitcnt vmcnt(0)" ::: "memory");
}
template <bool UPASS>
DEVI void peer_pass(unsigned* __restrict__ qcnt, const unsigned char* __restrict__ XH, const unsigned char* __restrict__ XL, const float* __restrict__ W, const unsigned* __restrict__ EID32, const unsigned char* __restrict__ TAB,
                    float* __restrict__ PART, bf16* __restrict__ Y2, volatile LAS unsigned* MISC, unsigned char* ldsbase, int tid) {
    const int lane = tid & 63, wv = tid >> 6;
    const int pref = (int)(xb_xcc_id() & 7u);
    constexpr int NTK = PCH / NWAVES;
    unsigned live = 0xFFu;
#pragma unroll 1
    for (int k = 0; k < NSL; ++k) {
        const int sl = (pref + k) & (NSL - 1);
        if (k == 1) {
            __syncthreads();
            if (tid < 64) { const unsigned c = (tid < NSL) ? __hip_atomic_load(qcnt + 64 * tid, __ATOMIC_RELAXED, __HIP_MEMORY_SCOPE_AGENT) : (unsigned)NPCH;
                const unsigned long long m = __ballot(c < (unsigned)NPCH); if (tid == 0) MISC[17] = (unsigned)m; }
            __syncthreads();
            live = MISC[17];
        }
        if (!((live >> sl) & 1u)) continue;
#pragma unroll 1
        for (;;) {
            __syncthreads();
            if (tid == 0) MISC[16] = __hip_atomic_fetch_add(qcnt + 64 * sl, 1u, __ATOMIC_RELAXED, __HIP_MEMORY_SCOPE_AGENT);
            __syncthreads();
            const int it = (int)MISC[16];
            if (it >= NPCH) break;
            const int t0 = it * PCH + wv * NTK;
            if (UPASS) {
                peer_u_tokens(t0, sl, XH, EID32, TAB, PART, (LAS unsigned char*)ldsbase + wv * 16384, (LAS unsigned char*)ldsbase + 131072 + wv * 2048, lane);
            } else {
                peer_v_tokens(t0, sl, XH  , (const float*)XL  , EID32, TAB, Y2, (LAS unsigned char*)ldsbase + wv * 16384, (LAS unsigned char*)ldsbase + 131072 + wv * 2048, lane);
            }
        }
    }
}
DEVI void peer_reduce(const float* __restrict__ PART, const float* __restrict__ GATE, const unsigned short* __restrict__ EID, const float* __restrict__ USC, const float* __restrict__ VSC, const float* __restrict__ XSC,
                      unsigned char* __restrict__ WQ8, float* __restrict__ WSC, int gw, int nw, int lane) {
    for (int tp = gw; tp < NT / 2; tp += nw) {
        const int t = 2 * tp + (lane >> 5), i4 = lane & 31;
        const size_t i = (size_t)t * 32 + i4;
        f32x4 s = (f32x4){0.f, 0.f, 0.f, 0.f};
#pragma unroll
        for (int sl = 0; sl < NSL; ++sl) { const uint2 pw = *(const uint2*)((const bf16*)PART + (size_t)sl * NT * 128 + i * 4); s += (f32x4){bflo(pw.x), bfhi(pw.x), bflo(pw.y), bfhi(pw.y)}; }
        const f32x4 g = *(const f32x4*)(GATE + i * 4);
        const uint2 ee = *(const uint2*)(EID + i * 4);
        const unsigned e[4] = {ee.x & 0xFFFFu, ee.x >> 16, ee.y & 0xFFFFu, ee.y >> 16};
        const float xs = XSC[t];
        float o[4]; float am = 0.f;
#pragma unroll
        for (int j = 0; j < 4; ++j) { o[j] = g[j] * gelu_tanh(s[j] * USC[e[j]] * xs) * VSC[e[j]]; am = fmaxf(am, fabsf(o[j])); }
#pragma unroll
        for (int m = 16; m > 0; m >>= 1) am = fmaxf(am, __shfl_xor(am, m));
        am = fmaxf(am, 1e-30f);
        const float inv = 224.0f / am;
        int pk = __builtin_amdgcn_cvt_pk_fp8_f32(o[0] * inv, o[1] * inv, 0, false); pk = __builtin_amdgcn_cvt_pk_fp8_f32(o[2] * inv, o[3] * inv, pk, true);
        const int p0 = 4 * i4, sK = p0 >> 5, kgK = (p0 >> 3) & 3, jK = p0 & 7;
        *(int*)(WQ8 + (size_t)t * 128 + kgK * 32 + sK * 8 + jK) = pk;
        if (i4 == 0) WSC[t] = am * (1.0f / 224.0f);
    }
}
DEVI void p10_final(const float* __restrict__ x, const bf16* __restrict__ Y1, const bf16* __restrict__ Y2, const float* __restrict__ post_g1, const float* __restrict__ post_g2,
                    const float* __restrict__ mod, float* __restrict__ OUT, int gw, int nw, int lane) {
    for (int row = gw; row < NT; row += nw) {
        const int b = row >> 13; const float* mb = mod + b * 6144;
        float y1[16], y2[16]; float s1 = 0.f, s2 = 0.f;
#pragma unroll
        for (int i = 0; i < 4; ++i) { const int d = 4 * lane + 256 * i; const uint2 w1 = *(const uint2*)(Y1 + (size_t)row * DM + d), w2 = *(const uint2*)(Y2 + (size_t)row * DM + d);
            y1[4 * i + 0] = bflo(w1.x); y1[4 * i + 1] = bfhi(w1.x); y1[4 * i + 2] = bflo(w1.y); y1[4 * i + 3] = bfhi(w1.y);
            y2[4 * i + 0] = bflo(w2.x); y2[4 * i + 1] = bfhi(w2.x); y2[4 * i + 2] = bflo(w2.y); y2[4 * i + 3] = bfhi(w2.y); }
#pragma unroll
        for (int j = 0; j < 16; ++j) { s1 += y1[j] * y1[j]; s2 += y2[j] * y2[j]; }
        const float r1 = rsqrtf(wave_sum(s1) * (1.0f / DM) + EPS), r2 = rsqrtf(wave_sum(s2) * (1.0f / DM) + EPS);
#pragma unroll
        for (int i = 0; i < 4; ++i) { const int d = 4 * lane + 256 * i;
            const f32x4 xx = *(const f32x4*)(x + (size_t)row * DM + d), g1 = *(const f32x4*)(post_g1 + d), g2 = *(const f32x4*)(post_g2 + d), gt1 = *(const f32x4*)(mb + 2048 + d), gt2 = *(const f32x4*)(mb + 5120 + d);
            f32x4 res;
#pragma unroll
            for (int j = 0; j < 4; ++j) { const float x1 = xx[j] + gt1[j] * (y1[4 * i + j] * r1 * g1[j]); res[j] = x1 + gt2[j] * (y2[4 * i + j] * r2 * g2[j]); }
            *(f32x4*)(OUT + (size_t)row * DM + d) = res; }
    }
}

__global__ void __launch_bounds__(NTHR, 2) fwd_kernel(Args args) {
    extern __shared__ __attribute__((aligned(16))) unsigned char lds[];
    const int tid = threadIdx.x, lane = tid & 63, wave = __builtin_amdgcn_readfirstlane(tid >> 6);
    const int G = gridDim.x, bid = blockIdx.x;
    const int gw = __builtin_amdgcn_readfirstlane(bid * NWAVES + wave), nw = G * NWAVES;
    unsigned char* ws = args.ws;
    volatile LAS unsigned* MISC = (volatile LAS unsigned*)((LAS unsigned char*)lds + MISC_OFF);
    if (tid < 64) MISC[tid] = 0u;
    __syncthreads();
#if MK_ONE_LAUNCH
    XcdBarrier bar = xcd_barrier_post((unsigned*)(ws + WS_CTL) + 1024, MISC + 8);
#define GRID_BAR() xcd_barrier(bar)
#else
#define GRID_BAR() do { } while (0)
#endif
    const int lo = args.ph_lo, hi = args.ph_hi;
#define IN(k) (lo <= (k) && (k) < hi)
#define SEAM(k) do { if (IN(k) && IN((k) + 1)) GRID_BAR(); } while (0)

    float* MOD = (float*)(ws + WS_MOD); float* KM = (float*)(ws + WS_KM); float* BIAS = (float*)(ws + WS_BIAS);
    bf16* WIN = (bf16*)(ws + WS_WIN); bf16* WBA = (bf16*)(ws + WS_WBA); bf16* WBG = (bf16*)(ws + WS_WBG); bf16* WOUT = (bf16*)(ws + WS_WOUT); bf16* WQ = (bf16*)(ws + WS_WQ);
    const unsigned char* PU = ws + WS_PU; const unsigned char* PV = ws + WS_PV; const float* USC = (const float*)(ws + WS_USC); const float* VSC = (const float*)(ws + WS_VSC);
    bf16* H1 = (bf16*)(ws + WS_A); bf16* MERGED = H1; bf16* H2 = H1;
    bf16* Qb = (bf16*)(ws + WS_B); bf16* Kb = Qb + (size_t)NT * 512; bf16* Vb = Kb + (size_t)NT * 512;
    bf16* Yb = Qb; bf16* QP = (bf16*)(ws + WS_QP);
    bf16* Ub = (bf16*)(ws + WS_C); bf16* GVb = Ub + (size_t)NT * 512;
    float* PART = (float*)(ws + WS_PART); float* PW = (float*)(ws + WS_PW); unsigned short* EID = (unsigned short*)(ws + WS_EID); float* GATE = (float*)(ws + WS_GATE); bf16* Y2 = H1;
    unsigned* QCNT = (unsigned*)(ws + WS_CTL) + 8192; unsigned* GCNT = (unsigned*)(ws + WS_CTL) + 12288; unsigned* QATT = (unsigned*)(ws + WS_CTL) + 13376;
    unsigned char* WQ8 = ws + WS_PW; float* WSC = (float*)(ws + WS_XSC + 131072);
    unsigned short* GLIST = (unsigned short*)(ws + WS_WIN); unsigned char* POa = ws + WS_A; unsigned char* POc = ws + WS_C; float* PMp = (float*)(ws + 500 * MiB); float* PLp = (float*)(ws + 504 * MiB);
    unsigned char* XH = ws + WS_XH; unsigned char* XL = ws + WS_XL; float* XSC = (float*)(ws + WS_XSC);
    bf16* GA = (bf16*)(ws + WS_D); bf16* GG = GA + (size_t)NT * 1024;
    bf16* YA = (bf16*)(ws + WS_E); bf16* YG = YA;
    LAS unsigned char* ring = (LAS unsigned char*)lds;
#define LV(x) ({ int t_ = (x); asm volatile("" : "+v"(t_)); t_; })
#define LS(x) ({ int t_ = (x); asm volatile("" : "+s"(t_)); t_; })

    if (IN(0)) { p0_prologue(args, lds, LV(tid), bid, G); }
    if (IN(0) && IN(1)) {
        if (tid == 0) { unsigned* ctl = (unsigned*)(ws + WS_CTL); XB_SPIN(xb_ld(ctl + 11600) < 96u, ctl + 1024);
            __builtin_amdgcn_fence(__ATOMIC_ACQUIRE, "agent"); asm volatile("s_waitcnt vmcnt(0)" ::: "memory"); }
        __syncthreads();
    }
    if (IN(1)) { p1_prenorm(args.in[0], args.in[4], MOD, 0, 1024, H1, ws + WS_H8, (float*)(ws + WS_HS), LS(gw), nw, LV(lane)); }
    SEAM(1);
    if (IN(2)) {
        { pg8::Gemm g{H1, WIN, NT, 1024, DM}; pg8::StaticOrder S; S.init(NT, 1024, G, bid); pg8::EpiIn E{Qb, Kb, Vb, Ub, GVb, GA, GG, KM, ring + RING_BYTES};
          pg8::gemm_phase<pg8::EpiIn, pg8::StaticOrder, true, true>(ring, g, S, E); }
        { pg8::Gemm g{(const bf16*)(ws + WS_H8), (const bf16*)(ws + WS_WIN8), NT, INW - 1024, DM / 2}; pg8::StaticOrder S; S.init(NT, INW - 1024, G, bid);
          pg8::EpiIn8 E{Vb, Ub, GVb, GA, GG, (const float*)(ws + WS_HS), (const float*)(ws + WS_WIN8S), ring + RING_BYTES};
          pg8::gemm_phase<pg8::EpiIn8, pg8::StaticOrder, true, true, true>(ring, g, S, E); }
    }
    SEAM(2);
    if (IN(3)) {
        for (int u = bid; u < NB * 64; u += G) p4_gmlp_unit(u, Ub, GVb, args.in[7], args.in[8], args.in[9], args.in[10], YG, lds, LV(tid));
#pragma unroll 1
        for (int u = bid; u < NB * NH * 32; u += G) kbs::select_unit(u >> 5, (u + (u >> 8) * 8) & 31, Qb, KM, GCNT, GLIST, lds, LV(tid));
    }
    SEAM(3);
    if (IN(4)) { kbs::attn_items(Qb, Kb, Vb, BIAS, GCNT, GLIST, QATT, POa, POc, PMp, PLp, lds, MISC, LV(tid)); }
    SEAM(4);
    if (IN(5)) { kbs::merge_partials(POa, POc, PMp, PLp, YA, LS(gw), nw, LV(lane)); }
    SEAM(5);
    if (IN(6)) {
        pg8::Gemm g{YA, WBA, NT, DM, DM}; pg8::StaticOrder S; S.init(NT, DM, G, bid); pg8::EpiMerge E{GA, GG, MERGED, ring + RING_BYTES};
        pg8::gemm_phase<pg8::EpiMerge, pg8::StaticOrder, true, true>(ring, g, S, E);
    }
    SEAM(6);
    if (IN(7)) {
        pg8::Gemm g{MERGED, WOUT, NT, DM, DM}; pg8::StaticOrder S; S.init(NT, DM, G, bid); pg8::EpiPlain E{Yb, DM, ring + RING_BYTES};
        pg8::gemm_phase<pg8::EpiPlain, pg8::StaticOrder, true, true>(ring, g, S, E);
    }
    SEAM(7);
    if (IN(8)) { p7_mid(args.in[0], Yb, args.in[5], args.in[15], MOD, args.out, H2, XH, XL, XSC, LS(gw), nw, LV(lane)); }
    SEAM(8);
    if (IN(9)) {
        pg8::Gemm g{(const bf16*)XH, (const bf16*)(ws + WS_WQ), NT, DM, DM / 2}; pg8::StaticOrder S; S.init(NT, DM, G, bid);
        pg8::EpiPlain8 E{QP, DM, XSC, (const float*)(ws + WS_WQ + MiB), ring + RING_BYTES};
        pg8::gemm_phase<pg8::EpiPlain8, pg8::StaticOrder, true, true, true>(ring, g, S, E);
    }
    if (IN(10)) { asm volatile("s_waitcnt vmcnt(0)" ::: "memory"); __syncthreads();
        pg8::StaticOrder S; S.init(NT, DM, G, bid); p9_route(QP, args.in[18], EID, GATE, lds, LV(tid), S); }
    SEAM(10);
    if (IN(11)) { peer_pass<true>(QCNT, XH, XL, nullptr, (const unsigned*)EID, PU, PART, nullptr, MISC, lds, LV(tid)); }
    SEAM(11);
    if (IN(12)) { peer_reduce(PART, GATE, EID, USC, VSC, XSC, WQ8, WSC, LS(gw), nw, LV(lane)); }
    SEAM(12);
    if (IN(13)) { peer_pass<false>(QCNT + 64 * NSL, WQ8, (const unsigned char*)WSC, nullptr, (const unsigned*)EID, PV, nullptr, Y2, MISC, lds, LV(tid)); }
    SEAM(13);
    if (IN(14)) { p10_final(args.in[0], Yb, Y2, args.in[5], args.in[16], MOD, args.out, LS(gw), nw, LV(lane)); }
#undef IN
#undef SEAM
}

extern "C" void kernel_launch(void* const* d_in, const int* in_sizes, int n_in, void* d_out, int out_size, void* d_ws, size_t ws_size, hipStream_t stream) {
    static int grid = 0;
    if (grid == 0) {
        if (n_in != 21 || out_size != NT * DM || ws_size < WS_END) { fprintf(stderr, "kernel_launch: unexpected shapes (n_in %d out %d ws %zu)\n", n_in, out_size, ws_size); grid = -1; return; }
        int dev = 0, cus = 0, per_cu = 0;
        if (hipGetDevice(&dev) != hipSuccess || hipDeviceGetAttribute(&cus, hipDeviceAttributeMultiprocessorCount, dev) != hipSuccess) { grid = -1; return; }
        if (hipFuncSetAttribute((const void*)fwd_kernel, hipFuncAttributeMaxDynamicSharedMemorySize, LDS_BYTES) != hipSuccess) { fprintf(stderr, "kernel_launch: hipFuncSetAttribute failed\n"); grid = -1; return; }
        if (hipOccupancyMaxActiveBlocksPerMultiprocessor(&per_cu, (const void*)fwd_kernel, NTHR, LDS_BYTES) != hipSuccess || per_cu < 1) { fprintf(stderr, "kernel_launch: occupancy query says %d\n", per_cu); (void)hipGetLastError(); per_cu = 1; }
        grid = cus;
    }
    if (grid < 0) return;
    (void)hipMemsetAsync((char*)d_ws + WS_CTL, 0, CTL_ZERO_BYTES, stream);
    Args a{};
    for (int i = 0; i < 21; ++i) a.in[i] = (const float*)d_in[i];
    a.out = (float*)d_out; a.ws = (unsigned char*)d_ws;
#if MK_ONE_LAUNCH
    a.ph_lo = 0; a.ph_hi = NPH;
    hipLaunchKernelGGL(fwd_kernel, dim3(grid), dim3(NTHR), LDS_BYTES, stream, a);
#else
    for (int p = 0; p < NPH; ++p) { a.ph_lo = p; a.ph_hi = p + 1; hipLaunchKernelGGL(fwd_kernel, dim3(grid), dim3(NTHR), LDS_BYTES, stream, a); }
#endif
}
```
